# Optimizing an MI355X kernel written in HIP

```python
import jax, jax.numpy as jnp
from jax import lax
import numpy as np

D_MODEL = 1024
BATCH = 8
SEQ = 4096
DEPTH = 4

CHUNK = 64
N_MIXERS = 2
EPS = 1e-6

HG_DK = 128
HG_HEADS = max(4, D_MODEL // HG_DK)
HG_DV = D_MODEL // HG_HEADS
HG_FDIM = HG_HEADS * HG_DK
HG_WIDTH = HG_HEADS * HG_DV
HG_IN = 2 * HG_FDIM + 2 * HG_WIDTH

FX_HD = 64
FX_HEADS = D_MODEL // FX_HD
FX_WIDTH = FX_HEADS * FX_HD
FX_IN = 4 * FX_WIDTH + FX_HEADS
Q_BLOCK = 128

N_HG_LAYERS = (DEPTH + N_MIXERS - 1) // N_MIXERS
N_FX_LAYERS = DEPTH // N_MIXERS

kernel_name = "hybrid_hgrn2_fox_adaln_trunk"


def _rms(x, g):
    xf = x.astype(jnp.float32)
    y = xf * lax.rsqrt(jnp.mean(xf * xf, axis=-1, keepdims=True) + EPS)
    return (y * g.astype(jnp.float32)).astype(x.dtype)


def _hgrn2_scan(q, log_f, k, v):
    B, S, H, DK = q.shape
    DV = v.shape[-1]
    N = S // CHUNK

    def to_chunks(t):
        return t.astype(jnp.float32).reshape(B, N, CHUNK, H, t.shape[-1]).transpose(1, 0, 3, 2, 4)

    qc, gc, kc, vc = to_chunks(q), to_chunks(log_f), to_chunks(k), to_chunks(v)
    causal = jnp.tril(jnp.ones((CHUNK, CHUNK), dtype=bool))

    def step(state, inp):
        qb, gb, kb, vb = inp
        bcum = jnp.cumsum(gb, axis=2)
        inter = jnp.einsum('bhtk,bhkv->bhtv', qb * jnp.exp(bcum), state)
        diff = jnp.where(causal[None, None, :, :, None],
                         bcum[:, :, :, None, :] - bcum[:, :, None, :, :], -jnp.inf)
        scores = jnp.einsum('bhtk,bhsk,bhtsk->bhts', qb, kb, jnp.exp(diff))
        intra = jnp.einsum('bhts,bhsv->bhtv', scores, vb)
        last = bcum[:, :, -1]
        k_dec = kb * jnp.exp(last[:, :, None, :] - bcum)
        new_state = state * jnp.exp(last)[..., None] + jnp.einsum('bhsk,bhsv->bhkv', k_dec, vb)
        return new_state, inter + intra

    s0 = jnp.zeros((B, H, DK, DV), jnp.float32)
    _, out = lax.scan(step, s0, (qc, gc, kc, vc))
    return out.transpose(1, 0, 3, 2, 4).reshape(B, S, H, DV)


def _hgrn2_layer(h, w_in, lb, o_g, w_out):
    B, S, _ = h.shape
    proj = h @ w_in
    q, fl, i, z = jnp.split(proj, [HG_FDIM, 2 * HG_FDIM, 2 * HG_FDIM + HG_WIDTH], axis=-1)
    fl = fl.astype(jnp.float32)
    log_f = jnp.logaddexp(jnp.log(lb), jnp.log1p(-lb) + jax.nn.log_sigmoid(fl))
    k = (1.0 - lb) * jax.nn.sigmoid(-fl)
    shp = (B, S, HG_HEADS, HG_DK)
    o = _hgrn2_scan(q.reshape(shp), log_f.reshape(shp), k.reshape(shp),
                    i.reshape(B, S, HG_HEADS, HG_DV))
    o = _rms(o, o_g.reshape(HG_HEADS, HG_DV)).astype(h.dtype)
    o = o.reshape(B, S, HG_WIDTH) * jax.nn.silu(z)
    return o @ w_out


def _fox_attn(q, k, v, log_f):
    B, S, H, D = q.shape
    cum = jnp.cumsum(log_f, axis=1).transpose(0, 2, 1)
    qh, kh, vh = (t.transpose(0, 2, 1, 3) for t in (q, k, v))
    scale = D ** -0.5
    outs = []
    for blk in range(S // Q_BLOCK):
        q0, q1 = blk * Q_BLOCK, (blk + 1) * Q_BLOCK
        s = jnp.einsum('bhtd,bhsd->bhts', qh[:, :, q0:q1], kh[:, :, :q1],
                       preferred_element_type=jnp.float32) * scale
        s = s + cum[:, :, q0:q1, None] - cum[:, :, None, :q1]
        tpos = jnp.arange(q0, q1)
        spos = jnp.arange(q1)
        s = jnp.where(spos[None, :] <= tpos[:, None], s, -jnp.inf)
        p = jax.nn.softmax(s, axis=-1)
        outs.append(jnp.einsum('bhts,bhsd->bhtd', p.astype(vh.dtype), vh[:, :, :q1]))
    return jnp.concatenate(outs, axis=2).transpose(0, 2, 1, 3)


def _fox_layer(h, w_in, b_f, q_g, k_g, w_out):
    B, S, _ = h.shape
    proj = h @ w_in
    q, k, v, z, fl = jnp.split(proj, [FX_WIDTH, 2 * FX_WIDTH, 3 * FX_WIDTH, 4 * FX_WIDTH], axis=-1)
    shp = (B, S, FX_HEADS, FX_HD)
    q = _rms(q.reshape(shp), q_g)
    k = _rms(k.reshape(shp), k_g)
    log_f = jax.nn.log_sigmoid(fl.astype(jnp.float32) + b_f.astype(jnp.float32))
    o = _fox_attn(q, k, v.reshape(shp), log_f)
    o = o.reshape(B, S, FX_WIDTH) * jax.nn.silu(z)
    return o @ w_out


def setup_inputs(seed: int = 0) -> dict:
    key = jax.random.key(seed)
    ks = jax.random.split(key, 16)
    f32 = jnp.float32
    D = D_MODEL
    return {
        "x": jax.random.normal(ks[0], (BATCH, SEQ, D), f32),
        "c": jax.random.normal(ks[1], (BATCH, D), f32),
        "norm_g": 1.0 + 0.05 * jax.random.normal(ks[2], (DEPTH, D), f32),
        "ada_w": 0.5 * D ** -0.5 * jax.random.normal(ks[3], (DEPTH, D, 3 * D), f32),
        "ada_b": 0.02 * jax.random.normal(ks[4], (DEPTH, 3 * D), f32),
        "hg_lb_logits": jax.random.normal(ks[5], (N_HG_LAYERS, HG_FDIM), f32),
        "hg_w_in": D ** -0.5 * jax.random.normal(ks[6], (N_HG_LAYERS, D, HG_IN), f32),
        "hg_o_g": 1.0 + 0.05 * jax.random.normal(ks[7], (N_HG_LAYERS, HG_WIDTH), f32),
        "hg_w_out": HG_WIDTH ** -0.5 * jax.random.normal(ks[8], (N_HG_LAYERS, HG_WIDTH, D), f32),
        "fx_w_in": D ** -0.5 * jax.random.normal(ks[9], (N_FX_LAYERS, D, FX_IN), f32),
        "fx_b_f": jax.random.uniform(ks[10], (N_FX_LAYERS, FX_HEADS), f32, 1.0, 5.0),
        "fx_q_g": 1.0 + 0.05 * jax.random.normal(ks[11], (N_FX_LAYERS, FX_HD), f32),
        "fx_k_g": 1.0 + 0.05 * jax.random.normal(ks[12], (N_FX_LAYERS, FX_HD), f32),
        "fx_w_out": FX_WIDTH ** -0.5 * jax.random.normal(ks[13], (N_FX_LAYERS, FX_WIDTH, D), f32),
    }


def reference(x, c, norm_g, ada_w, ada_b, hg_lb_logits, hg_w_in, hg_o_g, hg_w_out,
              fx_w_in, fx_b_f, fx_q_g, fx_k_g, fx_w_out):
    lb_all = jnp.cumsum(jax.nn.softmax(hg_lb_logits.astype(jnp.float32), axis=0), axis=0)
    lb_all = lb_all - lb_all[0:1]
    c_act = jax.nn.silu(c)
    for layer in range(DEPTH):
        mod = c_act @ ada_w[layer] + ada_b[layer]
        shift, scale, gate = jnp.split(mod, 3, axis=-1)
        h = _rms(x, norm_g[layer]) * (1.0 + scale[:, None, :]) + shift[:, None, :]
        j = layer // N_MIXERS
        if layer % N_MIXERS == 0:
            y = _hgrn2_layer(h, hg_w_in[j], lb_all[j], hg_o_g[j], hg_w_out[j])
        else:
            y = _fox_layer(h, fx_w_in[j], fx_b_f[j], fx_q_g[j], fx_k_g[j], fx_w_out[j])
        x = x + gate[:, None, :] * y
    return x
```

```cpp
#include <hip/hip_runtime.h>
#include <hip/hip_bf16.h>
#include <cstdio>
#include <cstdint>
#include <cmath>
#ifndef MK_ONE_LAUNCH
#define MK_ONE_LAUNCH 0
#endif
constexpr int BATCH = 8, SEQ = 4096, DM = 1024, M = BATCH * SEQ, DEPTH = 4;
constexpr int HG_H = 8, HG_DK = 128, HG_IN = 4096;
constexpr int FX_H = 16, FX_HD = 64, FX_IN = 4112, FX_INP = 4352;
constexpr float EPS = 1e-6f;
constexpr float LOG2E = 1.4426950408889634f;
constexpr float C2 = 0.125f * LOG2E;

namespace pg8 {
#define PG8_LAS __attribute__((address_space(3)))
typedef unsigned short bf16_t;
typedef short bf16x8 __attribute__((ext_vector_type(8)));
typedef float f32x4 __attribute__((ext_vector_type(4)));
typedef unsigned u32x4 __attribute__((ext_vector_type(4)));
constexpr int BM = 256, BK = 64, HALF = 128, HTB = HALF * BK * 2  , STAGE_BYTES = 8 * HTB, NXCD = 8, WGM = 8;

__host__ __device__ __forceinline__ int lds_byte(int r, int c) { const int st = (r >> 4) * 2 + (c >> 5), rr = r & 15, cc = c & 31, ob = rr * 64 + cc * 2; return st * 1024 + (ob ^ (((ob >> 9) & 1) << 5)); }
__host__ __device__ __forceinline__ void stage_rc(int b, int& R, int& C) { const int st = b / 1024, sb = b % 1024, swz = sb ^ (((sb >> 9) & 1) << 5); R = (st >> 1) * 16 + swz / 64; C = (st & 1) * 32 + (swz % 64) / 2; }
__host__ __device__ __forceinline__ int perm32(int rho) { const int n = rho >> 4, i = rho & 15; return 8 * (i >> 2) + 4 * n + (i & 3); }

struct Unit { int pm, pn; };
struct Gemm { const bf16_t* A; const bf16_t* Bt; int M, N, K; };

struct StaticOrder {
    int nM, nN, nwg, G, c;
    __host__ __device__ void init(int M, int N, int G_, int c_) { nM = M / BM; nN = N / BM; nwg = nM * nN; G = G_; c = c_; }
    __host__ __device__ bool next(int i, Unit& u) const {
        const long L = (long)i * G + c; if (L >= nwg) return false;
        int wgid = (int)L; { const int q = nwg / NXCD, r = nwg % NXCD, xcd = wgid % NXCD, off = wgid / NXCD; wgid = (xcd < r ? xcd * (q + 1) : r * (q + 1) + (xcd - r) * q) + off; }
        const int nig = WGM * nN, gid = wgid / nig, fm = gid * WGM, gsz = (nM - fm) < WGM ? (nM - fm) : WGM;
        u.pm = fm + ((wgid % nig) % gsz); u.pn = (wgid % nig) / gsz; return true;
    }
    __device__ __forceinline__ void a_ready(const Unit&) const {}
    __device__ __forceinline__ void done(const Unit&) const {}
};
template <class Epi, class Sched, bool ALIGN_EPI = false, bool SP2 = false>
__device__ __forceinline__ void gemm_phase(PG8_LAS unsigned char* lds, const Gemm g, const Sched& S, const Epi& E) {
    const int tid = threadIdx.x, wid = __builtin_amdgcn_readfirstlane(tid >> 6), lane = tid & 63, wr = wid >> 2, wc = wid & 3, fr = lane & 15, fq = lane >> 4;
    const int K = g.K, nt = K / BK;
    unsigned voffA[2], voffB[2];
#pragma unroll
    for (int i = 0; i < 2; ++i) { int R, C; stage_rc(tid * 16 + i * 8192, R, C); const int Rb = Epi::PMODE == 2 ? (64 * (R >> 5) + perm32(R & 31)) : (Epi::PMODE == 1 ? ((R & ~31) + perm32(R & 31)) : R);
        voffA[i] = (unsigned)(R * K + C) * 2u; voffB[i] = (unsigned)(Rb * K + C) * 2u; }
    const size_t kstep = (size_t)(BK * 2);
    const size_t hstep = (size_t)HALF * K * 2;
    const size_t hstepB = (Epi::PMODE == 2) ? (size_t)32 * K * 2 : hstep;
    const size_t tstep = 2 * hstep;
    const unsigned ldsw = (unsigned)wid * 1024u;
    const int aoff = lds_byte(wr * 64 + fr, fq * 8), boff = lds_byte(wc * 32 + fr, fq * 8);
#define PG8_SA(b, h) (((b) * 2 + (h)) * HTB)
#define PG8_SB(b, h) ((4 + (b) * 2 + (h)) * HTB)
#define PG8_STAGE(bufoff, gbase, voff) do { _Pragma("unroll") for (int _i = 0; _i < 2; ++_i) \
        __builtin_amdgcn_global_load_lds((const unsigned*)((const char*)(gbase) + (voff)[_i]), (PG8_LAS unsigned*)(lds + (bufoff) + ldsw + _i * 8192), 16, 0, 0); } while (0)
#define PG8_LDA(dst, b, h) do { _Pragma("unroll") for (int m = 0; m < 4; ++m) _Pragma("unroll") for (int k = 0; k < 2; ++k) dst[m][k] = *(const PG8_LAS bf16x8*)(lds + PG8_SA(b, h) + aoff + m * 2048 + k * 1024); } while (0)
#define PG8_LDB(dst, b, h) do { _Pragma("unroll") for (int n = 0; n < 2; ++n) _Pragma("unroll") for (int k = 0; k < 2; ++k) dst[n][k] = *(const PG8_LAS bf16x8*)(lds + PG8_SB(b, h) + boff + n * 2048 + k * 1024); } while (0)
#define PG8_MMA(ai, bj, At, Bt) do { __builtin_amdgcn_s_setprio(1); _Pragma("unroll") for (int m = 0; m < 4; ++m) _Pragma("unroll") for (int n = 0; n < 2; ++n) _Pragma("unroll") for (int k = 0; k < 2; ++k) \
        acc[ai][bj][m][n] = __builtin_amdgcn_mfma_f32_16x16x32_bf16(Bt[n][k], At[m][k], acc[ai][bj][m][n], 0, 0, 0); __builtin_amdgcn_s_setprio(0); } while (0)
#define PG8_WAIT_V(n) asm volatile("s_waitcnt vmcnt(" #n ")" ::: "memory")
#define PG8_WAIT_L(n) asm volatile("s_waitcnt lgkmcnt(" #n ")" ::: "memory")
#define PG8_BAR __builtin_amdgcn_s_barrier()
#define PG8_SCHED __builtin_amdgcn_sched_barrier(0)
    Unit cur, nxt; int ui = 0;
    if (!S.next(0, cur)) return;
    f32x4 acc[2][2][4][2];
#pragma unroll
    for (int a = 0; a < 2; ++a)
#pragma unroll
        for (int b = 0; b < 2; ++b)
#pragma unroll
            for (int m = 0; m < 4; ++m)
#pragma unroll
                for (int n = 0; n < 2; ++n) acc[a][b][m][n] = (f32x4){0.f, 0.f, 0.f, 0.f};
    bf16x8 At[4][2], B0[2][2], B1[2][2];
    const char* cA = (const char*)g.A + (size_t)cur.pm * tstep; const char* cB = (const char*)g.Bt + (size_t)cur.pn * tstep;
    S.a_ready(cur);
    if constexpr (SP2) {
        PG8_STAGE(PG8_SB(0, 0), cB, voffB); PG8_STAGE(PG8_SB(0, 1), cB + hstepB, voffB); PG8_STAGE(PG8_SA(0, 0), cA, voffA); PG8_STAGE(PG8_SA(0, 1), cA + hstep, voffA);
        if (wr == 1) PG8_BAR;
        PG8_WAIT_V(2); PG8_BAR;
        PG8_STAGE(PG8_SB(1, 0), cB + kstep, voffB); PG8_STAGE(PG8_SA(1, 0), cA + kstep, voffA); PG8_STAGE(PG8_SB(1, 1), cB + hstepB + kstep, voffB);
        PG8_WAIT_V(6); PG8_BAR;
    } else {
        PG8_STAGE(PG8_SB(0, 0), cB, voffB); PG8_STAGE(PG8_SA(0, 0), cA, voffA); PG8_STAGE(PG8_SB(0, 1), cB + hstepB, voffB); PG8_STAGE(PG8_SA(0, 1), cA + hstep, voffA);
        if (wr == 1) PG8_BAR;
        PG8_WAIT_V(4); PG8_BAR;
        PG8_STAGE(PG8_SB(1, 0), cB + kstep, voffB); PG8_STAGE(PG8_SA(1, 0), cA + kstep, voffA); PG8_STAGE(PG8_SB(1, 1), cB + hstepB + kstep, voffB);
        PG8_WAIT_V(6); PG8_BAR;
    }
    for (;;) {
        const bool has_next = S.next(ui + 1, nxt);
        const char* nA = has_next ? (const char*)g.A + (size_t)nxt.pm * tstep : cA; const char* nB = has_next ? (const char*)g.Bt + (size_t)nxt.pn * tstep : cB;
        for (int t = 0; t < nt; t += 2) {
            const bool last = (t == nt - 2);
            const char* a1 = cA + (size_t)(t + 1) * kstep;
            const char* a2 = last ? nA : cA + (size_t)(t + 2) * kstep; const char* b2 = last ? nB : cB + (size_t)(t + 2) * kstep;
            const char* a3 = a2 + kstep; const char* b3 = b2 + kstep;
            if (last && has_next) S.a_ready(nxt);
            if constexpr (SP2) {
            PG8_LDB(B0, 0, 0); PG8_LDB(B1, 0, 1); PG8_SCHED; PG8_LDA(At, 0, 0); PG8_STAGE(PG8_SA(1, 1), a1 + hstep, voffA);
            PG8_WAIT_V(8); PG8_WAIT_L(0); PG8_BAR; PG8_MMA(0, 0, At, B0); PG8_MMA(0, 1, At, B1); PG8_BAR; PG8_SCHED;
            PG8_LDA(At, 0, 1); PG8_STAGE(PG8_SB(0, 0), b2, voffB); PG8_STAGE(PG8_SB(0, 1), b2 + hstepB, voffB); PG8_STAGE(PG8_SA(0, 0), a2, voffA);
            PG8_WAIT_V(8); PG8_WAIT_L(0); PG8_BAR; PG8_MMA(1, 0, At, B0); PG8_MMA(1, 1, At, B1); PG8_BAR; PG8_SCHED;
            PG8_LDB(B0, 1, 0); PG8_LDB(B1, 1, 1); PG8_SCHED; PG8_LDA(At, 1, 0); PG8_STAGE(PG8_SA(0, 1), a2 + hstep, voffA);
            PG8_WAIT_V(8); PG8_WAIT_L(0); PG8_BAR; PG8_MMA(0, 0, At, B0); PG8_MMA(0, 1, At, B1); PG8_BAR; PG8_SCHED;
            PG8_LDA(At, 1, 1); PG8_STAGE(PG8_SB(1, 0), b3, voffB); PG8_STAGE(PG8_SB(1, 1), b3 + hstepB, voffB); PG8_STAGE(PG8_SA(1, 0), a3, voffA);
            PG8_WAIT_V(8); PG8_WAIT_L(0); PG8_BAR; PG8_MMA(1, 0, At, B0); PG8_MMA(1, 1, At, B1); PG8_BAR; PG8_SCHED;
            } else {
            PG8_LDB(B0, 0, 0); PG8_SCHED; PG8_LDA(At, 0, 0); PG8_STAGE(PG8_SA(1, 1), a1 + hstep, voffA);
            PG8_WAIT_L(8); PG8_BAR; PG8_WAIT_L(0); PG8_MMA(0, 0, At, B0); PG8_BAR; PG8_SCHED;
            PG8_LDB(B1, 0, 1); PG8_STAGE(PG8_SB(0, 0), b2, voffB);
            PG8_BAR; PG8_WAIT_L(0); PG8_MMA(0, 1, At, B1); PG8_BAR;
            PG8_LDA(At, 0, 1); PG8_STAGE(PG8_SA(0, 0), a2, voffA);
            PG8_BAR; PG8_WAIT_L(0); PG8_MMA(1, 0, At, B0); PG8_BAR; PG8_SCHED;
            PG8_STAGE(PG8_SB(0, 1), b2 + hstepB, voffB);
            PG8_WAIT_V(6); PG8_BAR; PG8_MMA(1, 1, At, B1); PG8_BAR;
            PG8_LDB(B0, 1, 0); PG8_SCHED; PG8_LDA(At, 1, 0); PG8_STAGE(PG8_SA(0, 1), a2 + hstep, voffA);
            PG8_WAIT_L(8); PG8_BAR; PG8_WAIT_L(0); PG8_MMA(0, 0, At, B0); PG8_BAR; PG8_SCHED;
            PG8_LDB(B1, 1, 1); PG8_STAGE(PG8_SB(1, 0), b3, voffB);
            PG8_BAR; PG8_WAIT_L(0); PG8_MMA(0, 1, At, B1); PG8_BAR;
            PG8_LDA(At, 1, 1); PG8_STAGE(PG8_SA(1, 0), a3, voffA);
            PG8_BAR; PG8_WAIT_L(0); PG8_MMA(1, 0, At, B0); PG8_BAR; PG8_SCHED;
            PG8_STAGE(PG8_SB(1, 1), b3 + hstepB, voffB);
            PG8_WAIT_V(6); PG8_BAR; PG8_MMA(1, 1, At, B1); PG8_BAR;
            }
        }
        if constexpr (ALIGN_EPI) { if (wr == 0) PG8_BAR; }
        if constexpr (!Epi::AFTER_DRAIN) { E(acc, cur, wr, wc, fr, fq); S.done(cur); }
        if (!has_next) break;
#pragma unroll
        for (int a = 0; a < 2; ++a)
#pragma unroll
            for (int b = 0; b < 2; ++b)
#pragma unroll
                for (int m = 0; m < 4; ++m)
#pragma unroll
                    for (int n = 0; n < 2; ++n) acc[a][b][m][n] = (f32x4){0.f, 0.f, 0.f, 0.f};
        cur = nxt; cA = nA; cB = nB; ++ui;
        if constexpr (ALIGN_EPI) { if (wr == 1) PG8_BAR; }
    }
    PG8_WAIT_V(0);
    if constexpr (!ALIGN_EPI) { if (wr == 0) PG8_BAR; }
    PG8_BAR;
    if constexpr (Epi::AFTER_DRAIN) { E.fused(acc, cur, wr, wc, fr, fq, lds, wid, lane); S.done(cur); }
#undef PG8_SA
#undef PG8_SB
#undef PG8_STAGE
#undef PG8_LDA
#undef PG8_LDB
#undef PG8_MMA
#undef PG8_WAIT_V
#undef PG8_WAIT_L
#undef PG8_BAR
#undef PG8_SCHED
}
}

#ifndef PG8_SP2
#define PG8_SP2 true
#endif
#ifndef PG8_ALIGN
#define PG8_ALIGN true
#endif
constexpr size_t MiB = 1u << 20;
constexpr size_t WS_CTL = 0, CTL_ZERO_BYTES = 1 * MiB;
constexpr size_t WS_ROWSS = 65536;
constexpr size_t WS_WIN = 4 * MiB, WIN_STRIDE = 10 * MiB;
constexpr size_t WS_WOUT = 44 * MiB, WOUT_STRIDE = 2 * MiB;
constexpr size_t WS_XS = 64 * MiB;
constexpr size_t WS_B0 = 128 * MiB, BUF_STRIDE = 64 * MiB;
constexpr size_t WS_AO = 384 * MiB;
constexpr size_t WS_MISC = 448 * MiB;
constexpr size_t WS_GS = WS_MISC, WS_SH = WS_MISC + 128 * 1024, WS_GATE = WS_MISC + 256 * 1024, WS_LB = WS_MISC + 384 * 1024;
constexpr size_t WS_PAR = WS_MISC + 400 * 1024;
constexpr size_t WS_BIAS = WS_MISC + 1 * MiB;
constexpr size_t WS_LF = WS_MISC + 2 * MiB;
constexpr size_t WS_CKL = WS_MISC + 4 * MiB;
constexpr size_t WS_KX = WS_MISC + 6 * MiB;
constexpr size_t WS_SLOC = WS_MISC + 16 * MiB;
constexpr size_t WS_DTOT = WS_MISC + 32 * MiB;
constexpr size_t WS_END = WS_MISC + 34 * MiB;
constexpr int CW_TMO = 0, CW_CODE = 1, CW_BAR = 4096;
constexpr int BIAS_LD = FX_INP;

constexpr int RING_OFF = 0, RING_BYTES = 131072;
constexpr int LDSCTL_OFF = RING_BYTES, MISC_OFF = LDSCTL_OFF + 320;
constexpr int LDS_BYTES = 147456;
constexpr int NWAVES = 8;

namespace pg8 {
__device__ __forceinline__ unsigned cvt_pk_bf16(float lo, float hi) { unsigned r; asm volatile("v_cvt_pk_bf16_f32 %0, %1, %2" : "=v"(r) : "v"(lo), "v"(hi)); return r; }
typedef _Float16 f16x2 __attribute__((ext_vector_type(2)));
__device__ __forceinline__ unsigned cvt_pk_f16(float lo, float hi) { f16x2 v = {(_Float16)lo, (_Float16)hi}; return __builtin_bit_cast(unsigned, v); }
__device__ __forceinline__ float fast_sigmoid(float v) { return __builtin_amdgcn_rcpf(1.0f + __expf(-v)); }
__device__ __forceinline__ float log_sigmoid(float v) { return fminf(v, 0.f) - __logf(1.0f + __expf(-fabsf(v))); }

struct EpiIn {
    static constexpr int PMODE = 2; static constexpr bool AFTER_DRAIN = false;
    unsigned char* ws; int l;
    __device__ __forceinline__ void operator()(const f32x4 (&acc)[2][2][4][2], const Unit& u, int wr_, int wc_, int fr_, int fq_) const {
        unsigned char* w = ws; int wr = wr_, wc = wc_, fr = fr_, fq = fq_, ll = l;
        asm volatile("" : "+s"(w), "+s"(ll), "+s"(wr), "+s"(wc), "+v"(fr), "+v"(fq));
        const int kind = ll & 1, jj = ll >> 1;
        const float* rowss = (const float*)(w + WS_ROWSS) + (size_t)ll * M;
        const int nb = BIAS_LD; const float* bias = (const float*)(w + WS_BIAS) + (size_t)ll * 8 * BIAS_LD;
        bf16_t* obase = (bf16_t*)(w + WS_B0); const size_t ostride = BUF_STRIDE / 2;
        const float* lb = (kind == 0 && jj > 0) ? (const float*)(w + WS_LB) + jj * 1024 : nullptr;
        const float* qg = (const float*)(w + WS_PAR) + jj * 64; const float* kg = (const float*)(w + WS_PAR) + 128 + jj * 64; const float* bfg = (const float*)(w + WS_PAR) + 256 + jj * 16;
        float* lf = (float*)(w + WS_LF);
        const int t = u.pn >> 2, b = u.pm >> 4;
        const int crel = 64 * wc + 8 * fq, gcol0 = u.pn * 256 + crel, ocol0 = (u.pn & 3) * 256 + crel;
        f32x4 bv[2][2], pv[2][2];
#pragma unroll
        for (int bj = 0; bj < 2; ++bj)
#pragma unroll
            for (int n = 0; n < 2; ++n) {
                bv[bj][n] = *(const f32x4*)(bias + (size_t)b * nb + gcol0 + 32 * bj + 4 * n);
                pv[bj][n] = (f32x4){0.f, 0.f, 0.f, 0.f};
                if (kind == 0) { if (t == 1 && lb) pv[bj][n] = *(const f32x4*)(lb + ocol0 + 32 * bj + 4 * n); }
                else { if (t == 0) pv[bj][n] = *(const f32x4*)(qg + 32 * bj + 8 * fq + 4 * n) * C2; else if (t == 1) pv[bj][n] = *(const f32x4*)(kg + 32 * bj + 8 * fq + 4 * n); }
            }
        bf16_t* ob = obase + (size_t)(t & 3) * ostride;
#pragma unroll
        for (int ai = 0; ai < 2; ++ai)
#pragma unroll
            for (int m = 0; m < 4; ++m) {
                const int row = u.pm * 256 + ai * 128 + wr * 64 + m * 16 + fr;
                const float rstd = rsqrtf(rowss[row] * (1.0f / 1024.0f) + EPS);
                f32x4 v[2][2];
#pragma unroll
                for (int bj = 0; bj < 2; ++bj)
#pragma unroll
                    for (int n = 0; n < 2; ++n) v[bj][n] = acc[ai][bj][m][n] * rstd + bv[bj][n];
                if (kind == 1 && t == 4) {
                    if (wc == 0 && fq < 2) {
#pragma unroll
                        for (int n = 0; n < 2; ++n) { const f32x4 bb = *(const f32x4*)(bfg + 8 * fq + 4 * n); f32x4 o;
#pragma unroll
                            for (int e = 0; e < 4; ++e) o[e] = log_sigmoid(v[0][n][e] + bb[e]);
                            *(f32x4*)(lf + (size_t)row * 16 + 8 * fq + 4 * n) = o; }
                    }
                    continue;
                }
                bool half16 = false;
                if (kind == 0) {
                    if (t == 1) {
                        half16 = true;
#pragma unroll
                        for (int bj = 0; bj < 2; ++bj)
#pragma unroll
                            for (int n = 0; n < 2; ++n)
#pragma unroll
                                for (int e = 0; e < 4; ++e) { const float fl = v[bj][n][e];
                                    v[bj][n][e] = lb ? __logf(pv[bj][n][e] + (1.0f - pv[bj][n][e]) * fast_sigmoid(fl)) : log_sigmoid(fl); }
                    } else if (t == 3) {
#pragma unroll
                        for (int bj = 0; bj < 2; ++bj)
#pragma unroll
                            for (int n = 0; n < 2; ++n)
#pragma unroll
                                for (int e = 0; e < 4; ++e) { const float z = v[bj][n][e]; v[bj][n][e] = z * fast_sigmoid(z); }
                    }
                } else {
                    if (t <= 1) {
                        float ss = 0.f;
#pragma unroll
                        for (int bj = 0; bj < 2; ++bj)
#pragma unroll
                            for (int n = 0; n < 2; ++n) { const f32x4 x = v[bj][n]; ss += (x[0] * x[0] + x[1] * x[1]) + (x[2] * x[2] + x[3] * x[3]); }
                        ss += __shfl_xor(ss, 16); ss += __shfl_xor(ss, 32);
                        const float rn = rsqrtf(ss * (1.0f / 64.0f) + EPS);
#pragma unroll
                        for (int bj = 0; bj < 2; ++bj)
#pragma unroll
                            for (int n = 0; n < 2; ++n) v[bj][n] = v[bj][n] * rn * pv[bj][n];
                    } else if (t == 3) {
#pragma unroll
                        for (int bj = 0; bj < 2; ++bj)
#pragma unroll
                            for (int n = 0; n < 2; ++n)
#pragma unroll
                                for (int e = 0; e < 4; ++e) { const float z = v[bj][n][e]; v[bj][n][e] = z * fast_sigmoid(z); }
                    }
                }
                bf16_t* rowp = ob + (size_t)row * 1024 + ocol0;
#pragma unroll
                for (int bj = 0; bj < 2; ++bj) { u32x4 w;
                    if (half16) { w.x = cvt_pk_f16(v[bj][0][0], v[bj][0][1]); w.y = cvt_pk_f16(v[bj][0][2], v[bj][0][3]); w.z = cvt_pk_f16(v[bj][1][0], v[bj][1][1]); w.w = cvt_pk_f16(v[bj][1][2], v[bj][1][3]); }
                    else { w.x = cvt_pk_bf16(v[bj][0][0], v[bj][0][1]); w.y = cvt_pk_bf16(v[bj][0][2], v[bj][0][3]); w.z = cvt_pk_bf16(v[bj][1][0], v[bj][1][1]); w.w = cvt_pk_bf16(v[bj][1][2], v[bj][1][3]); }
                    *(u32x4*)(rowp + 32 * bj) = w; }
            }
    }
};

struct EpiOut {
    static constexpr int PMODE = 1; static constexpr bool AFTER_DRAIN = false;
    unsigned char* ws; const float* x0; float* xo; int l;
    __device__ __forceinline__ void operator()(const f32x4 (&acc)[2][2][4][2], const Unit& u, int wr_, int wc_, int fr_, int fq_) const {
        unsigned char* w = ws; int wr = wr_, wc = wc_, fr = fr_, fq = fq_, ll = l; const float* xin = (l == 0) ? x0 : xo; float* xout = xo;
        asm volatile("" : "+s"(w), "+s"(ll), "+s"(wr), "+s"(wc), "+v"(fr), "+v"(fq), "+s"(xin), "+s"(xout));
        const float* gate = (const float*)(w + WS_GATE) + (size_t)ll * 8 * 1024;
        const float* gsn = (ll + 1 < DEPTH) ? (const float*)(w + WS_GS) + (size_t)(ll + 1) * 8 * 1024 : nullptr;
        bf16_t* xs = (bf16_t*)(w + WS_XS); float* rowssn = (float*)(w + WS_ROWSS) + (size_t)(ll + 1 < DEPTH ? ll + 1 : 0) * M;
        const int b = u.pm >> 4, col0 = u.pn * 256 + 32 * wc + 8 * fq;
        f32x4 gv[2][2], sv[2][2];
#pragma unroll
        for (int bj = 0; bj < 2; ++bj)
#pragma unroll
            for (int n = 0; n < 2; ++n) { gv[bj][n] = *(const f32x4*)(gate + b * 1024 + col0 + 128 * bj + 4 * n);
                sv[bj][n] = gsn ? *(const f32x4*)(gsn + b * 1024 + col0 + 128 * bj + 4 * n) : (f32x4){0.f, 0.f, 0.f, 0.f}; }
#pragma unroll
        for (int ai = 0; ai < 2; ++ai)
#pragma unroll
            for (int m = 0; m < 4; ++m) {
                const int row = u.pm * 256 + ai * 128 + wr * 64 + m * 16 + fr; float ss = 0.f;
#pragma unroll
                for (int bj = 0; bj < 2; ++bj) { const size_t off = (size_t)row * 1024 + col0 + 128 * bj;
                    const f32x4 y0 = *(const f32x4*)(xin + off) + gv[bj][0] * acc[ai][bj][m][0], y1 = *(const f32x4*)(xin + off + 4) + gv[bj][1] * acc[ai][bj][m][1];
                    *(f32x4*)(xout + off) = y0; *(f32x4*)(xout + off + 4) = y1;
                    ss += (y0[0] * y0[0] + y0[1] * y0[1]) + (y0[2] * y0[2] + y0[3] * y0[3]) + (y1[0] * y1[0] + y1[1] * y1[1]) + (y1[2] * y1[2] + y1[3] * y1[3]);
                    if (gsn) { const f32x4 a0 = y0 * sv[bj][0], a1 = y1 * sv[bj][1]; u32x4 w; w.x = cvt_pk_bf16(a0[0], a0[1]); w.y = cvt_pk_bf16(a0[2], a0[3]); w.z = cvt_pk_bf16(a1[0], a1[1]); w.w = cvt_pk_bf16(a1[2], a1[3]);
                        *(u32x4*)(xs + off) = w; } }
                if (gsn) { ss += __shfl_xor(ss, 16); ss += __shfl_xor(ss, 32); if (fq == 0) atomicAdd(rowssn + row, ss); }
            }
    }
};
}
#define GAS __attribute__((address_space(1)))
#define LAS __attribute__((address_space(3)))
typedef unsigned short bf16;
typedef unsigned v4u __attribute__((ext_vector_type(4)));
typedef float f32x4 __attribute__((ext_vector_type(4)));
typedef short bf16x8 __attribute__((ext_vector_type(8)));
typedef GAS unsigned gu32;
typedef GAS unsigned long long gu64;
#define RLX_AGENT __ATOMIC_RELAXED, __HIP_MEMORY_SCOPE_AGENT
#define LDS_WAIT() asm volatile("s_waitcnt lgkmcnt(0)" ::: "memory")
#define VM_WAIT() asm volatile("s_waitcnt vmcnt(0)" ::: "memory")
__device__ __forceinline__ unsigned long long rt() { return __builtin_amdgcn_s_memrealtime(); }
__device__ __forceinline__ unsigned f2bf(float f) { unsigned u = __builtin_bit_cast(unsigned, f); return (u + 0x7fffu + ((u >> 16) & 1u)) >> 16; }
__device__ __forceinline__ unsigned pk2(float lo, float hi) { return f2bf(lo) | (f2bf(hi) << 16); }
#define XB_TMO      128
#define XB_XCNT(j)  (256  + 64 * (j))
#define XB_XSUB(j)  (1280 + 64 * (j))
#define XB_XGEN(j)  (2304 + 64 * (j))
#define XB_TOP      3328
#define XB_TOPGEN   3392
#define XCD_BAR_WORDS 3456
#define XB_SPIN_CAP (1u << 18)

__device__ __forceinline__ unsigned xb_ld(unsigned* p)              { return __hip_atomic_load(p, __ATOMIC_RELAXED, __HIP_MEMORY_SCOPE_AGENT); }
__device__ __forceinline__ unsigned xb_add(unsigned* p, unsigned v) { return __hip_atomic_fetch_add(p, v, __ATOMIC_RELAXED, __HIP_MEMORY_SCOPE_AGENT); }
__device__ __forceinline__ unsigned xb_xcc_id() { return (unsigned)__builtin_amdgcn_s_getreg((3 << 11) | 20) & 0xFu; }
#define XB_SPIN(cond, bar) do { unsigned _sp = 0; while (cond) { __builtin_amdgcn_s_sleep(1); \
    if ((++_sp & 255u) == 0u) { if (xb_ld(&(bar)[XB_TMO])) break; if (_sp > XB_SPIN_CAP) { atomicAdd(&(bar)[XB_TMO], 1u); break; } } } } while (0)

struct XcdBarrier {
    unsigned* bar; unsigned x;
    volatile LAS unsigned* st;
};

__device__ __forceinline__ XcdBarrier xcd_barrier_post(unsigned* bar, volatile LAS unsigned* st) {
    XcdBarrier b; b.bar = bar; b.x = xb_xcc_id(); b.st = st;
    if (threadIdx.x == 0) (void)xb_add(&bar[XB_XCNT(b.x)], 1u);
    return b;
}
__device__ __forceinline__ void xcd_barrier_complete(unsigned* bar, unsigned x, unsigned& nloc, unsigned& nx) {
    const unsigned G = gridDim.x * gridDim.y * gridDim.z;
    unsigned sum, cnt, mine, sp = 0u;
    for (;;) {
        sum = 0u; cnt = 0u; mine = 0u;
#pragma unroll
        for (unsigned j = 0; j < 16; ++j) { const unsigned c = xb_ld(&bar[XB_XCNT(j)]); sum += c; cnt += (c > 0u) ? 1u : 0u; mine = (j == x) ? c : mine; }
        if (sum == G) break;
        __builtin_amdgcn_s_sleep(1);
        if ((++sp & 255u) == 0u) { if (xb_ld(&bar[XB_TMO])) break; if (sp > XB_SPIN_CAP) { atomicAdd(&bar[XB_TMO], 1u); break; } }
    }
    nloc = mine > 0u ? mine : 1u; nx = cnt > 0u ? cnt : 1u;
}

__device__ __forceinline__ void xcd_barrier(const XcdBarrier& b) {
    asm volatile("s_waitcnt vmcnt(0)" ::: "memory");
    __syncthreads();
    if (threadIdx.x == 0) {
        unsigned* bar = b.bar;
        __builtin_amdgcn_s_waitcnt(0);
        unsigned nloc = b.st[0], nx = b.st[1];
        if (nloc == 0u) { xcd_barrier_complete(bar, b.x, nloc, nx); b.st[0] = nloc; b.st[1] = nx; }
        const unsigned old = xb_add(&bar[XB_XSUB(b.x)], 1u);
        const unsigned gen = old / nloc;
        if (old + 1u == (gen + 1u) * nloc) {
            __builtin_amdgcn_fence(__ATOMIC_RELEASE, "agent");
            asm volatile("s_waitcnt vmcnt(0)" ::: "memory");
            const unsigned og = xb_add(&bar[XB_TOP], 1u);
            const unsigned tg = og / nx;
            if (og + 1u == (tg + 1u) * nx) xb_add(&bar[XB_TOPGEN], 1u);
            else XB_SPIN(xb_ld(&bar[XB_TOPGEN]) == tg, bar);
            __builtin_amdgcn_fence(__ATOMIC_ACQUIRE, "agent");
            xb_add(&bar[XB_XGEN(b.x)], 1u);
            asm volatile("s_waitcnt vmcnt(0)" ::: "memory");
        } else {
            XB_SPIN(xb_ld(&bar[XB_XGEN(b.x)]) == gen, bar);
            __builtin_amdgcn_fence(__ATOMIC_ACQUIRE, "agent");
            asm volatile("s_waitcnt vmcnt(0)" ::: "memory");
        }
    }
    __syncthreads();
}
__device__ __forceinline__ float wave_sum(float v) {
#pragma unroll
    for (int o = 1; o < 64; o <<= 1) v += __shfl_xor(v, o);
    return v;
}
__device__ __forceinline__ void p0_transpose_item(const float* W, int K, int N, bf16* WT, int row_off, LAS float* scr, int item, int lane) {
    const int nblk = N / 32, kb = item / nblk, nb = item % nblk, k0 = 64 * kb, n0 = 32 * nb;
#pragma unroll 8
    for (int i = 0; i < 32; ++i) { const int kk = 2 * i + (lane >> 5); scr[kk * 33 + (lane & 31)] = W[(size_t)(k0 + kk) * N + n0 + (lane & 31)]; }
    LDS_WAIT(); asm volatile("" ::: "memory");
    const int c = lane & 7;
#pragma unroll
    for (int j = 0; j < 4; ++j) { const int n = (lane >> 3) + 8 * j; const LAS float* s = scr + (8 * c) * 33 + n;
        v4u o; o.x = pk2(s[0 * 33], s[1 * 33]); o.y = pk2(s[2 * 33], s[3 * 33]); o.z = pk2(s[4 * 33], s[5 * 33]); o.w = pk2(s[6 * 33], s[7 * 33]);
        *(GAS v4u*)(WT + (size_t)(row_off + n0 + n) * K + k0 + 8 * c) = o; }
    LDS_WAIT(); asm volatile("" ::: "memory");
}
struct Frame {
    LAS unsigned char* lds; volatile LAS unsigned* MISC; gu32* ctl;
    int tid, lane, wave, G;
    unsigned char* ws;
};
#define relaunder(F) do { int t_ = threadIdx.x; asm volatile("" : "+v"(t_)); (F).tid = t_; (F).lane = t_ & 63; (F).wave = __builtin_amdgcn_readfirstlane(t_ >> 6); } while (0)
typedef _Float16 half_t;
__device__ __forceinline__ float bf2f(unsigned short h) { return __builtin_bit_cast(float, (unsigned)h << 16); }
__device__ __forceinline__ float bflo(unsigned w) { return __builtin_bit_cast(float, w << 16); }
__device__ __forceinline__ float bfhi(unsigned w) { return __builtin_bit_cast(float, w & 0xffff0000u); }

__device__ __forceinline__ void p0_transpose_item2(const float* W, int K, int N, bf16* WT, LAS float* scr, int kb, int n0, int nvalid, int lane) {
    const int k0 = 64 * kb;
#pragma unroll 8
    for (int i = 0; i < 32; ++i) { const int kk = 2 * i + (lane >> 5); const int nn = lane & 31; scr[kk * 33 + nn] = (nn < nvalid) ? W[(size_t)(k0 + kk) * N + n0 + nn] : 0.f; }
    LDS_WAIT(); asm volatile("" ::: "memory");
    const int c = lane & 7;
#pragma unroll
    for (int j = 0; j < 4; ++j) { const int n = (lane >> 3) + 8 * j; const LAS float* s = scr + (8 * c) * 33 + n;
        v4u o; o.x = pk2(s[0 * 33], s[1 * 33]); o.y = pk2(s[2 * 33], s[3 * 33]); o.z = pk2(s[4 * 33], s[5 * 33]); o.w = pk2(s[6 * 33], s[7 * 33]);
        if (n < nvalid) *(GAS v4u*)(WT + (size_t)(n0 + n) * K + k0 + 8 * c) = o; }
    LDS_WAIT(); asm volatile("" ::: "memory");
}

__device__ __forceinline__ void gemv8_block(Frame& F, const float* Wm, int N, int j0, int ncols, const LAS float* atab, LAS float* part) {
    float a8[8];
#pragma unroll
    for (int b = 0; b < 8; ++b) a8[b] = 0.f;
    const int j = j0 + F.lane; const bool ok = F.lane < ncols;
    const int kbeg = F.wave * 128;
#pragma unroll 4
    for (int kk = 0; kk < 128; ++kk) { const int k = kbeg + kk; const float w = ok ? Wm[(size_t)k * N + j] : 0.f;
        const f32x4 t0 = *(const LAS f32x4*)(atab + k * 8), t1 = *(const LAS f32x4*)(atab + k * 8 + 4);
        a8[0] += t0[0] * w; a8[1] += t0[1] * w; a8[2] += t0[2] * w; a8[3] += t0[3] * w; a8[4] += t1[0] * w; a8[5] += t1[1] * w; a8[6] += t1[2] * w; a8[7] += t1[3] * w; }
#pragma unroll
    for (int b = 0; b < 8; ++b) part[(F.wave * 8 + b) * 64 + F.lane] = a8[b];
}

__device__ __forceinline__ void p0a(Frame& F, const float* const* in) {
    relaunder(F);
    const float* c = in[1]; const float* norm_g = in[2]; const float* ada_w = in[3]; const float* ada_b = in[4]; const float* lbl = in[5];
    const float* hg_w_in = in[6]; const float* hg_w_out = in[8]; const float* fx_w_in = in[9]; const float* fx_w_out = in[13];
    unsigned char* ws = F.ws;
    {
        LAS float* atab = (LAS float*)(F.lds);
        LAS float* part = (LAS float*)(F.lds + 32768);
        for (int e = F.tid; e < 8192; e += 512) { const int b = e >> 10, k = e & 1023; const float v = c[b * 1024 + k]; atab[k * 8 + b] = v / (1.0f + __expf(-v)); }
        __syncthreads();
        for (int it = blockIdx.x; it < 4 * 48; it += F.G) {
            const int l = it / 48, jb = it % 48, j0 = jb * 64;
            gemv8_block(F, ada_w + (size_t)l * 1024 * 3072, 3072, j0, 64, atab, part);
            __syncthreads();
            { const int b = F.tid >> 6, jl = F.tid & 63, j = j0 + jl; float s = ada_b[l * 3072 + j];
#pragma unroll
              for (int w = 0; w < 8; ++w) s += part[(w * 8 + b) * 64 + jl];
              const int sec = j >> 10, cc = j & 1023; const size_t o = ((size_t)l * 8 + b) * 1024 + cc;
              if (sec == 0) ((float*)(ws + WS_SH))[o] = s; else if (sec == 1) ((float*)(ws + WS_GS))[o] = norm_g[l * 1024 + cc] * (1.0f + s); else ((float*)(ws + WS_GATE))[o] = s; }
            __syncthreads();
        }
    }
    if (blockIdx.x == 0) { float* par = (float*)(ws + WS_PAR); for (int e = F.tid; e < 128; e += 512) { par[e] = in[11][e]; par[128 + e] = in[12][e]; } if (F.tid < 32) par[256 + F.tid] = in[10][F.tid]; for (int e = F.tid; e < 2048; e += 512) par[288 + e] = in[7][e]; }
    if (blockIdx.x == F.G - 1) { for (int e = F.tid; e < 1024; e += 512) { const float d = lbl[1024 + e] - lbl[e]; ((float*)(ws + WS_LB))[e] = 0.f; ((float*)(ws + WS_LB))[1024 + e] = 1.0f / (1.0f + __expf(-d)); } }
    {
        __syncthreads();
        LAS float* scr = (LAS float*)(F.lds + F.wave * 16384);
        const int gw = blockIdx.x * NWAVES + F.wave, NGW = F.G * NWAVES;
        constexpr int I_HG = 16 * 128, I_FX = 16 * 129, I_O = 16 * 32;
        constexpr int NIT = 2 * I_HG + 2 * I_FX + 4 * I_O;
        for (int it = gw; it < NIT; it += NGW) {
            int r = it;
            if (r < 2 * I_HG) { const int j = r / I_HG; r %= I_HG; p0_transpose_item2(hg_w_in + (size_t)j * 1024 * HG_IN, 1024, HG_IN, (bf16*)(ws + WS_WIN + (size_t)(2 * j) * WIN_STRIDE), scr, r / 128, (r % 128) * 32, 32, F.lane); continue; }
            r -= 2 * I_HG;
            if (r < 2 * I_FX) { const int j = r / I_FX; r %= I_FX; const int nb = r % 129; p0_transpose_item2(fx_w_in + (size_t)j * 1024 * FX_IN, 1024, FX_IN, (bf16*)(ws + WS_WIN + (size_t)(2 * j + 1) * WIN_STRIDE), scr, r / 129, nb * 32, nb == 128 ? 16 : 32, F.lane); continue; }
            r -= 2 * I_FX;
            { const int l = r / I_O; r %= I_O; const float* src = (l & 1) ? fx_w_out + (size_t)(l >> 1) * 1024 * 1024 : hg_w_out + (size_t)(l >> 1) * 1024 * 1024;
              p0_transpose_item2(src, 1024, 1024, (bf16*)(ws + WS_WOUT + (size_t)l * WOUT_STRIDE), scr, r / 32, (r % 32) * 32, 32, F.lane); }
        }
        for (int e = blockIdx.x * 512 + F.tid; e < 2 * 240 * 128; e += F.G * 512) { const int j = e / (240 * 128), q = e % (240 * 128);
            *(GAS v4u*)((bf16*)(ws + WS_WIN + (size_t)(2 * j + 1) * WIN_STRIDE) + (size_t)FX_IN * 1024 + (size_t)q * 8) = (v4u){0u, 0u, 0u, 0u}; }
    }
}

__device__ __forceinline__ void p0b(Frame& F, const float* const* in) {
    relaunder(F);
    const float* x = in[0]; const float* hg_w_in = in[6]; const float* fx_w_in = in[9];
    unsigned char* ws = F.ws;
    {
        LAS float* atab = (LAS float*)(F.lds);
        LAS float* part = (LAS float*)(F.lds + 32768);
        constexpr int NB_HG = 64, NB_FX = 68;
        for (int it = blockIdx.x; it < 2 * NB_HG + 2 * NB_FX; it += F.G) {
            int l, jb; if (it < 2 * NB_HG) { l = 2 * (it / NB_HG); jb = it % NB_HG; } else { const int r = it - 2 * NB_HG; l = 2 * (r / NB_FX) + 1; jb = r % NB_FX; }
            const bool fx = l & 1; const int N = fx ? FX_IN : HG_IN; const int j0 = jb * 64; const int ncols = (j0 + 64 <= N) ? 64 : (j0 < N ? N - j0 : 0);
            const float* Wm = fx ? fx_w_in + (size_t)(l >> 1) * 1024 * FX_IN : hg_w_in + (size_t)(l >> 1) * 1024 * HG_IN;
            const float* sh = (const float*)(ws + WS_SH) + (size_t)l * 8 * 1024;
            __syncthreads();
            for (int e = F.tid; e < 8192; e += 512) { const int b = e >> 10, k = e & 1023; atab[k * 8 + b] = sh[b * 1024 + k]; }
            __syncthreads();
            gemv8_block(F, Wm, N, j0, ncols, atab, part);
            __syncthreads();
            { const int b = F.tid >> 6, jl = F.tid & 63; float s = 0.f;
#pragma unroll
              for (int w = 0; w < 8; ++w) s += part[(w * 8 + b) * 64 + jl];
              ((float*)(ws + WS_BIAS))[((size_t)l * 8 + b) * BIAS_LD + j0 + jl] = (jl < ncols) ? s : 0.f; }
        }
    }
    {
        const int gw = blockIdx.x * NWAVES + F.wave, NGW = F.G * NWAVES;
        const float* gs = (const float*)(ws + WS_GS);
        float* rowss = (float*)(ws + WS_ROWSS);
        bf16* xs = (bf16*)(ws + WS_XS);
        for (int m = gw; m < M; m += NGW) {
            const int b = m >> 12; const GAS f32x4* xr = (const GAS f32x4*)(x + (size_t)m * 1024) + F.lane; const f32x4* gr = (const f32x4*)(gs + b * 1024) + F.lane;
            GAS unsigned long long* o8 = (GAS unsigned long long*)(xs + (size_t)m * 1024) + F.lane; float s = 0.f;
#pragma unroll
            for (int j = 0; j < 4; ++j) { const f32x4 v = xr[64 * j], g = gr[64 * j]; s += (v.x * v.x + v.y * v.y) + (v.z * v.z + v.w * v.w);
                o8[64 * j] = (unsigned long long)pk2(v.x * g.x, v.y * g.y) | ((unsigned long long)pk2(v.z * g.z, v.w * g.w) << 32); }
            s = wave_sum(s); if (F.lane == 0) rowss[m] = s;
        }
    }
}

__device__ __forceinline__ void fox_cumsum(Frame& F) {
    relaunder(F);
    unsigned char* ws = F.ws; const float* lf = (const float*)(ws + WS_LF); float* ckl = (float*)(ws + WS_CKL); bf16* kx = (bf16*)(ws + WS_KX);
    const int gw = blockIdx.x * NWAVES + F.wave, NGW = F.G * NWAVES;
    for (int bh = gw; bh < 128; bh += NGW) {
        const int b = bh >> 4, h = bh & 15; const float* p = lf + ((size_t)b * SEQ + F.lane * 64) * 16 + h;
        float sum = 0.f;
        for (int i = 0; i < 64; ++i) sum += p[i * 16];
        float incl = sum;
#pragma unroll
        for (int off = 1; off < 64; off <<= 1) { const float t = __shfl_up(incl, off); if (F.lane >= off) incl += t; }
        float run = incl - sum;
        for (int i = 0; i < 64; ++i) { run += p[i * 16]; const float c = run * LOG2E; const size_t s = (size_t)bh * SEQ + F.lane * 64 + i; ckl[s] = c;
            const float xv = -c; const unsigned h0 = f2bf(xv); const float r1 = xv - __builtin_bit_cast(float, h0 << 16); const unsigned h1 = f2bf(r1); const float r2 = r1 - __builtin_bit_cast(float, h1 << 16); const unsigned h2 = f2bf(r2);
            *(GAS v4u*)(kx + s * 8) = (v4u){h0 | (h1 << 16), h2, 0u, 0u}; }
    }
}

__device__ __forceinline__ void attn_naive(Frame& F) {
    relaunder(F);
    unsigned char* ws = F.ws;
    const bf16* Q = (const bf16*)(ws + WS_B0); const bf16* K = (const bf16*)(ws + WS_B0 + BUF_STRIDE); const bf16* V = (const bf16*)(ws + WS_B0 + 2 * BUF_STRIDE); const bf16* Z = (const bf16*)(ws + WS_B0 + 3 * BUF_STRIDE);
    const float* CKL = (const float*)(ws + WS_CKL); bf16* AO = (bf16*)(ws + WS_AO);
    LAS float* Kf = (LAS float*)(F.lds); LAS float* Vf = Kf + 4096; LAS float* ckt = Vf + 4096;
    for (int u = blockIdx.x; u < 1024; u += F.G) {
        const int qblk = 7 - (u >> 7), bh = u & 127, b = bh >> 4, h = bh & 15;
        const int t = qblk * 512 + F.tid; const size_t row = (size_t)b * SEQ + t;
        float q[64], o[64];
#pragma unroll
        for (int c8 = 0; c8 < 8; ++c8) { const v4u w = *(const GAS v4u*)(Q + row * 1024 + h * 64 + c8 * 8);
            q[c8 * 8 + 0] = bflo(w.x); q[c8 * 8 + 1] = bfhi(w.x); q[c8 * 8 + 2] = bflo(w.y); q[c8 * 8 + 3] = bfhi(w.y); q[c8 * 8 + 4] = bflo(w.z); q[c8 * 8 + 5] = bfhi(w.z); q[c8 * 8 + 6] = bflo(w.w); q[c8 * 8 + 7] = bfhi(w.w); }
#pragma unroll
        for (int d = 0; d < 64; ++d) o[d] = 0.f;
        float mx = -INFINITY, l = 0.f;
        const int ntile = (qblk + 1) * 8;
        for (int j = 0; j < ntile; ++j) {
            __syncthreads();
            { const int key = F.tid >> 3, ch = F.tid & 7; const size_t krow = (size_t)b * SEQ + j * 64 + key;
              const v4u kw = *(const GAS v4u*)(K + krow * 1024 + h * 64 + ch * 8), vw = *(const GAS v4u*)(V + krow * 1024 + h * 64 + ch * 8);
              LAS f32x4* kd = (LAS f32x4*)(Kf + key * 64 + ch * 8); LAS f32x4* vd = (LAS f32x4*)(Vf + key * 64 + ch * 8);
              kd[0] = (f32x4){bflo(kw.x), bfhi(kw.x), bflo(kw.y), bfhi(kw.y)}; kd[1] = (f32x4){bflo(kw.z), bfhi(kw.z), bflo(kw.w), bfhi(kw.w)};
              vd[0] = (f32x4){bflo(vw.x), bfhi(vw.x), bflo(vw.y), bfhi(vw.y)}; vd[1] = (f32x4){bflo(vw.z), bfhi(vw.z), bflo(vw.w), bfhi(vw.w)};
              if (F.tid < 64) ckt[F.tid] = CKL[(size_t)bh * SEQ + j * 64 + F.tid]; }
            __syncthreads();
            int kmax = t - j * 64; if (kmax > 63) kmax = 63;
            for (int key = 0; key <= kmax; ++key) {
                float s = -ckt[key];
#pragma unroll
                for (int d4 = 0; d4 < 16; ++d4) { const f32x4 kk = *(const LAS f32x4*)(Kf + key * 64 + d4 * 4); s += q[d4 * 4] * kk[0] + q[d4 * 4 + 1] * kk[1] + q[d4 * 4 + 2] * kk[2] + q[d4 * 4 + 3] * kk[3]; }
                if (s > mx) { const float a = __builtin_amdgcn_exp2f(mx - s); l *= a;
#pragma unroll
                    for (int d = 0; d < 64; ++d) o[d] *= a;
                    mx = s; }
                const float p = __builtin_amdgcn_exp2f(s - mx); l += p;
#pragma unroll
                for (int d4 = 0; d4 < 16; ++d4) { const f32x4 vv = *(const LAS f32x4*)(Vf + key * 64 + d4 * 4); o[d4 * 4] += p * vv[0]; o[d4 * 4 + 1] += p * vv[1]; o[d4 * 4 + 2] += p * vv[2]; o[d4 * 4 + 3] += p * vv[3]; }
            }
        }
        const float inv = 1.0f / l;
#pragma unroll
        for (int c8 = 0; c8 < 8; ++c8) { const v4u zw = *(const GAS v4u*)(Z + row * 1024 + h * 64 + c8 * 8); v4u w;
            w.x = pk2(o[c8 * 8 + 0] * inv * bflo(zw.x), o[c8 * 8 + 1] * inv * bfhi(zw.x)); w.y = pk2(o[c8 * 8 + 2] * inv * bflo(zw.y), o[c8 * 8 + 3] * inv * bfhi(zw.y));
            w.z = pk2(o[c8 * 8 + 4] * inv * bflo(zw.z), o[c8 * 8 + 5] * inv * bfhi(zw.z)); w.w = pk2(o[c8 * 8 + 6] * inv * bflo(zw.w), o[c8 * 8 + 7] * inv * bfhi(zw.w));
            *(GAS v4u*)(AO + row * 1024 + h * 64 + c8 * 8) = w; }
    }
}

__device__ __forceinline__ void scan_naive(Frame& F, int jlayer) {
    relaunder(F); const float* og = (const float*)(F.ws + WS_PAR) + 288 + jlayer * 1024;
    unsigned char* ws = F.ws;
    const bf16* Qb = (const bf16*)(ws + WS_B0); const half_t* Gb = (const half_t*)(ws + WS_B0 + BUF_STRIDE); const bf16* Vb = (const bf16*)(ws + WS_B0 + 2 * BUF_STRIDE); const bf16* Zb = (const bf16*)(ws + WS_B0 + 3 * BUF_STRIDE);
    bf16* AO = (bf16*)(ws + WS_AO);
    LAS float* ff = (LAS float*)(F.lds); LAS float* kk = ff + 1024; LAS float* qq = kk + 1024; LAS float* vv = qq + 1024; LAS float* po = vv + 1024;
    for (int u = blockIdx.x; u < 64; u += F.G) {
        const int b = u >> 3, h = u & 7; const int v = F.tid & 127, kq = F.tid >> 7;
        float S[32];
#pragma unroll
        for (int i = 0; i < 32; ++i) S[i] = 0.f;
        for (int tg = 0; tg < SEQ / 8; ++tg) {
            const size_t row0 = (size_t)b * SEQ + tg * 8;
#pragma unroll
            for (int r = 0; r < 2; ++r) { const int e = F.tid + 512 * r, tok = e >> 7, c = e & 127; const size_t a = (row0 + tok) * 1024 + h * 128 + c;
                const float g = (float)Gb[a]; const float f = __expf(g); ff[e] = f; kk[e] = 1.0f - f; qq[e] = bf2f(Qb[a]); vv[e] = bf2f(Vb[a]); }
            __syncthreads();
#pragma unroll 1
            for (int tok = 0; tok < 8; ++tok) {
                const float vt = vv[tok * 128 + v]; float p = 0.f;
#pragma unroll
                for (int i4 = 0; i4 < 8; ++i4) { const int k = tok * 128 + kq * 32 + i4 * 4; const f32x4 f4 = *(const LAS f32x4*)(ff + k), k4 = *(const LAS f32x4*)(kk + k), q4 = *(const LAS f32x4*)(qq + k);
#pragma unroll
                    for (int e = 0; e < 4; ++e) { S[i4 * 4 + e] = f4[e] * S[i4 * 4 + e] + k4[e] * vt; p += q4[e] * S[i4 * 4 + e]; } }
                po[(tok * 4 + kq) * 128 + v] = p;
            }
            __syncthreads();
            { const int tok = F.tid >> 6, v2 = (F.tid & 63) * 2;
              float o0 = 0.f, o1 = 0.f;
#pragma unroll
              for (int q4 = 0; q4 < 4; ++q4) { o0 += po[(tok * 4 + q4) * 128 + v2]; o1 += po[(tok * 4 + q4) * 128 + v2 + 1]; }
              const float ss = wave_sum(o0 * o0 + o1 * o1); const float rn = rsqrtf(ss * (1.0f / 128.0f) + EPS);
              const size_t a = (row0 + tok) * 1024 + h * 128 + v2; const unsigned zw = *(const GAS unsigned*)(Zb + a);
              *(GAS unsigned*)(AO + a) = pk2(o0 * rn * og[h * 128 + v2] * bflo(zw), o1 * rn * og[h * 128 + v2 + 1] * bfhi(zw)); }
        }
        __syncthreads();
    }
}

struct Args { const float* in[14]; float* out; unsigned char* ws; int ph_lo, ph_hi, li, pad; };
constexpr int N_PHASES = 2 + 4 * DEPTH;
__global__ void __launch_bounds__(NWAVES * 64, 2) fwd(Args args) {
    extern __shared__ __attribute__((aligned(16))) unsigned char lds[];
    Frame F;
    F.lds = (LAS unsigned char*)lds; F.MISC = (volatile LAS unsigned*)(F.lds + MISC_OFF);
    F.tid = threadIdx.x; F.lane = F.tid & 63; F.wave = __builtin_amdgcn_readfirstlane(F.tid >> 6); F.G = gridDim.x; F.ws = args.ws;
    F.ctl = (gu32*)(args.ws + WS_CTL);
    for (int u = F.tid; u < (LDS_BYTES - LDSCTL_OFF) / 4; u += NWAVES * 64) ((LAS unsigned*)(F.lds + LDSCTL_OFF))[u] = 0u;
    __syncthreads();
    XcdBarrier bar; bar.bar = (unsigned*)(F.ctl + CW_BAR); bar.x = 0; bar.st = nullptr;
    const bool one = (args.ph_hi - args.ph_lo) > 1;
    if (one) bar = xcd_barrier_post((unsigned*)(F.ctl + CW_BAR), F.MISC + 8);
    const int lo = args.ph_lo, hi = args.ph_hi;
#define IN(k) (lo <= (k) && (k) < hi)
#define SEAM(k) do { if (IN(k) && IN((k) + 1)) xcd_barrier(bar); } while (0)
    unsigned char* ws = args.ws;
    if (IN(0)) { p0a(F, args.in); SEAM(0); }
    if (IN(1)) { p0b(F, args.in); SEAM(1); }
    for (int l = 0; l < DEPTH; ++l) {
        const int pb = 2 + 4 * l, j = l >> 1; const bool fx = l & 1;
        if (IN(pb)) {
            pg8::Gemm g{(const pg8::bf16_t*)(ws + WS_XS), (const pg8::bf16_t*)(ws + WS_WIN + (size_t)l * WIN_STRIDE), M, fx ? FX_INP : HG_IN, DM};
            pg8::StaticOrder S; S.init(M, g.N, F.G, (int)blockIdx.x);
            pg8::EpiIn E; E.ws = ws; E.l = l;
            pg8::gemm_phase<pg8::EpiIn, pg8::StaticOrder, PG8_ALIGN, PG8_SP2>(F.lds + RING_OFF, g, S, E);
            SEAM(pb);
        }
        if (IN(pb + 1)) { if (fx) { fox_cumsum(F); SEAM(pb + 1); } }
        if (IN(pb + 2)) { if (fx) attn_naive(F); else scan_naive(F, j); SEAM(pb + 2); }
        if (IN(pb + 3)) {
            pg8::Gemm g{(const pg8::bf16_t*)(ws + WS_AO), (const pg8::bf16_t*)(ws + WS_WOUT + (size_t)l * WOUT_STRIDE), M, DM, DM};
            pg8::StaticOrder S; S.init(M, DM, F.G, (int)blockIdx.x);
            pg8::EpiOut E; E.ws = ws; E.x0 = args.in[0]; E.xo = args.out; E.l = l;
            pg8::gemm_phase<pg8::EpiOut, pg8::StaticOrder, PG8_ALIGN, PG8_SP2>(F.lds + RING_OFF, g, S, E);
            SEAM(pb + 3);
        }
    }
#undef IN
#undef SEAM
}

extern "C" void kernel_launch(void* const* d_in, const int* in_sizes, int n_in, void* d_out, int out_size, void* d_ws, size_t ws_size, hipStream_t stream) {
    static int grid = 0;
    if (grid == 0) {
        if (n_in != 14 || in_sizes[0] != M * DM || out_size != M * DM || ws_size < WS_END) { fprintf(stderr, "kernel_launch: unexpected shapes (n_in %d, in0 %d, out %d, ws %zu); nothing launched\n", n_in, n_in > 0 ? in_sizes[0] : -1, out_size, ws_size); grid = -1; return; }
        int dev = 0, cus = 0, per_cu = 0;
        if (hipGetDevice(&dev) != hipSuccess || hipDeviceGetAttribute(&cus, hipDeviceAttributeMultiprocessorCount, dev) != hipSuccess) { grid = -1; return; }
        if (hipFuncSetAttribute((const void*)fwd, hipFuncAttributeMaxDynamicSharedMemorySize, LDS_BYTES) != hipSuccess) { fprintf(stderr, "kernel_launch: hipFuncSetAttribute failed\n"); grid = -1; return; }
        if (hipOccupancyMaxActiveBlocksPerMultiprocessor(&per_cu, (const void*)fwd, NWAVES * 64, LDS_BYTES) != hipSuccess || per_cu < 1) fprintf(stderr, "kernel_launch: note: occupancy query reports %d workgroups per CU\n", per_cu);
        (void)hipGetLastError();
        grid = cus;
    }
    if (grid < 0) return;
    if (hipMemsetAsync((char*)d_ws + WS_CTL, 0, CTL_ZERO_BYTES, stream) != hipSuccess) { fprintf(stderr, "kernel_launch: hipMemsetAsync failed\n"); return; }
    Args a{};
    for (int i = 0; i < 14; ++i) a.in[i] = (const float*)d_in[i];
    a.out = (float*)d_out; a.ws = (unsigned char*)d_ws; a.li = 0; a.pad = 0;
#if MK_ONE_LAUNCH
    a.ph_lo = 0; a.ph_hi = N_PHASES;
    hipLaunchKernelGGL(fwd, dim3(grid), dim3(NWAVES * 64), LDS_BYTES, stream, a);
#else
    for (int p = 0; p < N_PHASES; ++p) {
        if (p >= 2 && ((p - 2) & 3) == 1 && (((p - 2) >> 2) & 1) == 0) continue;
        a.ph_lo = p; a.ph_hi = p + 1;
        hipLaunchKernelGGL(fwd, dim3(grid), dim3(NWAVES * 64), LDS_BYTES, stream, a);
    }
#endif
    const hipError_t le = hipPeekAtLastError();
    if (le != hipSuccess) fprintf(stderr, "kernel_launch: launch failed: %s\n", hipGetErrorName(le));
}
```

```cpp
#include <hip/hip_runtime.h>
#include <hip/hip_bf16.h>
#include <cstdio>
#include <cstdint>
#include <cmath>
#ifndef MK_ONE_LAUNCH
#define MK_ONE_LAUNCH 1
#endif
constexpr int BATCH = 8, SEQ = 4096, DM = 1024, M = BATCH * SEQ, DEPTH = 4;
constexpr int HG_H = 8, HG_DK = 128, HG_IN = 4096;
constexpr int FX_H = 16, FX_HD = 64, FX_IN = 4112, FX_INP = 4352;
constexpr float EPS = 1e-6f;
constexpr float LOG2E = 1.4426950408889634f;
constexpr float C2 = 0.125f * LOG2E;

namespace pg8 {
#define PG8_LAS __attribute__((address_space(3)))
typedef unsigned short bf16_t;
typedef short bf16x8 __attribute__((ext_vector_type(8)));
typedef float f32x4 __attribute__((ext_vector_type(4)));
typedef unsigned u32x4 __attribute__((ext_vector_type(4)));
constexpr int BM = 256, BK = 64, HALF = 128, HTB = HALF * BK * 2  , STAGE_BYTES = 8 * HTB, NXCD = 8, WGM = 8;

__host__ __device__ __forceinline__ int lds_byte(int r, int c) { const int st = (r >> 4) * 2 + (c >> 5), rr = r & 15, cc = c & 31, ob = rr * 64 + cc * 2; return st * 1024 + (ob ^ (((ob >> 9) & 1) << 5)); }
__host__ __device__ __forceinline__ void stage_rc(int b, int& R, int& C) { const int st = b / 1024, sb = b % 1024, swz = sb ^ (((sb >> 9) & 1) << 5); R = (st >> 1) * 16 + swz / 64; C = (st & 1) * 32 + (swz % 64) / 2; }
__host__ __device__ __forceinline__ int perm32(int rho) { const int n = rho >> 4, i = rho & 15; return 8 * (i >> 2) + 4 * n + (i & 3); }

struct Unit { int pm, pn; };
struct Gemm { const bf16_t* A; const bf16_t* Bt; int M, N, K; };

struct StaticOrder {
    int nM, nN, nwg, G, c;
    __host__ __device__ void init(int M, int N, int G_, int c_) { nM = M / BM; nN = N / BM; nwg = nM * nN; G = G_; c = c_; }
    __host__ __device__ bool next(int i, Unit& u) const {
        const long L = (long)i * G + c; if (L >= nwg) return false;
        int wgid = (int)L; { const int q = nwg / NXCD, r = nwg % NXCD, xcd = wgid % NXCD, off = wgid / NXCD; wgid = (xcd < r ? xcd * (q + 1) : r * (q + 1) + (xcd - r) * q) + off; }
        const int nig = WGM * nN, gid = wgid / nig, fm = gid * WGM, gsz = (nM - fm) < WGM ? (nM - fm) : WGM;
        u.pm = fm + ((wgid % nig) % gsz); u.pn = (wgid % nig) / gsz; return true;
    }
    __device__ __forceinline__ void a_ready(const Unit&) const {}
    __device__ __forceinline__ void done(const Unit&) const {}
};
template <class Epi, class Sched, bool ALIGN_EPI = false, bool SP2 = false>
__device__ __forceinline__ void gemm_phase(PG8_LAS unsigned char* lds, const Gemm g, const Sched& S, const Epi& E) {
    const int tid = threadIdx.x, wid = __builtin_amdgcn_readfirstlane(tid >> 6), lane = tid & 63, wr = wid >> 2, wc = wid & 3, fr = lane & 15, fq = lane >> 4;
    const int K = g.K, nt = K / BK;
    unsigned voffA[2], voffB[2];
#pragma unroll
    for (int i = 0; i < 2; ++i) { int R, C; stage_rc(tid * 16 + i * 8192, R, C); const int Rb = Epi::PMODE == 2 ? (64 * (R >> 5) + perm32(R & 31)) : (Epi::PMODE == 1 ? ((R & ~31) + perm32(R & 31)) : R);
        voffA[i] = (unsigned)(R * K + C) * 2u; voffB[i] = (unsigned)(Rb * K + C) * 2u; }
    const size_t kstep = (size_t)(BK * 2);
    const size_t hstep = (size_t)HALF * K * 2;
    const size_t hstepB = (Epi::PMODE == 2) ? (size_t)32 * K * 2 : hstep;
    const size_t tstep = 2 * hstep;
    const unsigned ldsw = (unsigned)wid * 1024u;
    const int aoff = lds_byte(wr * 64 + fr, fq * 8), boff = lds_byte(wc * 32 + fr, fq * 8);
#define PG8_SA(b, h) (((b) * 2 + (h)) * HTB)
#define PG8_SB(b, h) ((4 + (b) * 2 + (h)) * HTB)
#define PG8_STAGE(bufoff, gbase, voff) do { _Pragma("unroll") for (int _i = 0; _i < 2; ++_i) \
        __builtin_amdgcn_global_load_lds((const unsigned*)((const char*)(gbase) + (voff)[_i]), (PG8_LAS unsigned*)(lds + (bufoff) + ldsw + _i * 8192), 16, 0, 0); } while (0)
#define PG8_LDA(dst, b, h) do { _Pragma("unroll") for (int m = 0; m < 4; ++m) _Pragma("unroll") for (int k = 0; k < 2; ++k) dst[m][k] = *(const PG8_LAS bf16x8*)(lds + PG8_SA(b, h) + aoff + m * 2048 + k * 1024); } while (0)
#define PG8_LDB(dst, b, h) do { _Pragma("unroll") for (int n = 0; n < 2; ++n) _Pragma("unroll") for (int k = 0; k < 2; ++k) dst[n][k] = *(const PG8_LAS bf16x8*)(lds + PG8_SB(b, h) + boff + n * 2048 + k * 1024); } while (0)
#define PG8_MMA(ai, bj, At, Bt) do { __builtin_amdgcn_s_setprio(1); _Pragma("unroll") for (int m = 0; m < 4; ++m) _Pragma("unroll") for (int n = 0; n < 2; ++n) _Pragma("unroll") for (int k = 0; k < 2; ++k) \
        acc[ai][bj][m][n] = __builtin_amdgcn_mfma_f32_16x16x32_bf16(Bt[n][k], At[m][k], acc[ai][bj][m][n], 0, 0, 0); __builtin_amdgcn_s_setprio(0); } while (0)
#define PG8_WAIT_V(n) asm volatile("s_waitcnt vmcnt(" #n ")" ::: "memory")
#define PG8_WAIT_L(n) asm volatile("s_waitcnt lgkmcnt(" #n ")" ::: "memory")
#define PG8_BAR __builtin_amdgcn_s_barrier()
#define PG8_SCHED __builtin_amdgcn_sched_barrier(0)
    Unit cur, nxt; int ui = 0;
    if (!S.next(0, cur)) return;
    f32x4 acc[2][2][4][2];
#pragma unroll
    for (int a = 0; a < 2; ++a)
#pragma unroll
        for (int b = 0; b < 2; ++b)
#pragma unroll
            for (int m = 0; m < 4; ++m)
#pragma unroll
                for (int n = 0; n < 2; ++n) acc[a][b][m][n] = (f32x4){0.f, 0.f, 0.f, 0.f};
    bf16x8 At[4][2], B0[2][2], B1[2][2];
    const char* cA = (const char*)g.A + (size_t)cur.pm * tstep; const char* cB = (const char*)g.Bt + (size_t)cur.pn * tstep;
    S.a_ready(cur);
    if constexpr (SP2) {
        PG8_STAGE(PG8_SB(0, 0), cB, voffB); PG8_STAGE(PG8_SB(0, 1), cB + hstepB, voffB); PG8_STAGE(PG8_SA(0, 0), cA, voffA); PG8_STAGE(PG8_SA(0, 1), cA + hstep, voffA);
        if (wr == 1) PG8_BAR;
        PG8_WAIT_V(2); PG8_BAR;
        PG8_STAGE(PG8_SB(1, 0), cB + kstep, voffB); PG8_STAGE(PG8_SA(1, 0), cA + kstep, voffA); PG8_STAGE(PG8_SB(1, 1), cB + hstepB + kstep, voffB);
        PG8_WAIT_V(6); PG8_BAR;
    } else {
        PG8_STAGE(PG8_SB(0, 0), cB, voffB); PG8_STAGE(PG8_SA(0, 0), cA, voffA); PG8_STAGE(PG8_SB(0, 1), cB + hstepB, voffB); PG8_STAGE(PG8_SA(0, 1), cA + hstep, voffA);
        if (wr == 1) PG8_BAR;
        PG8_WAIT_V(4); PG8_BAR;
        PG8_STAGE(PG8_SB(1, 0), cB + kstep, voffB); PG8_STAGE(PG8_SA(1, 0), cA + kstep, voffA); PG8_STAGE(PG8_SB(1, 1), cB + hstepB + kstep, voffB);
        PG8_WAIT_V(6); PG8_BAR;
    }
    for (;;) {
        const bool has_next = S.next(ui + 1, nxt);
        const char* nA = has_next ? (const char*)g.A + (size_t)nxt.pm * tstep : cA; const char* nB = has_next ? (const char*)g.Bt + (size_t)nxt.pn * tstep : cB;
        for (int t = 0; t < nt; t += 2) {
            const bool last = (t == nt - 2);
            const char* a1 = cA + (size_t)(t + 1) * kstep;
            const char* a2 = last ? nA : cA + (size_t)(t + 2) * kstep; const char* b2 = last ? nB : cB + (size_t)(t + 2) * kstep;
            const char* a3 = a2 + kstep; const char* b3 = b2 + kstep;
            if (last && has_next) S.a_ready(nxt);
            if constexpr (SP2) {
            PG8_LDB(B0, 0, 0); PG8_LDB(B1, 0, 1); PG8_SCHED; PG8_LDA(At, 0, 0); PG8_STAGE(PG8_SA(1, 1), a1 + hstep, voffA);
            PG8_WAIT_V(8); PG8_WAIT_L(0); PG8_BAR; PG8_MMA(0, 0, At, B0); PG8_MMA(0, 1, At, B1); PG8_BAR; PG8_SCHED;
            PG8_LDA(At, 0, 1); PG8_STAGE(PG8_SB(0, 0), b2, voffB); PG8_STAGE(PG8_SB(0, 1), b2 + hstepB, voffB); PG8_STAGE(PG8_SA(0, 0), a2, voffA);
            PG8_WAIT_V(8); PG8_WAIT_L(0); PG8_BAR; PG8_MMA(1, 0, At, B0); PG8_MMA(1, 1, At, B1); PG8_BAR; PG8_SCHED;
            PG8_LDB(B0, 1, 0); PG8_LDB(B1, 1, 1); PG8_SCHED; PG8_LDA(At, 1, 0); PG8_STAGE(PG8_SA(0, 1), a2 + hstep, voffA);
            PG8_WAIT_V(8); PG8_WAIT_L(0); PG8_BAR; PG8_MMA(0, 0, At, B0); PG8_MMA(0, 1, At, B1); PG8_BAR; PG8_SCHED;
            PG8_LDA(At, 1, 1); PG8_STAGE(PG8_SB(1, 0), b3, voffB); PG8_STAGE(PG8_SB(1, 1), b3 + hstepB, voffB); PG8_STAGE(PG8_SA(1, 0), a3, voffA);
            PG8_WAIT_V(8); PG8_WAIT_L(0); PG8_BAR; PG8_MMA(1, 0, At, B0); PG8_MMA(1, 1, At, B1); PG8_BAR; PG8_SCHED;
            } else {
            PG8_LDB(B0, 0, 0); PG8_SCHED; PG8_LDA(At, 0, 0); PG8_STAGE(PG8_SA(1, 1), a1 + hstep, voffA);
            PG8_WAIT_L(8); PG8_BAR; PG8_WAIT_L(0); PG8_MMA(0, 0, At, B0); PG8_BAR; PG8_SCHED;
            PG8_LDB(B1, 0, 1); PG8_STAGE(PG8_SB(0, 0), b2, voffB);
            PG8_BAR; PG8_WAIT_L(0); PG8_MMA(0, 1, At, B1); PG8_BAR;
            PG8_LDA(At, 0, 1); PG8_STAGE(PG8_SA(0, 0), a2, voffA);
            PG8_BAR; PG8_WAIT_L(0); PG8_MMA(1, 0, At, B0); PG8_BAR; PG8_SCHED;
            PG8_STAGE(PG8_SB(0, 1), b2 + hstepB, voffB);
            PG8_WAIT_V(6); PG8_BAR; PG8_MMA(1, 1, At, B1); PG8_BAR;
            PG8_LDB(B0, 1, 0); PG8_SCHED; PG8_LDA(At, 1, 0); PG8_STAGE(PG8_SA(0, 1), a2 + hstep, voffA);
            PG8_WAIT_L(8); PG8_BAR; PG8_WAIT_L(0); PG8_MMA(0, 0, At, B0); PG8_BAR; PG8_SCHED;
            PG8_LDB(B1, 1, 1); PG8_STAGE(PG8_SB(1, 0), b3, voffB);
            PG8_BAR; PG8_WAIT_L(0); PG8_MMA(0, 1, At, B1); PG8_BAR;
            PG8_LDA(At, 1, 1); PG8_STAGE(PG8_SA(1, 0), a3, voffA);
            PG8_BAR; PG8_WAIT_L(0); PG8_MMA(1, 0, At, B0); PG8_BAR; PG8_SCHED;
            PG8_STAGE(PG8_SB(1, 1), b3 + hstepB, voffB);
            PG8_WAIT_V(6); PG8_BAR; PG8_MMA(1, 1, At, B1); PG8_BAR;
            }
        }
        if constexpr (ALIGN_EPI) { if (wr == 0) PG8_BAR; }
        if constexpr (!Epi::AFTER_DRAIN) { E(acc, cur, wr, wc, fr, fq); S.done(cur); }
        if (!has_next) break;
#pragma unroll
        for (int a = 0; a < 2; ++a)
#pragma unroll
            for (int b = 0; b < 2; ++b)
#pragma unroll
                for (int m = 0; m < 4; ++m)
#pragma unroll
                    for (int n = 0; n < 2; ++n) acc[a][b][m][n] = (f32x4){0.f, 0.f, 0.f, 0.f};
        cur = nxt; cA = nA; cB = nB; ++ui;
        if constexpr (ALIGN_EPI) { if (wr == 1) PG8_BAR; }
    }
    PG8_WAIT_V(0);
    if constexpr (!ALIGN_EPI) { if (wr == 0) PG8_BAR; }
    PG8_BAR;
    if constexpr (Epi::AFTER_DRAIN) { E.fused(acc, cur, wr, wc, fr, fq, lds, wid, lane); S.done(cur); }
#undef PG8_SA
#undef PG8_SB
#undef PG8_STAGE
#undef PG8_LDA
#undef PG8_LDB
#undef PG8_MMA
#undef PG8_WAIT_V
#undef PG8_WAIT_L
#undef PG8_BAR
#undef PG8_SCHED
}
}

#ifndef PG8_SP2
#define PG8_SP2 true
#endif
#ifndef PG8_ALIGN
#define PG8_ALIGN true
#endif
constexpr size_t MiB = 1u << 20;
constexpr size_t WS_CTL = 0, CTL_ZERO_BYTES = 1 * MiB;
constexpr size_t WS_ROWSS = 65536;
constexpr size_t WS_WIN = 4 * MiB, WIN_STRIDE = 10 * MiB;
constexpr size_t WS_WOUT = 44 * MiB, WOUT_STRIDE = 2 * MiB;
constexpr size_t WS_XS = 64 * MiB;
constexpr size_t WS_B0 = 128 * MiB, BUF_STRIDE = 64 * MiB;
constexpr size_t WS_AO = 384 * MiB;
constexpr size_t WS_MISC = 448 * MiB;
constexpr size_t WS_GS = WS_MISC, WS_SH = WS_MISC + 128 * 1024, WS_GATE = WS_MISC + 256 * 1024, WS_LB = WS_MISC + 384 * 1024;
constexpr size_t WS_PAR = WS_MISC + 400 * 1024;
constexpr size_t WS_BIAS = WS_MISC + 1 * MiB;
constexpr size_t WS_LF = WS_MISC + 2 * MiB;
constexpr size_t WS_CKL = WS_MISC + 4 * MiB;
constexpr size_t WS_KX = WS_MISC + 6 * MiB;
constexpr size_t WS_SLOC = WS_MISC + 16 * MiB;
constexpr size_t WS_DTOT = WS_MISC + 32 * MiB;
constexpr size_t WS_END = WS_MISC + 34 * MiB;
constexpr int CW_TMO = 0, CW_CODE = 1, CW_BAR = 4096;
constexpr int BIAS_LD = FX_INP;

constexpr int RING_OFF = 0, RING_BYTES = 131072;
constexpr int LDSCTL_OFF = RING_BYTES, MISC_OFF = LDSCTL_OFF + 320;
constexpr int LDS_BYTES = 147456;
constexpr int NWAVES = 8;

namespace pg8 {
__device__ __forceinline__ unsigned cvt_pk_bf16(float lo, float hi) { unsigned r; asm volatile("v_cvt_pk_bf16_f32 %0, %1, %2" : "=v"(r) : "v"(lo), "v"(hi)); return r; }
typedef _Float16 f16x2 __attribute__((ext_vector_type(2)));
__device__ __forceinline__ unsigned cvt_pk_f16(float lo, float hi) { f16x2 v = {(_Float16)lo, (_Float16)hi}; return __builtin_bit_cast(unsigned, v); }
__device__ __forceinline__ float fast_sigmoid(float v) { return __builtin_amdgcn_rcpf(1.0f + __expf(-v)); }
__device__ __forceinline__ float log_sigmoid(float v) { return fminf(v, 0.f) - __logf(1.0f + __expf(-fabsf(v))); }

struct EpiIn {
    static constexpr int PMODE = 2; static constexpr bool AFTER_DRAIN = false;
    unsigned char* ws; int l;
    __device__ __forceinline__ void operator()(const f32x4 (&acc)[2][2][4][2], const Unit& u, int wr_, int wc_, int fr_, int fq_) const {
        unsigned char* w = ws; int wr = wr_, wc = wc_, fr = fr_, fq = fq_, ll = l;
        asm volatile("" : "+s"(w), "+s"(ll), "+s"(wr), "+s"(wc), "+v"(fr), "+v"(fq));
        const int kind = ll & 1, jj = ll >> 1;
        const float* rowss = (const float*)(w + WS_ROWSS) + (size_t)ll * M;
        const int nb = BIAS_LD; const float* bias = (const float*)(w + WS_BIAS) + (size_t)ll * 8 * BIAS_LD;
        bf16_t* obase = (bf16_t*)(w + WS_B0); const size_t ostride = BUF_STRIDE / 2;
        const float* lb = (kind == 0 && jj > 0) ? (const float*)(w + WS_LB) + jj * 1024 : nullptr;
        const float* qg = (const float*)(w + WS_PAR) + jj * 64; const float* kg = (const float*)(w + WS_PAR) + 128 + jj * 64; const float* bfg = (const float*)(w + WS_PAR) + 256 + jj * 16;
        float* lf = (float*)(w + WS_LF);
        const int t = u.pn >> 2, b = u.pm >> 4;
        const int crel = 64 * wc + 8 * fq, gcol0 = u.pn * 256 + crel, ocol0 = (u.pn & 3) * 256 + crel;
        f32x4 bv[2][2], pv[2][2];
#pragma unroll
        for (int bj = 0; bj < 2; ++bj)
#pragma unroll
            for (int n = 0; n < 2; ++n) {
                bv[bj][n] = *(const f32x4*)(bias + (size_t)b * nb + gcol0 + 32 * bj + 4 * n);
                pv[bj][n] = (f32x4){0.f, 0.f, 0.f, 0.f};
                if (kind == 0) { if (t == 1 && lb) pv[bj][n] = *(const f32x4*)(lb + ocol0 + 32 * bj + 4 * n); }
                else { if (t == 0) pv[bj][n] = *(const f32x4*)(qg + 32 * bj + 8 * fq + 4 * n) * C2; else if (t == 1) pv[bj][n] = *(const f32x4*)(kg + 32 * bj + 8 * fq + 4 * n); }
            }
        bf16_t* ob = obase + (size_t)(t & 3) * ostride;
#pragma unroll
        for (int ai = 0; ai < 2; ++ai)
#pragma unroll
            for (int m = 0; m < 4; ++m) {
                const int row = u.pm * 256 + ai * 128 + wr * 64 + m * 16 + fr;
                const float rstd = rsqrtf(rowss[row] * (1.0f / 1024.0f) + EPS);
                f32x4 v[2][2];
#pragma unroll
                for (int bj = 0; bj < 2; ++bj)
#pragma unroll
                    for (int n = 0; n < 2; ++n) v[bj][n] = acc[ai][bj][m][n] * rstd + bv[bj][n];
                if (kind == 1 && t == 4) {
                    if (wc == 0 && fq < 2) {
#pragma unroll
                        for (int n = 0; n < 2; ++n) { const f32x4 bb = *(const f32x4*)(bfg + 8 * fq + 4 * n); f32x4 o;
#pragma unroll
                            for (int e = 0; e < 4; ++e) o[e] = log_sigmoid(v[0][n][e] + bb[e]);
                            *(f32x4*)(lf + (size_t)row * 16 + 8 * fq + 4 * n) = o; }
                    }
                    continue;
                }
                bool half16 = false;
                if (kind == 0) {
                    if (t == 1) {
                        half16 = true;
#pragma unroll
                        for (int bj = 0; bj < 2; ++bj)
#pragma unroll
                            for (int n = 0; n < 2; ++n)
#pragma unroll
                                for (int e = 0; e < 4; ++e) { const float fl = v[bj][n][e];
                                    v[bj][n][e] = lb ? __logf(pv[bj][n][e] + (1.0f - pv[bj][n][e]) * fast_sigmoid(fl)) : log_sigmoid(fl); }
                    } else if (t == 3) {
#pragma unroll
                        for (int bj = 0; bj < 2; ++bj)
#pragma unroll
                            for (int n = 0; n < 2; ++n)
#pragma unroll
                                for (int e = 0; e < 4; ++e) { const float z = v[bj][n][e]; v[bj][n][e] = z * fast_sigmoid(z); }
                    }
                } else {
                    if (t <= 1) {
                        float ss = 0.f;
#pragma unroll
                        for (int bj = 0; bj < 2; ++bj)
#pragma unroll
                            for (int n = 0; n < 2; ++n) { const f32x4 x = v[bj][n]; ss += (x[0] * x[0] + x[1] * x[1]) + (x[2] * x[2] + x[3] * x[3]); }
                        ss += __shfl_xor(ss, 16); ss += __shfl_xor(ss, 32);
                        const float rn = rsqrtf(ss * (1.0f / 64.0f) + EPS);
#pragma unroll
                        for (int bj = 0; bj < 2; ++bj)
#pragma unroll
                            for (int n = 0; n < 2; ++n) v[bj][n] = v[bj][n] * rn * pv[bj][n];
                    } else if (t == 3) {
#pragma unroll
                        for (int bj = 0; bj < 2; ++bj)
#pragma unroll
                            for (int n = 0; n < 2; ++n)
#pragma unroll
                                for (int e = 0; e < 4; ++e) { const float z = v[bj][n][e]; v[bj][n][e] = z * fast_sigmoid(z); }
                    }
                }
                bf16_t* rowp = ob + (size_t)row * 1024 + ocol0;
#pragma unroll
                for (int bj = 0; bj < 2; ++bj) { u32x4 w;
                    if (half16) { w.x = cvt_pk_f16(v[bj][0][0], v[bj][0][1]); w.y = cvt_pk_f16(v[bj][0][2], v[bj][0][3]); w.z = cvt_pk_f16(v[bj][1][0], v[bj][1][1]); w.w = cvt_pk_f16(v[bj][1][2], v[bj][1][3]); }
                    else { w.x = cvt_pk_bf16(v[bj][0][0], v[bj][0][1]); w.y = cvt_pk_bf16(v[bj][0][2], v[bj][0][3]); w.z = cvt_pk_bf16(v[bj][1][0], v[bj][1][1]); w.w = cvt_pk_bf16(v[bj][1][2], v[bj][1][3]); }
                    *(u32x4*)(rowp + 32 * bj) = w; }
            }
    }
};

struct EpiOut {
    static constexpr int PMODE = 1; static constexpr bool AFTER_DRAIN = false;
    unsigned char* ws; const float* x0; float* xo; int l;
    __device__ __forceinline__ void operator()(const f32x4 (&acc)[2][2][4][2], const Unit& u, int wr_, int wc_, int fr_, int fq_) const {
        unsigned char* w = ws; int wr = wr_, wc = wc_, fr = fr_, fq = fq_, ll = l; const float* xin = (l == 0) ? x0 : xo; float* xout = xo;
        asm volatile("" : "+s"(w), "+s"(ll), "+s"(wr), "+s"(wc), "+v"(fr), "+v"(fq), "+s"(xin), "+s"(xout));
        const float* gate = (const float*)(w + WS_GATE) + (size_t)ll * 8 * 1024;
        const float* gsn = (ll + 1 < DEPTH) ? (const float*)(w + WS_GS) + (size_t)(ll + 1) * 8 * 1024 : nullptr;
        bf16_t* xs = (bf16_t*)(w + WS_XS); float* rowssn = (float*)(w + WS_ROWSS) + (size_t)(ll + 1 < DEPTH ? ll + 1 : 0) * M;
        const int b = u.pm >> 4, col0 = u.pn * 256 + 32 * wc + 8 * fq;
        f32x4 gv[2][2], sv[2][2];
#pragma unroll
        for (int bj = 0; bj < 2; ++bj)
#pragma unroll
            for (int n = 0; n < 2; ++n) { gv[bj][n] = *(const f32x4*)(gate + b * 1024 + col0 + 128 * bj + 4 * n);
                sv[bj][n] = gsn ? *(const f32x4*)(gsn + b * 1024 + col0 + 128 * bj + 4 * n) : (f32x4){0.f, 0.f, 0.f, 0.f}; }
#pragma unroll
        for (int ai = 0; ai < 2; ++ai)
#pragma unroll
            for (int m = 0; m < 4; ++m) {
                const int row = u.pm * 256 + ai * 128 + wr * 64 + m * 16 + fr; float ss = 0.f;
#pragma unroll
                for (int bj = 0; bj < 2; ++bj) { const size_t off = (size_t)row * 1024 + col0 + 128 * bj;
                    const f32x4 y0 = *(const f32x4*)(xin + off) + gv[bj][0] * acc[ai][bj][m][0], y1 = *(const f32x4*)(xin + off + 4) + gv[bj][1] * acc[ai][bj][m][1];
                    *(f32x4*)(xout + off) = y0; *(f32x4*)(xout + off + 4) = y1;
                    ss += (y0[0] * y0[0] + y0[1] * y0[1]) + (y0[2] * y0[2] + y0[3] * y0[3]) + (y1[0] * y1[0] + y1[1] * y1[1]) + (y1[2] * y1[2] + y1[3] * y1[3]);
                    if (gsn) { const f32x4 a0 = y0 * sv[bj][0], a1 = y1 * sv[bj][1]; u32x4 w; w.x = cvt_pk_bf16(a0[0], a0[1]); w.y = cvt_pk_bf16(a0[2], a0[3]); w.z = cvt_pk_bf16(a1[0], a1[1]); w.w = cvt_pk_bf16(a1[2], a1[3]);
                        *(u32x4*)(xs + off) = w; } }
                if (gsn) { ss += __shfl_xor(ss, 16); ss += __shfl_xor(ss, 32); if (fq == 0) atomicAdd(rowssn + row, ss); }
            }
    }
};
}
#define GAS __attribute__((address_space(1)))
#define LAS __attribute__((address_space(3)))
typedef unsigned short bf16;
typedef unsigned v4u __attribute__((ext_vector_type(4)));
typedef float f32x4 __attribute__((ext_vector_type(4)));
typedef short bf16x8 __attribute__((ext_vector_type(8)));
typedef GAS unsigned gu32;
typedef GAS unsigned long long gu64;
#define RLX_AGENT __ATOMIC_RELAXED, __HIP_MEMORY_SCOPE_AGENT
#define LDS_WAIT() asm volatile("s_waitcnt lgkmcnt(0)" ::: "memory")
#define VM_WAIT() asm volatile("s_waitcnt vmcnt(0)" ::: "memory")
__device__ __forceinline__ unsigned long long rt() { return __builtin_amdgcn_s_memrealtime(); }
__device__ __forceinline__ unsigned f2bf(float f) { unsigned u = __builtin_bit_cast(unsigned, f); return (u + 0x7fffu + ((u >> 16) & 1u)) >> 16; }
__device__ __forceinline__ unsigned pk2(float lo, float hi) { return f2bf(lo) | (f2bf(hi) << 16); }
#define XB_TMO      128
#define XB_XCNT(j)  (256  + 64 * (j))
#define XB_XSUB(j)  (1280 + 64 * (j))
#define XB_XGEN(j)  (2304 + 64 * (j))
#define XB_TOP      3328
#define XB_TOPGEN   3392
#define XCD_BAR_WORDS 3456
#define XB_SPIN_CAP (1u << 18)

__device__ __forceinline__ unsigned xb_ld(unsigned* p)              { return __hip_atomic_load(p, __ATOMIC_RELAXED, __HIP_MEMORY_SCOPE_AGENT); }
__device__ __forceinline__ unsigned xb_add(unsigned* p, unsigned v) { return __hip_atomic_fetch_add(p, v, __ATOMIC_RELAXED, __HIP_MEMORY_SCOPE_AGENT); }
__device__ __forceinline__ unsigned xb_xcc_id() { return (unsigned)__builtin_amdgcn_s_getreg((3 << 11) | 20) & 0xFu; }
#define XB_SPIN(cond, bar) do { unsigned _sp = 0; while (cond) { __builtin_amdgcn_s_sleep(1); \
    if ((++_sp & 255u) == 0u) { if (xb_ld(&(bar)[XB_TMO])) break; if (_sp > XB_SPIN_CAP) { atomicAdd(&(bar)[XB_TMO], 1u); break; } } } } while (0)

struct XcdBarrier {
    unsigned* bar; unsigned x;
    volatile LAS unsigned* st;
};

__device__ __forceinline__ XcdBarrier xcd_barrier_post(unsigned* bar, volatile LAS unsigned* st) {
    XcdBarrier b; b.bar = bar; b.x = xb_xcc_id(); b.st = st;
    if (threadIdx.x == 0) (void)xb_add(&bar[XB_XCNT(b.x)], 1u);
    return b;
}
__device__ __forceinline__ void xcd_barrier_complete(unsigned* bar, unsigned x, unsigned& nloc, unsigned& nx) {
    const unsigned G = gridDim.x * gridDim.y * gridDim.z;
    unsigned sum, cnt, mine, sp = 0u;
    for (;;) {
        sum = 0u; cnt = 0u; mine = 0u;
#pragma unroll
        for (unsigned j = 0; j < 16; ++j) { const unsigned c = xb_ld(&bar[XB_XCNT(j)]); sum += c; cnt += (c > 0u) ? 1u : 0u; mine = (j == x) ? c : mine; }
        if (sum == G) break;
        __builtin_amdgcn_s_sleep(1);
        if ((++sp & 255u) == 0u) { if (xb_ld(&bar[XB_TMO])) break; if (sp > XB_SPIN_CAP) { atomicAdd(&bar[XB_TMO], 1u); break; } }
    }
    nloc = mine > 0u ? mine : 1u; nx = cnt > 0u ? cnt : 1u;
}

__device__ __forceinline__ void xcd_barrier(const XcdBarrier& b) {
    asm volatile("s_waitcnt vmcnt(0)" ::: "memory");
    __syncthreads();
    if (threadIdx.x == 0) {
        unsigned* bar = b.bar;
        __builtin_amdgcn_s_waitcnt(0);
        unsigned nloc = b.st[0], nx = b.st[1];
        if (nloc == 0u) { xcd_barrier_complete(bar, b.x, nloc, nx); b.st[0] = nloc; b.st[1] = nx; }
        const unsigned old = xb_add(&bar[XB_XSUB(b.x)], 1u);
        const unsigned gen = old / nloc;
        if (old + 1u == (gen + 1u) * nloc) {
            __builtin_amdgcn_fence(__ATOMIC_RELEASE, "agent");
            asm volatile("s_waitcnt vmcnt(0)" ::: "memory");
            const unsigned og = xb_add(&bar[XB_TOP], 1u);
            const unsigned tg = og / nx;
            if (og + 1u == (tg + 1u) * nx) xb_add(&bar[XB_TOPGEN], 1u);
            else XB_SPIN(xb_ld(&bar[XB_TOPGEN]) == tg, bar);
            __builtin_amdgcn_fence(__ATOMIC_ACQUIRE, "agent");
            xb_add(&bar[XB_XGEN(b.x)], 1u);
            asm volatile("s_waitcnt vmcnt(0)" ::: "memory");
        } else {
            XB_SPIN(xb_ld(&bar[XB_XGEN(b.x)]) == gen, bar);
            __builtin_amdgcn_fence(__ATOMIC_ACQUIRE, "agent");
            asm volatile("s_waitcnt vmcnt(0)" ::: "memory");
        }
    }
    __syncthreads();
}
__device__ __forceinline__ float wave_sum(float v) {
#pragma unroll
    for (int o = 1; o < 64; o <<= 1) v += __shfl_xor(v, o);
    return v;
}
__device__ __forceinline__ void p0_transpose_item(const float* W, int K, int N, bf16* WT, int row_off, LAS float* scr, int item, int lane) {
    const int nblk = N / 32, kb = item / nblk, nb = item % nblk, k0 = 64 * kb, n0 = 32 * nb;
#pragma unroll 8
    for (int i = 0; i < 32; ++i) { const int kk = 2 * i + (lane >> 5); scr[kk * 33 + (lane & 31)] = W[(size_t)(k0 + kk) * N + n0 + (lane & 31)]; }
    LDS_WAIT(); asm volatile("" ::: "memory");
    const int c = lane & 7;
#pragma unroll
    for (int j = 0; j < 4; ++j) { const int n = (lane >> 3) + 8 * j; const LAS float* s = scr + (8 * c) * 33 + n;
        v4u o; o.x = pk2(s[0 * 33], s[1 * 33]); o.y = pk2(s[2 * 33], s[3 * 33]); o.z = pk2(s[4 * 33], s[5 * 33]); o.w = pk2(s[6 * 33], s[7 * 33]);
        *(GAS v4u*)(WT + (size_t)(row_off + n0 + n) * K + k0 + 8 * c) = o; }
    LDS_WAIT(); asm volatile("" ::: "memory");
}
struct Frame {
    LAS unsigned char* lds; volatile LAS unsigned* MISC; gu32* ctl;
    int tid, lane, wave, G;
    unsigned char* ws;
};
#define relaunder(F) do { int t_ = threadIdx.x; asm volatile("" : "+v"(t_)); (F).tid = t_; (F).lane = t_ & 63; (F).wave = __builtin_amdgcn_readfirstlane(t_ >> 6); } while (0)
typedef _Float16 half_t;
__device__ __forceinline__ float bf2f(unsigned short h) { return __builtin_bit_cast(float, (unsigned)h << 16); }
__device__ __forceinline__ float bflo(unsigned w) { return __builtin_bit_cast(float, w << 16); }
__device__ __forceinline__ float bfhi(unsigned w) { return __builtin_bit_cast(float, w & 0xffff0000u); }

__device__ __forceinline__ void p0_transpose_item2(const float* W, int K, int N, bf16* WT, LAS float* scr, int kb, int n0, int nvalid, int lane) {
    const int k0 = 64 * kb;
#pragma unroll 8
    for (int i = 0; i < 32; ++i) { const int kk = 2 * i + (lane >> 5); const int nn = lane & 31; scr[kk * 33 + nn] = (nn < nvalid) ? W[(size_t)(k0 + kk) * N + n0 + nn] : 0.f; }
    LDS_WAIT(); asm volatile("" ::: "memory");
    const int c = lane & 7;
#pragma unroll
    for (int j = 0; j < 4; ++j) { const int n = (lane >> 3) + 8 * j; const LAS float* s = scr + (8 * c) * 33 + n;
        v4u o; o.x = pk2(s[0 * 33], s[1 * 33]); o.y = pk2(s[2 * 33], s[3 * 33]); o.z = pk2(s[4 * 33], s[5 * 33]); o.w = pk2(s[6 * 33], s[7 * 33]);
        if (n < nvalid) *(GAS v4u*)(WT + (size_t)(n0 + n) * K + k0 + 8 * c) = o; }
    LDS_WAIT(); asm volatile("" ::: "memory");
}

__device__ __forceinline__ void gemv8_block(Frame& F, const float* Wm, int N, int j0, int ncols, const LAS float* atab, LAS float* part) {
    float a8[8];
#pragma unroll
    for (int b = 0; b < 8; ++b) a8[b] = 0.f;
    const int j = j0 + F.lane; const bool ok = F.lane < ncols;
    const int kbeg = F.wave * 128;
#pragma unroll 4
    for (int kk = 0; kk < 128; ++kk) { const int k = kbeg + kk; const float w = ok ? Wm[(size_t)k * N + j] : 0.f;
        const f32x4 t0 = *(const LAS f32x4*)(atab + k * 8), t1 = *(const LAS f32x4*)(atab + k * 8 + 4);
        a8[0] += t0[0] * w; a8[1] += t0[1] * w; a8[2] += t0[2] * w; a8[3] += t0[3] * w; a8[4] += t1[0] * w; a8[5] += t1[1] * w; a8[6] += t1[2] * w; a8[7] += t1[3] * w; }
#pragma unroll
    for (int b = 0; b < 8; ++b) part[(F.wave * 8 + b) * 64 + F.lane] = a8[b];
}

__device__ __forceinline__ void p0a(Frame& F, const float* const* in) {
    relaunder(F);
    const float* c = in[1]; const float* norm_g = in[2]; const float* ada_w = in[3]; const float* ada_b = in[4]; const float* lbl = in[5];
    const float* hg_w_in = in[6]; const float* hg_w_out = in[8]; const float* fx_w_in = in[9]; const float* fx_w_out = in[13];
    unsigned char* ws = F.ws;
    {
        LAS float* atab = (LAS float*)(F.lds);
        LAS float* part = (LAS float*)(F.lds + 32768);
        for (int e = F.tid; e < 8192; e += 512) { const int b = e >> 10, k = e & 1023; const float v = c[b * 1024 + k]; atab[k * 8 + b] = v / (1.0f + __expf(-v)); }
        __syncthreads();
        for (int it = blockIdx.x; it < 4 * 48; it += F.G) {
            const int l = it / 48, jb = it % 48, j0 = jb * 64;
            gemv8_block(F, ada_w + (size_t)l * 1024 * 3072, 3072, j0, 64, atab, part);
            __syncthreads();
            { const int b = F.tid >> 6, jl = F.tid & 63, j = j0 + jl; float s = ada_b[l * 3072 + j];
#pragma unroll
              for (int w = 0; w < 8; ++w) s += part[(w * 8 + b) * 64 + jl];
              const int sec = j >> 10, cc = j & 1023; const size_t o = ((size_t)l * 8 + b) * 1024 + cc;
              if (sec == 0) ((float*)(ws + WS_SH))[o] = s; else if (sec == 1) ((float*)(ws + WS_GS))[o] = norm_g[l * 1024 + cc] * (1.0f + s); else ((float*)(ws + WS_GATE))[o] = s; }
            __syncthreads();
        }
    }
    if (blockIdx.x == 0) { float* par = (float*)(ws + WS_PAR); for (int e = F.tid; e < 128; e += 512) { par[e] = in[11][e]; par[128 + e] = in[12][e]; } if (F.tid < 32) par[256 + F.tid] = in[10][F.tid]; for (int e = F.tid; e < 2048; e += 512) par[288 + e] = in[7][e]; }
    if (blockIdx.x == F.G - 1) { for (int e = F.tid; e < 1024; e += 512) { const float d = lbl[1024 + e] - lbl[e]; ((float*)(ws + WS_LB))[e] = 0.f; ((float*)(ws + WS_LB))[1024 + e] = 1.0f / (1.0f + __expf(-d)); } }
    {
        __syncthreads();
        LAS float* scr = (LAS float*)(F.lds + F.wave * 16384);
        const int gw = blockIdx.x * NWAVES + F.wave, NGW = F.G * NWAVES;
        constexpr int I_HG = 16 * 128, I_FX = 16 * 129, I_O = 16 * 32;
        constexpr int NIT = 2 * I_HG + 2 * I_FX + 4 * I_O;
        for (int it = gw; it < NIT; it += NGW) {
            int r = it;
            if (r < 2 * I_HG) { const int j = r / I_HG; r %= I_HG; p0_transpose_item2(hg_w_in + (size_t)j * 1024 * HG_IN, 1024, HG_IN, (bf16*)(ws + WS_WIN + (size_t)(2 * j) * WIN_STRIDE), scr, r / 128, (r % 128) * 32, 32, F.lane); continue; }
            r -= 2 * I_HG;
            if (r < 2 * I_FX) { const int j = r / I_FX; r %= I_FX; const int nb = r % 129; p0_transpose_item2(fx_w_in + (size_t)j * 1024 * FX_IN, 1024, FX_IN, (bf16*)(ws + WS_WIN + (size_t)(2 * j + 1) * WIN_STRIDE), scr, r / 129, nb * 32, nb == 128 ? 16 : 32, F.lane); continue; }
            r -= 2 * I_FX;
            { const int l = r / I_O; r %= I_O; const float* src = (l & 1) ? fx_w_out + (size_t)(l >> 1) * 1024 * 1024 : hg_w_out + (size_t)(l >> 1) * 1024 * 1024;
              p0_transpose_item2(src, 1024, 1024, (bf16*)(ws + WS_WOUT + (size_t)l * WOUT_STRIDE), scr, r / 32, (r % 32) * 32, 32, F.lane); }
        }
        for (int e = blockIdx.x * 512 + F.tid; e < 2 * 240 * 128; e += F.G * 512) { const int j = e / (240 * 128), q = e % (240 * 128);
            *(GAS v4u*)((bf16*)(ws + WS_WIN + (size_t)(2 * j + 1) * WIN_STRIDE) + (size_t)FX_IN * 1024 + (size_t)q * 8) = (v4u){0u, 0u, 0u, 0u}; }
    }
}

__device__ __forceinline__ void p0b(Frame& F, const float* const* in) {
    relaunder(F);
    const float* x = in[0]; const float* hg_w_in = in[6]; const float* fx_w_in = in[9];
    unsigned char* ws = F.ws;
    {
        LAS float* atab = (LAS float*)(F.lds);
        LAS float* part = (LAS float*)(F.lds + 32768);
        constexpr int NB_HG = 64, NB_FX = 68;
        for (int it = blockIdx.x; it < 2 * NB_HG + 2 * NB_FX; it += F.G) {
            int l, jb; if (it < 2 * NB_HG) { l = 2 * (it / NB_HG); jb = it % NB_HG; } else { const int r = it - 2 * NB_HG; l = 2 * (r / NB_FX) + 1; jb = r % NB_FX; }
            const bool fx = l & 1; const int N = fx ? FX_IN : HG_IN; const int j0 = jb * 64; const int ncols = (j0 + 64 <= N) ? 64 : (j0 < N ? N - j0 : 0);
            const float* Wm = fx ? fx_w_in + (size_t)(l >> 1) * 1024 * FX_IN : hg_w_in + (size_t)(l >> 1) * 1024 * HG_IN;
            const float* sh = (const float*)(ws + WS_SH) + (size_t)l * 8 * 1024;
            __syncthreads();
            for (int e = F.tid; e < 8192; e += 512) { const int b = e >> 10, k = e & 1023; atab[k * 8 + b] = sh[b * 1024 + k]; }
            __syncthreads();
            gemv8_block(F, Wm, N, j0, ncols, atab, part);
            __syncthreads();
            { const int b = F.tid >> 6, jl = F.tid & 63; float s = 0.f;
#pragma unroll
              for (int w = 0; w < 8; ++w) s += part[(w * 8 + b) * 64 + jl];
              ((float*)(ws + WS_BIAS))[((size_t)l * 8 + b) * BIAS_LD + j0 + jl] = (jl < ncols) ? s : 0.f; }
        }
    }
    {
        const int gw = blockIdx.x * NWAVES + F.wave, NGW = F.G * NWAVES;
        const float* gs = (const float*)(ws + WS_GS);
        float* rowss = (float*)(ws + WS_ROWSS);
        bf16* xs = (bf16*)(ws + WS_XS);
        for (int m = gw; m < M; m += NGW) {
            const int b = m >> 12; const GAS f32x4* xr = (const GAS f32x4*)(x + (size_t)m * 1024) + F.lane; const f32x4* gr = (const f32x4*)(gs + b * 1024) + F.lane;
            GAS unsigned long long* o8 = (GAS unsigned long long*)(xs + (size_t)m * 1024) + F.lane; float s = 0.f;
#pragma unroll
            for (int j = 0; j < 4; ++j) { const f32x4 v = xr[64 * j], g = gr[64 * j]; s += (v.x * v.x + v.y * v.y) + (v.z * v.z + v.w * v.w);
                o8[64 * j] = (unsigned long long)pk2(v.x * g.x, v.y * g.y) | ((unsigned long long)pk2(v.z * g.z, v.w * g.w) << 32); }
            s = wave_sum(s); if (F.lane == 0) rowss[m] = s;
        }
    }
}

__device__ __forceinline__ void fox_cumsum(Frame& F) {
    relaunder(F);
    unsigned char* ws = F.ws; const float* lf = (const float*)(ws + WS_LF); float* ckl = (float*)(ws + WS_CKL); bf16* kx = (bf16*)(ws + WS_KX);
    const int gw = blockIdx.x * NWAVES + F.wave, NGW = F.G * NWAVES;
    for (int bh = gw; bh < 128; bh += NGW) {
        const int b = bh >> 4, h = bh & 15; const float* p = lf + ((size_t)b * SEQ + F.lane * 64) * 16 + h;
        float sum = 0.f;
        for (int i = 0; i < 64; ++i) sum += p[i * 16];
        float incl = sum;
#pragma unroll
        for (int off = 1; off < 64; off <<= 1) { const float t = __shfl_up(incl, off); if (F.lane >= off) incl += t; }
        float run = incl - sum;
        for (int i = 0; i < 64; ++i) { run += p[i * 16]; const float c = run * LOG2E; const size_t s = (size_t)bh * SEQ + F.lane * 64 + i; ckl[s] = c;
            const float xv = -c; const unsigned h0 = f2bf(xv); const float r1 = xv - __builtin_bit_cast(float, h0 << 16); const unsigned h1 = f2bf(r1); const float r2 = r1 - __builtin_bit_cast(float, h1 << 16); const unsigned h2 = f2bf(r2);
            *(GAS v4u*)(kx + s * 8) = (v4u){h0 | (h1 << 16), h2, 0u, 0u}; }
    }
}

__device__ __forceinline__ void attn_naive(Frame& F) {
    relaunder(F);
    unsigned char* ws = F.ws;
    const bf16* Q = (const bf16*)(ws + WS_B0); const bf16* K = (const bf16*)(ws + WS_B0 + BUF_STRIDE); const bf16* V = (const bf16*)(ws + WS_B0 + 2 * BUF_STRIDE); const bf16* Z = (const bf16*)(ws + WS_B0 + 3 * BUF_STRIDE);
    const float* CKL = (const float*)(ws + WS_CKL); bf16* AO = (bf16*)(ws + WS_AO);
    LAS float* Kf = (LAS float*)(F.lds); LAS float* Vf = Kf + 4096; LAS float* ckt = Vf + 4096;
    for (int u = blockIdx.x; u < 1024; u += F.G) {
        const int qblk = 7 - (u >> 7), bh = u & 127, b = bh >> 4, h = bh & 15;
        const int t = qblk * 512 + F.tid; const size_t row = (size_t)b * SEQ + t;
        float q[64], o[64];
#pragma unroll
        for (int c8 = 0; c8 < 8; ++c8) { const v4u w = *(const GAS v4u*)(Q + row * 1024 + h * 64 + c8 * 8);
            q[c8 * 8 + 0] = bflo(w.x); q[c8 * 8 + 1] = bfhi(w.x); q[c8 * 8 + 2] = bflo(w.y); q[c8 * 8 + 3] = bfhi(w.y); q[c8 * 8 + 4] = bflo(w.z); q[c8 * 8 + 5] = bfhi(w.z); q[c8 * 8 + 6] = bflo(w.w); q[c8 * 8 + 7] = bfhi(w.w); }
#pragma unroll
        for (int d = 0; d < 64; ++d) o[d] = 0.f;
        float mx = -INFINITY, l = 0.f;
        const int ntile = (qblk + 1) * 8;
        for (int j = 0; j < ntile; ++j) {
            __syncthreads();
            { const int key = F.tid >> 3, ch = F.tid & 7; const size_t krow = (size_t)b * SEQ + j * 64 + key;
              const v4u kw = *(const GAS v4u*)(K + krow * 1024 + h * 64 + ch * 8), vw = *(const GAS v4u*)(V + krow * 1024 + h * 64 + ch * 8);
              LAS f32x4* kd = (LAS f32x4*)(Kf + key * 64 + ch * 8); LAS f32x4* vd = (LAS f32x4*)(Vf + key * 64 + ch * 8);
              kd[0] = (f32x4){bflo(kw.x), bfhi(kw.x), bflo(kw.y), bfhi(kw.y)}; kd[1] = (f32x4){bflo(kw.z), bfhi(kw.z), bflo(kw.w), bfhi(kw.w)};
              vd[0] = (f32x4){bflo(vw.x), bfhi(vw.x), bflo(vw.y), bfhi(vw.y)}; vd[1] = (f32x4){bflo(vw.z), bfhi(vw.z), bflo(vw.w), bfhi(vw.w)};
              if (F.tid < 64) ckt[F.tid] = CKL[(size_t)bh * SEQ + j * 64 + F.tid]; }
            __syncthreads();
            int kmax = t - j * 64; if (kmax > 63) kmax = 63;
            for (int key = 0; key <= kmax; ++key) {
                float s = -ckt[key];
#pragma unroll
                for (int d4 = 0; d4 < 16; ++d4) { const f32x4 kk = *(const LAS f32x4*)(Kf + key * 64 + d4 * 4); s += q[d4 * 4] * kk[0] + q[d4 * 4 + 1] * kk[1] + q[d4 * 4 + 2] * kk[2] + q[d4 * 4 + 3] * kk[3]; }
                if (s > mx) { const float a = __builtin_amdgcn_exp2f(mx - s); l *= a;
#pragma unroll
                    for (int d = 0; d < 64; ++d) o[d] *= a;
                    mx = s; }
                const float p = __builtin_amdgcn_exp2f(s - mx); l += p;
#pragma unroll
                for (int d4 = 0; d4 < 16; ++d4) { const f32x4 vv = *(const LAS f32x4*)(Vf + key * 64 + d4 * 4); o[d4 * 4] += p * vv[0]; o[d4 * 4 + 1] += p * vv[1]; o[d4 * 4 + 2] += p * vv[2]; o[d4 * 4 + 3] += p * vv[3]; }
            }
        }
        const float inv = 1.0f / l;
#pragma unroll
        for (int c8 = 0; c8 < 8; ++c8) { const v4u zw = *(const GAS v4u*)(Z + row * 1024 + h * 64 + c8 * 8); v4u w;
            w.x = pk2(o[c8 * 8 + 0] * inv * bflo(zw.x), o[c8 * 8 + 1] * inv * bfhi(zw.x)); w.y = pk2(o[c8 * 8 + 2] * inv * bflo(zw.y), o[c8 * 8 + 3] * inv * bfhi(zw.y));
            w.z = pk2(o[c8 * 8 + 4] * inv * bflo(zw.z), o[c8 * 8 + 5] * inv * bfhi(zw.z)); w.w = pk2(o[c8 * 8 + 6] * inv * bflo(zw.w), o[c8 * 8 + 7] * inv * bfhi(zw.w));
            *(GAS v4u*)(AO + row * 1024 + h * 64 + c8 * 8) = w; }
    }
}

__device__ __forceinline__ void scan_naive(Frame& F, int jlayer) {
    relaunder(F); const float* og = (const float*)(F.ws + WS_PAR) + 288 + jlayer * 1024;
    unsigned char* ws = F.ws;
    const bf16* Qb = (const bf16*)(ws + WS_B0); const half_t* Gb = (const half_t*)(ws + WS_B0 + BUF_STRIDE); const bf16* Vb = (const bf16*)(ws + WS_B0 + 2 * BUF_STRIDE); const bf16* Zb = (const bf16*)(ws + WS_B0 + 3 * BUF_STRIDE);
    bf16* AO = (bf16*)(ws + WS_AO);
    LAS float* ff = (LAS float*)(F.lds); LAS float* kk = ff + 1024; LAS float* qq = kk + 1024; LAS float* vv = qq + 1024; LAS float* po = vv + 1024;
    for (int u = blockIdx.x; u < 64; u += F.G) {
        const int b = u >> 3, h = u & 7; const int v = F.tid & 127, kq = F.tid >> 7;
        float S[32];
#pragma unroll
        for (int i = 0; i < 32; ++i) S[i] = 0.f;
        for (int tg = 0; tg < SEQ / 8; ++tg) {
            const size_t row0 = (size_t)b * SEQ + tg * 8;
#pragma unroll
            for (int r = 0; r < 2; ++r) { const int e = F.tid + 512 * r, tok = e >> 7, c = e & 127; const size_t a = (row0 + tok) * 1024 + h * 128 + c;
                const float g = (float)Gb[a]; const float f = __expf(g); ff[e] = f; kk[e] = 1.0f - f; qq[e] = bf2f(Qb[a]); vv[e] = bf2f(Vb[a]); }
            __syncthreads();
#pragma unroll 1
            for (int tok = 0; tok < 8; ++tok) {
                const float vt = vv[tok * 128 + v]; float p = 0.f;
#pragma unroll
                for (int i4 = 0; i4 < 8; ++i4) { const int k = tok * 128 + kq * 32 + i4 * 4; const f32x4 f4 = *(const LAS f32x4*)(ff + k), k4 = *(const LAS f32x4*)(kk + k), q4 = *(const LAS f32x4*)(qq + k);
#pragma unroll
                    for (int e = 0; e < 4; ++e) { S[i4 * 4 + e] = f4[e] * S[i4 * 4 + e] + k4[e] * vt; p += q4[e] * S[i4 * 4 + e]; } }
                po[(tok * 4 + kq) * 128 + v] = p;
            }
            __syncthreads();
            { const int tok = F.tid >> 6, v2 = (F.tid & 63) * 2;
              float o0 = 0.f, o1 = 0.f;
#pragma unroll
              for (int q4 = 0; q4 < 4; ++q4) { o0 += po[(tok * 4 + q4) * 128 + v2]; o1 += po[(tok * 4 + q4) * 128 + v2 + 1]; }
              const float ss = wave_sum(o0 * o0 + o1 * o1); const float rn = rsqrtf(ss * (1.0f / 128.0f) + EPS);
              const size_t a = (row0 + tok) * 1024 + h * 128 + v2; const unsigned zw = *(const GAS unsigned*)(Zb + a);
              *(GAS unsigned*)(AO + a) = pk2(o0 * rn * og[h * 128 + v2] * bflo(zw), o1 * rn * og[h * 128 + v2 + 1] * bfhi(zw)); }
        }
        __syncthreads();
    }
}

struct Args { const float* in[14]; float* out; unsigned char* ws; int ph_lo, ph_hi, li, pad; };
constexpr int N_PHASES = 2 + 4 * DEPTH;
__global__ void __launch_bounds__(NWAVES * 64, 2) fwd(Args args) {
    extern __shared__ __attribute__((aligned(16))) unsigned char lds[];
    Frame F;
    F.lds = (LAS unsigned char*)lds; F.MISC = (volatile LAS unsigned*)(F.lds + MISC_OFF);
    F.tid = threadIdx.x; F.lane = F.tid & 63; F.wave = __builtin_amdgcn_readfirstlane(F.tid >> 6); F.G = gridDim.x; F.ws = args.ws;
    F.ctl = (gu32*)(args.ws + WS_CTL);
    for (int u = F.tid; u < (LDS_BYTES - LDSCTL_OFF) / 4; u += NWAVES * 64) ((LAS unsigned*)(F.lds + LDSCTL_OFF))[u] = 0u;
    __syncthreads();
    XcdBarrier bar; bar.bar = (unsigned*)(F.ctl + CW_BAR); bar.x = 0; bar.st = nullptr;
    const bool one = (args.ph_hi - args.ph_lo) > 1;
    if (one) bar = xcd_barrier_post((unsigned*)(F.ctl + CW_BAR), F.MISC + 8);
    const int lo = args.ph_lo, hi = args.ph_hi;
#define IN(k) (lo <= (k) && (k) < hi)
#define SEAM(k) do { if (IN(k) && IN((k) + 1)) xcd_barrier(bar); } while (0)
    unsigned char* ws = args.ws;
    if (IN(0)) { p0a(F, args.in); SEAM(0); }
    if (IN(1)) { p0b(F, args.in); SEAM(1); }
    for (int l = 0; l < DEPTH; ++l) {
        const int pb = 2 + 4 * l, j = l >> 1; const bool fx = l & 1;
        if (IN(pb)) {
            pg8::Gemm g{(const pg8::bf16_t*)(ws + WS_XS), (const pg8::bf16_t*)(ws + WS_WIN + (size_t)l * WIN_STRIDE), M, fx ? FX_INP : HG_IN, DM};
            pg8::StaticOrder S; S.init(M, g.N, F.G, (int)blockIdx.x);
            pg8::EpiIn E; E.ws = ws; E.l = l;
            pg8::gemm_phase<pg8::EpiIn, pg8::StaticOrder, PG8_ALIGN, PG8_SP2>(F.lds + RING_OFF, g, S, E);
            SEAM(pb);
        }
        if (IN(pb + 1)) { if (fx) { fox_cumsum(F); SEAM(pb + 1); } }
        if (IN(pb + 2)) { if (fx) attn_naive(F); else scan_naive(F, j); SEAM(pb + 2); }
        if (IN(pb + 3)) {
            pg8::Gemm g{(const pg8::bf16_t*)(ws + WS_AO), (const pg8::bf16_t*)(ws + WS_WOUT + (size_t)l * WOUT_STRIDE), M, DM, DM};
            pg8::StaticOrder S; S.init(M, DM, F.G, (int)blockIdx.x);
            pg8::EpiOut E; E.ws = ws; E.x0 = args.in[0]; E.xo = args.out; E.l = l;
            pg8::gemm_phase<pg8::EpiOut, pg8::StaticOrder, PG8_ALIGN, PG8_SP2>(F.lds + RING_OFF, g, S, E);
            SEAM(pb + 3);
        }
    }
#undef IN
#undef SEAM
}

extern "C" void kernel_launch(void* const* d_in, const int* in_sizes, int n_in, void* d_out, int out_size, void* d_ws, size_t ws_size, hipStream_t stream) {
    static int grid = 0;
    if (grid == 0) {
        if (n_in != 14 || in_sizes[0] != M * DM || out_size != M * DM || ws_size < WS_END) { fprintf(stderr, "kernel_launch: unexpected shapes (n_in %d, in0 %d, out %d, ws %zu); nothing launched\n", n_in, n_in > 0 ? in_sizes[0] : -1, out_size, ws_size); grid = -1; return; }
        int dev = 0, cus = 0, per_cu = 0;
        if (hipGetDevice(&dev) != hipSuccess || hipDeviceGetAttribute(&cus, hipDeviceAttributeMultiprocessorCount, dev) != hipSuccess) { grid = -1; return; }
        if (hipFuncSetAttribute((const void*)fwd, hipFuncAttributeMaxDynamicSharedMemorySize, LDS_BYTES) != hipSuccess) { fprintf(stderr, "kernel_launch: hipFuncSetAttribute failed\n"); grid = -1; return; }
        if (hipOccupancyMaxActiveBlocksPerMultiprocessor(&per_cu, (const void*)fwd, NWAVES * 64, LDS_BYTES) != hipSuccess || per_cu < 1) fprintf(stderr, "kernel_launch: note: occupancy query reports %d workgroups per CU\n", per_cu);
        (void)hipGetLastError();
        grid = cus;
    }
    if (grid < 0) return;
    if (hipMemsetAsync((char*)d_ws + WS_CTL, 0, CTL_ZERO_BYTES, stream) != hipSuccess) { fprintf(stderr, "kernel_launch: hipMemsetAsync failed\n"); return; }
    Args a{};
    for (int i = 0; i < 14; ++i) a.in[i] = (const float*)d_in[i];
    a.out = (float*)d_out; a.ws = (unsigned char*)d_ws; a.li = 0; a.pad = 0;
#if MK_ONE_LAUNCH
    a.ph_lo = 0; a.ph_hi = N_PHASES;
    hipLaunchKernelGGL(fwd, dim3(grid), dim3(NWAVES * 64), LDS_BYTES, stream, a);
#else
    for (int p = 0; p < N_PHASES; ++p) {
        if (p >= 2 && ((p - 2) & 3) == 1 && (((p - 2) >> 2) & 1) == 0) continue;
        a.ph_lo = p; a.ph_hi = p + 1;
        hipLaunchKernelGGL(fwd, dim3(grid), dim3(NWAVES * 64), LDS_BYTES, stream, a);
    }
#endif
    const hipError_t le = hipPeekAtLastError();
    if (le != hipSuccess) fprintf(stderr, "kernel_launch: launch failed: %s\n", hipGetErrorName(le));
}
```

```cpp
#include <hip/hip_runtime.h>
#include <hip/hip_bf16.h>
#include <cstdio>
#include <cstdint>
#include <cmath>
#ifndef MK_ONE_LAUNCH
#define MK_ONE_LAUNCH 1
#endif
#ifndef FAST_ATTN
#define FAST_ATTN 1
#endif
constexpr int BATCH = 8, SEQ = 4096, DM = 1024, M = BATCH * SEQ, DEPTH = 4;
constexpr int HG_H = 8, HG_DK = 128, HG_IN = 4096;
constexpr int FX_H = 16, FX_HD = 64, FX_IN = 4112, FX_INP = 4352;
constexpr float EPS = 1e-6f;
constexpr float LOG2E = 1.4426950408889634f;
constexpr float C2 = 0.125f * LOG2E;

namespace pg8 {
#define PG8_LAS __attribute__((address_space(3)))
typedef unsigned short bf16_t;
typedef short bf16x8 __attribute__((ext_vector_type(8)));
typedef float f32x4 __attribute__((ext_vector_type(4)));
typedef unsigned u32x4 __attribute__((ext_vector_type(4)));
constexpr int BM = 256, BK = 64, HALF = 128, HTB = HALF * BK * 2  , STAGE_BYTES = 8 * HTB, NXCD = 8, WGM = 8;

__host__ __device__ __forceinline__ int lds_byte(int r, int c) { const int st = (r >> 4) * 2 + (c >> 5), rr = r & 15, cc = c & 31, ob = rr * 64 + cc * 2; return st * 1024 + (ob ^ (((ob >> 9) & 1) << 5)); }
__host__ __device__ __forceinline__ void stage_rc(int b, int& R, int& C) { const int st = b / 1024, sb = b % 1024, swz = sb ^ (((sb >> 9) & 1) << 5); R = (st >> 1) * 16 + swz / 64; C = (st & 1) * 32 + (swz % 64) / 2; }
__host__ __device__ __forceinline__ int perm32(int rho) { const int n = rho >> 4, i = rho & 15; return 8 * (i >> 2) + 4 * n + (i & 3); }

struct Unit { int pm, pn; };
struct Gemm { const bf16_t* A; const bf16_t* Bt; int M, N, K; };

struct StaticOrder {
    int nM, nN, nwg, G, c;
    __host__ __device__ void init(int M, int N, int G_, int c_) { nM = M / BM; nN = N / BM; nwg = nM * nN; G = G_; c = c_; }
    __host__ __device__ bool next(int i, Unit& u) const {
        const long L = (long)i * G + c; if (L >= nwg) return false;
        int wgid = (int)L; { const int q = nwg / NXCD, r = nwg % NXCD, xcd = wgid % NXCD, off = wgid / NXCD; wgid = (xcd < r ? xcd * (q + 1) : r * (q + 1) + (xcd - r) * q) + off; }
        const int nig = WGM * nN, gid = wgid / nig, fm = gid * WGM, gsz = (nM - fm) < WGM ? (nM - fm) : WGM;
        u.pm = fm + ((wgid % nig) % gsz); u.pn = (wgid % nig) / gsz; return true;
    }
    __device__ __forceinline__ void a_ready(const Unit&) const {}
    __device__ __forceinline__ void done(const Unit&) const {}
};
template <class Epi, class Sched, bool ALIGN_EPI = false, bool SP2 = false>
__device__ __forceinline__ void gemm_phase(PG8_LAS unsigned char* lds, const Gemm g, const Sched& S, const Epi& E) {
    const int tid = threadIdx.x, wid = __builtin_amdgcn_readfirstlane(tid >> 6), lane = tid & 63, wr = wid >> 2, wc = wid & 3, fr = lane & 15, fq = lane >> 4;
    const int K = g.K, nt = K / BK;
    unsigned voffA[2], voffB[2];
#pragma unroll
    for (int i = 0; i < 2; ++i) { int R, C; stage_rc(tid * 16 + i * 8192, R, C); const int Rb = Epi::PMODE == 2 ? (64 * (R >> 5) + perm32(R & 31)) : (Epi::PMODE == 1 ? ((R & ~31) + perm32(R & 31)) : R);
        voffA[i] = (unsigned)(R * K + C) * 2u; voffB[i] = (unsigned)(Rb * K + C) * 2u; }
    const size_t kstep = (size_t)(BK * 2);
    const size_t hstep = (size_t)HALF * K * 2;
    const size_t hstepB = (Epi::PMODE == 2) ? (size_t)32 * K * 2 : hstep;
    const size_t tstep = 2 * hstep;
    const unsigned ldsw = (unsigned)wid * 1024u;
    const int aoff = lds_byte(wr * 64 + fr, fq * 8), boff = lds_byte(wc * 32 + fr, fq * 8);
#define PG8_SA(b, h) (((b) * 2 + (h)) * HTB)
#define PG8_SB(b, h) ((4 + (b) * 2 + (h)) * HTB)
#define PG8_STAGE(bufoff, gbase, voff) do { _Pragma("unroll") for (int _i = 0; _i < 2; ++_i) \
        __builtin_amdgcn_global_load_lds((const unsigned*)((const char*)(gbase) + (voff)[_i]), (PG8_LAS unsigned*)(lds + (bufoff) + ldsw + _i * 8192), 16, 0, 0); } while (0)
#define PG8_LDA(dst, b, h) do { _Pragma("unroll") for (int m = 0; m < 4; ++m) _Pragma("unroll") for (int k = 0; k < 2; ++k) dst[m][k] = *(const PG8_LAS bf16x8*)(lds + PG8_SA(b, h) + aoff + m * 2048 + k * 1024); } while (0)
#define PG8_LDB(dst, b, h) do { _Pragma("unroll") for (int n = 0; n < 2; ++n) _Pragma("unroll") for (int k = 0; k < 2; ++k) dst[n][k] = *(const PG8_LAS bf16x8*)(lds + PG8_SB(b, h) + boff + n * 2048 + k * 1024); } while (0)
#define PG8_MMA(ai, bj, At, Bt) do { __builtin_amdgcn_s_setprio(1); _Pragma("unroll") for (int m = 0; m < 4; ++m) _Pragma("unroll") for (int n = 0; n < 2; ++n) _Pragma("unroll") for (int k = 0; k < 2; ++k) \
        acc[ai][bj][m][n] = __builtin_amdgcn_mfma_f32_16x16x32_bf16(Bt[n][k], At[m][k], acc[ai][bj][m][n], 0, 0, 0); __builtin_amdgcn_s_setprio(0); } while (0)
#define PG8_WAIT_V(n) asm volatile("s_waitcnt vmcnt(" #n ")" ::: "memory")
#define PG8_WAIT_L(n) asm volatile("s_waitcnt lgkmcnt(" #n ")" ::: "memory")
#define PG8_BAR __builtin_amdgcn_s_barrier()
#define PG8_SCHED __builtin_amdgcn_sched_barrier(0)
    Unit cur, nxt; int ui = 0;
    if (!S.next(0, cur)) return;
    f32x4 acc[2][2][4][2];
#pragma unroll
    for (int a = 0; a < 2; ++a)
#pragma unroll
        for (int b = 0; b < 2; ++b)
#pragma unroll
            for (int m = 0; m < 4; ++m)
#pragma unroll
                for (int n = 0; n < 2; ++n) acc[a][b][m][n] = (f32x4){0.f, 0.f, 0.f, 0.f};
    bf16x8 At[4][2], B0[2][2], B1[2][2];
    const char* cA = (const char*)g.A + (size_t)cur.pm * tstep; const char* cB = (const char*)g.Bt + (size_t)cur.pn * tstep;
    S.a_ready(cur);
    if constexpr (SP2) {
        PG8_STAGE(PG8_SB(0, 0), cB, voffB); PG8_STAGE(PG8_SB(0, 1), cB + hstepB, voffB); PG8_STAGE(PG8_SA(0, 0), cA, voffA); PG8_STAGE(PG8_SA(0, 1), cA + hstep, voffA);
        if (wr == 1) PG8_BAR;
        PG8_WAIT_V(2); PG8_BAR;
        PG8_STAGE(PG8_SB(1, 0), cB + kstep, voffB); PG8_STAGE(PG8_SA(1, 0), cA + kstep, voffA); PG8_STAGE(PG8_SB(1, 1), cB + hstepB + kstep, voffB);
        PG8_WAIT_V(6); PG8_BAR;
    } else {
        PG8_STAGE(PG8_SB(0, 0), cB, voffB); PG8_STAGE(PG8_SA(0, 0), cA, voffA); PG8_STAGE(PG8_SB(0, 1), cB + hstepB, voffB); PG8_STAGE(PG8_SA(0, 1), cA + hstep, voffA);
        if (wr == 1) PG8_BAR;
        PG8_WAIT_V(4); PG8_BAR;
        PG8_STAGE(PG8_SB(1, 0), cB + kstep, voffB); PG8_STAGE(PG8_SA(1, 0), cA + kstep, voffA); PG8_STAGE(PG8_SB(1, 1), cB + hstepB + kstep, voffB);
        PG8_WAIT_V(6); PG8_BAR;
    }
    for (;;) {
        const bool has_next = S.next(ui + 1, nxt);
        const char* nA = has_next ? (const char*)g.A + (size_t)nxt.pm * tstep : cA; const char* nB = has_next ? (const char*)g.Bt + (size_t)nxt.pn * tstep : cB;
        for (int t = 0; t < nt; t += 2) {
            const bool last = (t == nt - 2);
            const char* a1 = cA + (size_t)(t + 1) * kstep;
            const char* a2 = last ? nA : cA + (size_t)(t + 2) * kstep; const char* b2 = last ? nB : cB + (size_t)(t + 2) * kstep;
            const char* a3 = a2 + kstep; const char* b3 = b2 + kstep;
            if (last && has_next) S.a_ready(nxt);
            if constexpr (SP2) {
            PG8_LDB(B0, 0, 0); PG8_LDB(B1, 0, 1); PG8_SCHED; PG8_LDA(At, 0, 0); PG8_STAGE(PG8_SA(1, 1), a1 + hstep, voffA);
            PG8_WAIT_V(8); PG8_WAIT_L(0); PG8_BAR; PG8_MMA(0, 0, At, B0); PG8_MMA(0, 1, At, B1); PG8_BAR; PG8_SCHED;
            PG8_LDA(At, 0, 1); PG8_STAGE(PG8_SB(0, 0), b2, voffB); PG8_STAGE(PG8_SB(0, 1), b2 + hstepB, voffB); PG8_STAGE(PG8_SA(0, 0), a2, voffA);
            PG8_WAIT_V(8); PG8_WAIT_L(0); PG8_BAR; PG8_MMA(1, 0, At, B0); PG8_MMA(1, 1, At, B1); PG8_BAR; PG8_SCHED;
            PG8_LDB(B0, 1, 0); PG8_LDB(B1, 1, 1); PG8_SCHED; PG8_LDA(At, 1, 0); PG8_STAGE(PG8_SA(0, 1), a2 + hstep, voffA);
            PG8_WAIT_V(8); PG8_WAIT_L(0); PG8_BAR; PG8_MMA(0, 0, At, B0); PG8_MMA(0, 1, At, B1); PG8_BAR; PG8_SCHED;
            PG8_LDA(At, 1, 1); PG8_STAGE(PG8_SB(1, 0), b3, voffB); PG8_STAGE(PG8_SB(1, 1), b3 + hstepB, voffB); PG8_STAGE(PG8_SA(1, 0), a3, voffA);
            PG8_WAIT_V(8); PG8_WAIT_L(0); PG8_BAR; PG8_MMA(1, 0, At, B0); PG8_MMA(1, 1, At, B1); PG8_BAR; PG8_SCHED;
            } else {
            PG8_LDB(B0, 0, 0); PG8_SCHED; PG8_LDA(At, 0, 0); PG8_STAGE(PG8_SA(1, 1), a1 + hstep, voffA);
            PG8_WAIT_L(8); PG8_BAR; PG8_WAIT_L(0); PG8_MMA(0, 0, At, B0); PG8_BAR; PG8_SCHED;
            PG8_LDB(B1, 0, 1); PG8_STAGE(PG8_SB(0, 0), b2, voffB);
            PG8_BAR; PG8_WAIT_L(0); PG8_MMA(0, 1, At, B1); PG8_BAR;
            PG8_LDA(At, 0, 1); PG8_STAGE(PG8_SA(0, 0), a2, voffA);
            PG8_BAR; PG8_WAIT_L(0); PG8_MMA(1, 0, At, B0); PG8_BAR; PG8_SCHED;
            PG8_STAGE(PG8_SB(0, 1), b2 + hstepB, voffB);
            PG8_WAIT_V(6); PG8_BAR; PG8_MMA(1, 1, At, B1); PG8_BAR;
            PG8_LDB(B0, 1, 0); PG8_SCHED; PG8_LDA(At, 1, 0); PG8_STAGE(PG8_SA(0, 1), a2 + hstep, voffA);
            PG8_WAIT_L(8); PG8_BAR; PG8_WAIT_L(0); PG8_MMA(0, 0, At, B0); PG8_BAR; PG8_SCHED;
            PG8_LDB(B1, 1, 1); PG8_STAGE(PG8_SB(1, 0), b3, voffB);
            PG8_BAR; PG8_WAIT_L(0); PG8_MMA(0, 1, At, B1); PG8_BAR;
            PG8_LDA(At, 1, 1); PG8_STAGE(PG8_SA(1, 0), a3, voffA);
            PG8_BAR; PG8_WAIT_L(0); PG8_MMA(1, 0, At, B0); PG8_BAR; PG8_SCHED;
            PG8_STAGE(PG8_SB(1, 1), b3 + hstepB, voffB);
            PG8_WAIT_V(6); PG8_BAR; PG8_MMA(1, 1, At, B1); PG8_BAR;
            }
        }
        if constexpr (ALIGN_EPI) { if (wr == 0) PG8_BAR; }
        if constexpr (!Epi::AFTER_DRAIN) { E(acc, cur, wr, wc, fr, fq); S.done(cur); }
        if (!has_next) break;
#pragma unroll
        for (int a = 0; a < 2; ++a)
#pragma unroll
            for (int b = 0; b < 2; ++b)
#pragma unroll
                for (int m = 0; m < 4; ++m)
#pragma unroll
                    for (int n = 0; n < 2; ++n) acc[a][b][m][n] = (f32x4){0.f, 0.f, 0.f, 0.f};
        cur = nxt; cA = nA; cB = nB; ++ui;
        if constexpr (ALIGN_EPI) { if (wr == 1) PG8_BAR; }
    }
    PG8_WAIT_V(0);
    if constexpr (!ALIGN_EPI) { if (wr == 0) PG8_BAR; }
    PG8_BAR;
    if constexpr (Epi::AFTER_DRAIN) { E.fused(acc, cur, wr, wc, fr, fq, lds, wid, lane); S.done(cur); }
#undef PG8_SA
#undef PG8_SB
#undef PG8_STAGE
#undef PG8_LDA
#undef PG8_LDB
#undef PG8_MMA
#undef PG8_WAIT_V
#undef PG8_WAIT_L
#undef PG8_BAR
#undef PG8_SCHED
}
}

#ifndef PG8_SP2
#define PG8_SP2 true
#endif
#ifndef PG8_ALIGN
#define PG8_ALIGN true
#endif
constexpr size_t MiB = 1u << 20;
constexpr size_t WS_CTL = 0, CTL_ZERO_BYTES = 1 * MiB;
constexpr size_t WS_ROWSS = 65536;
constexpr size_t WS_WIN = 4 * MiB, WIN_STRIDE = 10 * MiB;
constexpr size_t WS_WOUT = 44 * MiB, WOUT_STRIDE = 2 * MiB;
constexpr size_t WS_XS = 64 * MiB;
constexpr size_t WS_B0 = 128 * MiB, BUF_STRIDE = 64 * MiB;
constexpr size_t WS_AO = 384 * MiB;
constexpr size_t WS_MISC = 448 * MiB;
constexpr size_t WS_GS = WS_MISC, WS_SH = WS_MISC + 128 * 1024, WS_GATE = WS_MISC + 256 * 1024, WS_LB = WS_MISC + 384 * 1024;
constexpr size_t WS_PAR = WS_MISC + 400 * 1024;
constexpr size_t WS_BIAS = WS_MISC + 1 * MiB;
constexpr size_t WS_LF = WS_MISC + 2 * MiB;
constexpr size_t WS_CKL = WS_MISC + 4 * MiB;
constexpr size_t WS_KX = WS_MISC + 6 * MiB;
constexpr size_t WS_SLOC = WS_MISC + 16 * MiB;
constexpr size_t WS_DTOT = WS_MISC + 32 * MiB;
constexpr size_t WS_END = WS_MISC + 34 * MiB;
constexpr int CW_TMO = 0, CW_CODE = 1, CW_BAR = 4096;
constexpr int BIAS_LD = FX_INP;

constexpr int RING_OFF = 0, RING_BYTES = 131072;
constexpr int LDSCTL_OFF = RING_BYTES, MISC_OFF = LDSCTL_OFF + 320;
constexpr int LDS_BYTES = 147456;
constexpr int NWAVES = 8;

namespace pg8 {
#define PG8_GAS __attribute__((address_space(1)))
__device__ __forceinline__ unsigned cvt_pk_bf16(float lo, float hi) { unsigned r; asm volatile("v_cvt_pk_bf16_f32 %0, %1, %2" : "=v"(r) : "v"(lo), "v"(hi)); return r; }
typedef _Float16 f16x2 __attribute__((ext_vector_type(2)));
__device__ __forceinline__ unsigned cvt_pk_f16(float lo, float hi) { f16x2 v = {(_Float16)lo, (_Float16)hi}; return __builtin_bit_cast(unsigned, v); }
__device__ __forceinline__ float fast_sigmoid(float v) { return __builtin_amdgcn_rcpf(1.0f + __expf(-v)); }
__device__ __forceinline__ float log_sigmoid(float v) { return fminf(v, 0.f) - __logf(1.0f + __expf(-fabsf(v))); }

struct EpiAll {
    static constexpr int PMODE = 2; static constexpr bool AFTER_DRAIN = false;
    unsigned char* ws; const float* x0; float* xo; int l; int isout;
    __device__ __forceinline__ void operator()(const f32x4 (&acc)[2][2][4][2], const Unit& u, int wr_, int wc_, int fr_, int fq_) const {
        if (isout) epi_out(acc, u, wr_, wc_, fr_, fq_); else epi_in(acc, u, wr_, wc_, fr_, fq_);
    }
    __device__ __forceinline__ void epi_in(const f32x4 (&acc)[2][2][4][2], const Unit& u, int wr_, int wc_, int fr_, int fq_) const {
        unsigned char* w = ws; int wr = wr_, wc = wc_, fr = fr_, fq = fq_, ll = l;
        asm volatile("" : "+s"(w), "+s"(ll), "+s"(wr), "+s"(wc), "+v"(fr), "+v"(fq));
        const int kind = ll & 1, jj = ll >> 1;
        const PG8_GAS float* rowss = (const PG8_GAS float*)(w + WS_ROWSS) + (size_t)ll * M;
        const int nb = BIAS_LD; const PG8_GAS float* bias = (const PG8_GAS float*)(w + WS_BIAS) + (size_t)ll * 8 * BIAS_LD;
        PG8_GAS bf16_t* obase = (PG8_GAS bf16_t*)(w + WS_B0); const size_t ostride = BUF_STRIDE / 2;
        const PG8_GAS float* lb = (kind == 0 && jj > 0) ? (const PG8_GAS float*)(w + WS_LB) + jj * 1024 : nullptr;
        const PG8_GAS float* qg = (const PG8_GAS float*)(w + WS_PAR) + jj * 64; const PG8_GAS float* kg = (const PG8_GAS float*)(w + WS_PAR) + 128 + jj * 64; const PG8_GAS float* bfg = (const PG8_GAS float*)(w + WS_PAR) + 256 + jj * 16;
        PG8_GAS float* lf = (PG8_GAS float*)(w + WS_LF);
        const int t = u.pn >> 2, b = u.pm >> 4;
        const int crel = 64 * wc + 8 * fq, gcol0 = u.pn * 256 + crel, ocol0 = (u.pn & 3) * 256 + crel;
        f32x4 bv[2][2], pv[2][2];
#pragma unroll
        for (int bj = 0; bj < 2; ++bj)
#pragma unroll
            for (int n = 0; n < 2; ++n) {
                bv[bj][n] = *(const PG8_GAS f32x4*)(bias + (size_t)b * nb + gcol0 + 32 * bj + 4 * n);
                pv[bj][n] = (f32x4){0.f, 0.f, 0.f, 0.f};
                if (kind == 0) { if (t == 1 && lb) pv[bj][n] = *(const PG8_GAS f32x4*)(lb + ocol0 + 32 * bj + 4 * n); }
                else { if (t == 0) pv[bj][n] = *(const PG8_GAS f32x4*)(qg + 32 * bj + 8 * fq + 4 * n) * C2; else if (t == 1) pv[bj][n] = *(const PG8_GAS f32x4*)(kg + 32 * bj + 8 * fq + 4 * n); }
            }
        PG8_GAS bf16_t* ob = obase + (size_t)(t & 3) * ostride;
#pragma unroll
        for (int ai = 0; ai < 2; ++ai)
#pragma unroll
            for (int m = 0; m < 4; ++m) {
                const int row = u.pm * 256 + ai * 128 + wr * 64 + m * 16 + fr;
                const float rstd = rsqrtf(rowss[row] * (1.0f / 1024.0f) + EPS);
                f32x4 v[2][2];
#pragma unroll
                for (int bj = 0; bj < 2; ++bj)
#pragma unroll
                    for (int n = 0; n < 2; ++n) v[bj][n] = acc[ai][bj][m][n] * rstd + bv[bj][n];
                if (kind == 1 && t == 4) {
                    if (wc == 0 && fq < 2) {
#pragma unroll
                        for (int n = 0; n < 2; ++n) { const f32x4 bb = *(const PG8_GAS f32x4*)(bfg + 8 * fq + 4 * n); f32x4 o;
#pragma unroll
                            for (int e = 0; e < 4; ++e) o[e] = log_sigmoid(v[0][n][e] + bb[e]);
                            *(PG8_GAS f32x4*)(lf + (size_t)row * 16 + 8 * fq + 4 * n) = o; }
                    }
                    continue;
                }
                bool half16 = false;
                if (kind == 0) {
                    if (t == 1) {
                        half16 = true;
#pragma unroll
                        for (int bj = 0; bj < 2; ++bj)
#pragma unroll
                            for (int n = 0; n < 2; ++n)
#pragma unroll
                                for (int e = 0; e < 4; ++e) { const float fl = v[bj][n][e];
                                    v[bj][n][e] = lb ? __logf(pv[bj][n][e] + (1.0f - pv[bj][n][e]) * fast_sigmoid(fl)) : log_sigmoid(fl); }
                    } else if (t == 3) {
#pragma unroll
                        for (int bj = 0; bj < 2; ++bj)
#pragma unroll
                            for (int n = 0; n < 2; ++n)
#pragma unroll
                                for (int e = 0; e < 4; ++e) { const float z = v[bj][n][e]; v[bj][n][e] = z * fast_sigmoid(z); }
                    }
                } else {
                    if (t <= 1) {
                        float ss = 0.f;
#pragma unroll
                        for (int bj = 0; bj < 2; ++bj)
#pragma unroll
                            for (int n = 0; n < 2; ++n) { const f32x4 x = v[bj][n]; ss += (x[0] * x[0] + x[1] * x[1]) + (x[2] * x[2] + x[3] * x[3]); }
                        ss += __shfl_xor(ss, 16); ss += __shfl_xor(ss, 32);
                        const float rn = rsqrtf(ss * (1.0f / 64.0f) + EPS);
#pragma unroll
                        for (int bj = 0; bj < 2; ++bj)
#pragma unroll
                            for (int n = 0; n < 2; ++n) v[bj][n] = v[bj][n] * rn * pv[bj][n];
                    } else if (t == 3) {
#pragma unroll
                        for (int bj = 0; bj < 2; ++bj)
#pragma unroll
                            for (int n = 0; n < 2; ++n)
#pragma unroll
                                for (int e = 0; e < 4; ++e) { const float z = v[bj][n][e]; v[bj][n][e] = z * fast_sigmoid(z); }
                    }
                }
                PG8_GAS bf16_t* rowp = ob + (size_t)row * 1024 + ocol0;
#pragma unroll
                for (int bj = 0; bj < 2; ++bj) { u32x4 w;
                    if (half16) { w.x = cvt_pk_f16(v[bj][0][0], v[bj][0][1]); w.y = cvt_pk_f16(v[bj][0][2], v[bj][0][3]); w.z = cvt_pk_f16(v[bj][1][0], v[bj][1][1]); w.w = cvt_pk_f16(v[bj][1][2], v[bj][1][3]); }
                    else { w.x = cvt_pk_bf16(v[bj][0][0], v[bj][0][1]); w.y = cvt_pk_bf16(v[bj][0][2], v[bj][0][3]); w.z = cvt_pk_bf16(v[bj][1][0], v[bj][1][1]); w.w = cvt_pk_bf16(v[bj][1][2], v[bj][1][3]); }
                    *(PG8_GAS u32x4*)(rowp + 32 * bj) = w; }
            }
    }

    __device__ __forceinline__ void epi_out(const f32x4 (&acc)[2][2][4][2], const Unit& u, int wr_, int wc_, int fr_, int fq_) const {
        unsigned char* w = ws; int wr = wr_, wc = wc_, fr = fr_, fq = fq_, ll = l; const float* xin_ = (l == 0) ? x0 : xo; float* xout_ = xo;
        asm volatile("" : "+s"(w), "+s"(ll), "+s"(wr), "+s"(wc), "+v"(fr), "+v"(fq), "+s"(xin_), "+s"(xout_));
        const PG8_GAS float* xin = (const PG8_GAS float*)xin_; PG8_GAS float* xout = (PG8_GAS float*)xout_;
        const PG8_GAS float* gate = (const PG8_GAS float*)(w + WS_GATE) + (size_t)ll * 8 * 1024;
        const PG8_GAS float* gsn = (ll + 1 < DEPTH) ? (const PG8_GAS float*)(w + WS_GS) + (size_t)(ll + 1) * 8 * 1024 : nullptr;
        PG8_GAS bf16_t* xs = (PG8_GAS bf16_t*)(w + WS_XS); float* rowssn = (float*)(w + WS_ROWSS) + (size_t)(ll + 1 < DEPTH ? ll + 1 : 0) * M;
        const int b = u.pm >> 4, col0 = u.pn * 256 + 64 * wc + 8 * fq;
        f32x4 gv[2][2], sv[2][2];
#pragma unroll
        for (int bj = 0; bj < 2; ++bj)
#pragma unroll
            for (int n = 0; n < 2; ++n) { gv[bj][n] = *(const PG8_GAS f32x4*)(gate + b * 1024 + col0 + 32 * bj + 4 * n);
                sv[bj][n] = gsn ? *(const PG8_GAS f32x4*)(gsn + b * 1024 + col0 + 32 * bj + 4 * n) : (f32x4){0.f, 0.f, 0.f, 0.f}; }
#pragma unroll
        for (int ai = 0; ai < 2; ++ai)
#pragma unroll
            for (int m = 0; m < 4; ++m) {
                const int row = u.pm * 256 + ai * 128 + wr * 64 + m * 16 + fr; float ss = 0.f;
#pragma unroll
                for (int bj = 0; bj < 2; ++bj) { const size_t off = (size_t)row * 1024 + col0 + 32 * bj;
                    const f32x4 y0 = *(const PG8_GAS f32x4*)(xin + off) + gv[bj][0] * acc[ai][bj][m][0], y1 = *(const PG8_GAS f32x4*)(xin + off + 4) + gv[bj][1] * acc[ai][bj][m][1];
                    *(PG8_GAS f32x4*)(xout + off) = y0; *(PG8_GAS f32x4*)(xout + off + 4) = y1;
                    ss += (y0[0] * y0[0] + y0[1] * y0[1]) + (y0[2] * y0[2] + y0[3] * y0[3]) + (y1[0] * y1[0] + y1[1] * y1[1]) + (y1[2] * y1[2] + y1[3] * y1[3]);
                    if (gsn) { const f32x4 a0 = y0 * sv[bj][0], a1 = y1 * sv[bj][1]; u32x4 w; w.x = cvt_pk_bf16(a0[0], a0[1]); w.y = cvt_pk_bf16(a0[2], a0[3]); w.z = cvt_pk_bf16(a1[0], a1[1]); w.w = cvt_pk_bf16(a1[2], a1[3]);
                        *(PG8_GAS u32x4*)(xs + off) = w; } }
                if (gsn) { ss += __shfl_xor(ss, 16); ss += __shfl_xor(ss, 32); if (fq == 0) atomicAdd(rowssn + row, ss); }
            }
    }
};
}
#include <hip/hip_bf16.h>
#include <cmath>
namespace attn_body {
using bf16=__hip_bfloat16;
using bf16x8=__attribute__((ext_vector_type(8)))short;
using s16x4=__attribute__((ext_vector_type(4)))short;
using f32x16=__attribute__((ext_vector_type(16)))float;
using u32x4=__attribute__((ext_vector_type(4)))unsigned;
constexpr int BATCH=8,NHEAD=16,SEQ=4096,D=64,DM=NHEAD*D;
constexpr int NW=8,QBLK=32,QB=QBLK*NW,KVBLK=64,NQB=SEQ/QB;
constexpr int ATTN_PITCH=DM, ATTN_UNIT_ROWS=QB;
__device__ __forceinline__ int crow(int r,int hi){return (r&3)+8*(r>>2)+4*hi;}
#define SBAR() __builtin_amdgcn_sched_barrier(0)
__device__ __forceinline__ void cmask(f32x16&p0,f32x16&p1,int jb,int qrel,int hi){
  const float NEG=-INFINITY; int kb=64*jb+4*hi;
  #pragma unroll
  for(int r=0;r<16;++r){int kv=kb+(r&3)+8*(r>>2); if(kv>qrel)p0[r]=NEG; if(kv+32>qrel)p1[r]=NEG;}
}

constexpr int NSLOT=3, SLOTB=8192;
constexpr int LDS_K=0, LDS_V=NSLOT*SLOTB, LDS_KX=2*NSLOT*SLOTB, LDS_WS=LDS_KX+4*1024, LDS_OST=LDS_WS+NW*64*4, LDS_BYTES=LDS_OST+NW*4096;
constexpr float C2=0.125f*1.4426950408889634f;
__device__ __forceinline__ void glds16(const void*sbase,unsigned voff,unsigned lds_dst){unsigned keep;
  asm volatile("s_mov_b32 %0, m0\n\ts_mov_b32 m0, %3\n\ts_nop 0\n\tglobal_load_lds_dwordx4 %1, %2\n\ts_mov_b32 m0, %0":"=&s"(keep):"v"(voff),"s"(sbase),"s"(lds_dst):"memory");}
__device__ __forceinline__ float max3f(float a,float b,float c){float r;asm("v_max3_f32 %0, %1, %2, %3":"=v"(r):"v"(a),"v"(b),"v"(c));return r;}
__device__ __forceinline__ float max2f(float a,float b){float r;asm("v_max_f32_e32 %0, %1, %2":"=v"(r):"v"(a),"v"(b));return r;}
__device__ __forceinline__ float fadd_s(float a,float b){float r;asm("v_add_f32_e32 %0, %1, %2":"=v"(r):"v"(a),"v"(b));return r;}
__device__ __forceinline__ float fsub_s(float a,float b){float r;asm("v_sub_f32_e32 %0, %1, %2":"=v"(r):"v"(a),"v"(b));return r;}
typedef float f32x2_t __attribute__((ext_vector_type(2))); typedef __bf16 bf16x2_t __attribute__((ext_vector_type(2)));
__device__ __forceinline__ unsigned cvtpk_s(float lo,float hi){f32x2_t v={lo,hi};bf16x2_t b=__builtin_convertvector(v,bf16x2_t);return __builtin_bit_cast(unsigned,b);}
#define WAIT_BAR(N) asm volatile("s_waitcnt vmcnt(" #N ") lgkmcnt(0)\n\ts_barrier":::"memory")

__device__ __forceinline__ void qkt(f32x16&p0,f32x16&p1,const char*Kslot,const char*KXslot,const bf16x8*qr,const f32x16&negm,int r32,int hi){
  const char*kb=Kslot+hi*1024+r32*16;
  #pragma unroll
  for(int d0=0;d0<4;++d0){
    const bf16x8 b0=*reinterpret_cast<const bf16x8*>(kb+d0*2048);
    const bf16x8 b1=*reinterpret_cast<const bf16x8*>(kb+d0*2048+512);
    if(d0==0){p0=__builtin_amdgcn_mfma_f32_32x32x16_bf16(b0,qr[0],negm,0,0,0);p1=__builtin_amdgcn_mfma_f32_32x32x16_bf16(b1,qr[0],negm,0,0,0);}
    else{p0=__builtin_amdgcn_mfma_f32_32x32x16_bf16(b0,qr[d0],p0,0,0,0);p1=__builtin_amdgcn_mfma_f32_32x32x16_bf16(b1,qr[d0],p1,0,0,0);}}
  { const bf16x8 e0=*reinterpret_cast<const bf16x8*>(KXslot+r32*16), e1=*reinterpret_cast<const bf16x8*>(KXslot+r32*16+512);
    p0=__builtin_amdgcn_mfma_f32_32x32x16_bf16(e0,qr[4],p0,0,0,0);p1=__builtin_amdgcn_mfma_f32_32x32x16_bf16(e1,qr[4],p1,0,0,0);}
}
typedef __attribute__((address_space(3))) const char* lds_cptr;
typedef short v4i16_t __attribute__((ext_vector_type(4)));
__device__ __forceinline__ void kload8(bf16x8*kf,lds_cptr kp){
  kf[0]=*(const __attribute__((address_space(3))) bf16x8*)(kp);      kf[1]=*(const __attribute__((address_space(3))) bf16x8*)(kp+512);
  kf[2]=*(const __attribute__((address_space(3))) bf16x8*)(kp+2048); kf[3]=*(const __attribute__((address_space(3))) bf16x8*)(kp+2560);
  kf[4]=*(const __attribute__((address_space(3))) bf16x8*)(kp+4096); kf[5]=*(const __attribute__((address_space(3))) bf16x8*)(kp+4608);
  kf[6]=*(const __attribute__((address_space(3))) bf16x8*)(kp+6144); kf[7]=*(const __attribute__((address_space(3))) bf16x8*)(kp+6656);
}
__device__ __forceinline__ void kload2(bf16x8*kf,lds_cptr kp,int j){ kf[2*j]=*(const __attribute__((address_space(3))) bf16x8*)(kp+j*2048); kf[2*j+1]=*(const __attribute__((address_space(3))) bf16x8*)(kp+j*2048+512); }
__device__ __forceinline__ s16x4 vtr(lds_cptr p){ return __builtin_bit_cast(s16x4,__builtin_amdgcn_ds_read_tr16_b64_v4i16((__attribute__((address_space(3))) v4i16_t*)p)); }
__device__ __forceinline__ float rowmax(const f32x16&p0,const f32x16&p1){
  float a=max3f(p0[0],p0[1],p1[0]),b=max3f(p0[2],p0[3],p1[1]);a=max3f(a,p1[2],p1[3]);
  #pragma unroll
  for(int r=4;r<16;r+=4){a=max3f(a,p0[r],p0[r+1]);b=max3f(b,p0[r+2],p0[r+3]);a=max3f(a,p1[r],p1[r+1]);b=max3f(b,p1[r+2],p1[r+3]);}
  const float m=max2f(a,b);
  auto rr=__builtin_amdgcn_permlane32_swap(__float_as_uint(m),__float_as_uint(m),false,false);
  return max2f(__uint_as_float(rr[0]),__uint_as_float(rr[1]));
}
__device__ __forceinline__ void pv(f32x16*o,int vb,bf16x8 pa0,bf16x8 pa1,bf16x8 pa2,bf16x8 pa3){
  #pragma unroll
  for(int d0=0;d0<2;++d0){s16x4 lo[4],hi[4];
    #pragma unroll
    for(int ks=0;ks<4;++ks){
      asm volatile("ds_read_b64_tr_b16 %0,%1 offset:%c2":"=&v"(lo[ks]):"v"(vb),"i"(d0*4096+ks*1024):"memory");
      asm volatile("ds_read_b64_tr_b16 %0,%1 offset:%c2":"=&v"(hi[ks]):"v"(vb),"i"(d0*4096+ks*1024+512):"memory");}
    asm volatile("s_waitcnt lgkmcnt(0)":::"memory");SBAR();
    #define PK(k) (bf16x8){lo[k][0],lo[k][1],lo[k][2],lo[k][3],hi[k][0],hi[k][1],hi[k][2],hi[k][3]}
    o[d0]=__builtin_amdgcn_mfma_f32_32x32x16_bf16(pa0,PK(0),o[d0],0,0,0);
    o[d0]=__builtin_amdgcn_mfma_f32_32x32x16_bf16(pa1,PK(1),o[d0],0,0,0);
    o[d0]=__builtin_amdgcn_mfma_f32_32x32x16_bf16(pa2,PK(2),o[d0],0,0,0);
    o[d0]=__builtin_amdgcn_mfma_f32_32x32x16_bf16(pa3,PK(3),o[d0],0,0,0);
    #undef PK
  }
}

#ifndef ATTN_STORE16
#define ATTN_STORE16(p,v) (*(u32x4*)(p)=(v))
#endif
template<int THRL> __device__ __forceinline__ void attn_unit(int b,int h,int qb,const bf16*Q,const bf16*__restrict__ K,const bf16*__restrict__ V,const bf16*__restrict__ KX,const bf16*__restrict__ Z,bf16*O,char*shm){
  int tid_=threadIdx.x; asm volatile("":"+v"(tid_));
  const int tid=tid_,lane=tid&63,r32=lane&31,hi=lane>>5; const int wid=__builtin_amdgcn_readfirstlane(tid>>6);
  const long rowbase=(long)b*SEQ; const int q0=qb*QB;
  const bf16*Qw=Q+(rowbase+q0+wid*QBLK)*DM+h*D;
  const bf16*Kh=K+rowbase*DM+h*D,*Vh=V+rowbase*DM+h*D; const bf16*KXh=KX+((long)(b*NHEAD+h)*SEQ)*8;
  const unsigned lds0=(unsigned)(uintptr_t)shm;
  float*wsf=(float*)(shm+LDS_WS)+wid*64;
  const unsigned koff=(unsigned)(lane*DM+wid*8)*2u;
  const unsigned voff=(unsigned)((16*(wid&3)+(lane>>2))*DM+(wid>>2)*32+(lane&3)*8)*2u;
  const unsigned kdst=lds0+LDS_K+wid*1024, vdst=lds0+LDS_V+wid*1024, kxdst=lds0+LDS_KX+wid*128;
  const unsigned kxoff=(unsigned)(8*wid+(lane&7))*16u;
  #define DMA_K(t,slot) glds16(Kh+(long)(t)*KVBLK*DM,koff,(unsigned)__builtin_amdgcn_readfirstlane(kdst+(slot)))
  #define DMA_V(t,slot) glds16(Vh+(long)(t)*KVBLK*DM,voff,(unsigned)__builtin_amdgcn_readfirstlane(vdst+(slot)))
  #define DMA_KX(t) do{ const unsigned d_=(unsigned)__builtin_amdgcn_readfirstlane(kxdst+(((t)&3)<<10)); if(lane<8) glds16(KXh+(long)(t)*KVBLK*8,kxoff,d_); }while(0)
  const int vb0=(int)(lds0+LDS_V)+((lane>>4)&1)*32+(lane&3)*8+(4*hi+((lane&15)>>2))*64;
  const char*Kbase=shm+LDS_K; const char*KXbase=shm+LDS_KX; bf16x8 kf[8];
  const lds_cptr shm3=(lds_cptr)shm; const lds_cptr kp0=shm3+LDS_K+hi*1024+r32*16; const lds_cptr vp0=shm3+LDS_V+((lane>>4)&1)*32+(lane&3)*8+(4*hi+((lane&15)>>2))*64; const lds_cptr kxp0=shm3+LDS_KX+r32*16;
  const int NT=(q0+QB)/KVBLK;
  DMA_K(0,0);DMA_KX(0);DMA_V(0,0);DMA_K(1,SLOTB);DMA_KX(1);
  bf16x8 qr[5];
  { const short one_=hi?(short)0:(short)0x3F80; qr[4]=(bf16x8){one_,one_,one_,0,0,0,0,0}; }
  #pragma unroll
  for(int d0=0;d0<4;++d0)qr[d0]=*reinterpret_cast<const bf16x8*>(&Qw[(long)r32*DM+d0*16+hi*8]);
  float mhat=0.f,l_reg=0.f;f32x16 o[2];o[0]=f32x16{};o[1]=f32x16{};f32x16 negm=f32x16{};asm volatile("":"+v"(negm));
  const int qrel=wid*QBLK+r32;
  #define CMASK(P0,P1,t) do{int jb_=(t)-(NT-4); if(jb_>=0)cmask(P0,P1,jb_,qrel,hi);}while(0)
  bool resc=false;
  #define START(P0,P1) do{ const float rm=rowmax(P0,P1); resc=false; \
    { const float dl=rm; mhat=fadd_s(mhat,dl); \
      _Pragma("unroll") for(int r=0;r<16;++r){P0[r]=fsub_s(P0[r],dl);P1[r]=fsub_s(P1[r],dl);} \
      _Pragma("unroll") for(int r=0;r<16;++r)negm[r]=-mhat; asm volatile("":"+v"(negm)); } \
    _Pragma("unroll") for(int r=0;r<16;++r)P0[r]=__builtin_amdgcn_exp2f(P0[r]); }while(0)
  #define RESC() do{ if(resc){ asm volatile("s_waitcnt lgkmcnt(0)":::"memory"); \
      _Pragma("unroll") for(int d_=0;d_<2;++d_) _Pragma("unroll") for(int r=0;r<16;++r)o[d_][r]*=wsf[crow(r,hi)]; } }while(0)
  f32x16 pA0,pA1,pB0,pB1;
  int sl_prev=0,sl_cur=0,sl_next=SLOTB;
  #define ROT() do{sl_prev=sl_cur;sl_cur=sl_next;sl_next=(sl_next==(NSLOT-1)*SLOTB)?0:sl_next+SLOTB;}while(0)
  DMA_K(2,2*SLOTB);DMA_KX(2);
  WAIT_BAR(5);
  qkt(pA0,pA1,Kbase,KXbase,qr,negm,r32,hi);asm volatile("s_nop 15\n\ts_nop 7":"+v"(pA0),"+v"(pA1));CMASK(pA0,pA1,0);
  START(pA0,pA1);
  _Pragma("unroll") for(int r=0;r<16;++r)pA1[r]=__builtin_amdgcn_exp2f(pA1[r]);
  WAIT_BAR(0);
  DMA_K(3,0);DMA_KX(3);DMA_V(1,SLOTB);
  ROT();
  kload8(kf,kp0+sl_cur);
  WAIT_BAR(3);
  s16x4 vlo[8],vhi[8]; u32x4 pw0,pw1,pw2,pw3;
  #define PKW(P,B) cvtpk_s(P[B],P[B+1])
  #define PAF(k) __builtin_bit_cast(bf16x8,pw##k)
  #define VFR(i) (bf16x8){vlo[i][0],vlo[i][1],vlo[i][2],vlo[i][3],vhi[i][0],vhi[i][1],vhi[i][2],vhi[i][3]}
  #define PIN(x) asm volatile("":"+v"(x))
  #define MX3(a,b,c) __builtin_fmaxf(__builtin_fmaxf((a),(b)),(c))
  #define GAPA(MF,A0,A1,A2,A3,W0,W1,PW) do{ MF; sacc+=A0; sacc+=A1; sacc+=A2; sacc+=A3; PIN(sacc); W0; W1; PIN(PW); SBAR(); }while(0)
  #define EX(v) __builtin_amdgcn_exp2f(v)
  #define GAPB(MF,X,B) do{ MF; X[B]=EX(X[B]); X[B+1]=EX(X[B+1]); X[B+2]=EX(X[B+2]); X[B+3]=EX(X[B+3]); PIN(X); SBAR(); }while(0)
  #define VRD(i) do{ vlo[i]=vtr(vp_+(((i)>>2)*4096+((i)&3)*1024)); vhi[i]=vtr(vp_+(((i)>>2)*4096+((i)&3)*1024+512)); }while(0)
  #define KRD(G,j) do{ if(G){ kload2(kf,kp0+sl_next,j); SBAR(); } }while(0)
  #define STEP(C0,C1,P0,P1,t,GK,GV,GL) do{ SBAR(); \
    const lds_cptr vp_=vp0+sl_prev; \
    VRD(0); SBAR(); float sacc=(P0[0]+P0[1]); \
    GAPA(C0=__builtin_amdgcn_mfma_f32_32x32x16_bf16(kf[0],qr[0],negm,0,0,0), P0[2],P0[3],P0[4],P0[5],     pw0[0]=PKW(P0,0), pw0[1]=PKW(P0,2), pw0); \
    VRD(4); SBAR(); GAPA(C1=__builtin_amdgcn_mfma_f32_32x32x16_bf16(kf[1],qr[0],negm,0,0,0), P0[6],P0[7],P0[8],P0[9],     pw0[2]=PKW(P0,4), pw0[3]=PKW(P0,6), pw0); \
    VRD(1); SBAR(); GAPA(C0=__builtin_amdgcn_mfma_f32_32x32x16_bf16(kf[2],qr[1],C0,0,0,0),   P0[10],P0[11],P0[12],P0[13], pw1[0]=PKW(P0,8), pw1[1]=PKW(P0,10), pw1); \
    VRD(5); SBAR(); GAPA(C1=__builtin_amdgcn_mfma_f32_32x32x16_bf16(kf[3],qr[1],C1,0,0,0),   P0[14],P0[15],P1[0],P1[1],   pw1[2]=PKW(P0,12),pw1[3]=PKW(P0,14), pw1); \
    VRD(2); SBAR(); GAPA(C0=__builtin_amdgcn_mfma_f32_32x32x16_bf16(kf[4],qr[2],C0,0,0,0),   P1[2],P1[3],P1[4],P1[5],     pw2[0]=PKW(P1,0), pw2[1]=PKW(P1,2), pw2); \
    VRD(6); SBAR(); GAPA(C1=__builtin_amdgcn_mfma_f32_32x32x16_bf16(kf[5],qr[2],C1,0,0,0),   P1[6],P1[7],P1[8],P1[9],     pw2[2]=PKW(P1,4), pw2[3]=PKW(P1,6), pw2); \
    VRD(3); SBAR(); GAPA(C0=__builtin_amdgcn_mfma_f32_32x32x16_bf16(kf[6],qr[3],C0,0,0,0),   P1[10],P1[11],P1[12],P1[13], pw3[0]=PKW(P1,8), pw3[1]=PKW(P1,10), pw3); \
    VRD(7); SBAR(); GAPA(C1=__builtin_amdgcn_mfma_f32_32x32x16_bf16(kf[7],qr[3],C1,0,0,0),   P1[14],P1[15],0.f,0.f,       pw3[2]=PKW(P1,12),pw3[3]=PKW(P1,14), pw3); \
    { const lds_cptr xp_=kxp0+(((t)&3)<<10); const bf16x8 e0_=*(const __attribute__((address_space(3))) bf16x8*)(xp_), e1_=*(const __attribute__((address_space(3))) bf16x8*)(xp_+512); \
      C0=__builtin_amdgcn_mfma_f32_32x32x16_bf16(e0_,qr[4],C0,0,0,0); C1=__builtin_amdgcn_mfma_f32_32x32x16_bf16(e1_,qr[4],C1,0,0,0); SBAR(); } \
    l_reg+=sacc; \
    if(GK){DMA_K((t)+3,sl_cur);DMA_KX((t)+3);} if(GV){DMA_V((t)+1,sl_next);} \
    CMASK(C0,C1,t); \
    { float a=MX3(C0[0],C0[1],C1[0]),b=MX3(C0[2],C0[3],C1[1]); a=MX3(a,C1[2],C1[3]); \
      _Pragma("unroll") for(int r=4;r<16;r+=4){a=MX3(a,C0[r],C0[r+1]);b=MX3(b,C0[r+2],C0[r+3]);a=MX3(a,C1[r],C1[r+1]);b=MX3(b,C1[r+2],C1[r+3]);} \
      float rm=__builtin_fmaxf(a,b); { auto rr=__builtin_amdgcn_permlane32_swap(__float_as_uint(rm),__float_as_uint(rm),false,false); rm=__builtin_fmaxf(__uint_as_float(rr[0]),__uint_as_float(rr[1])); } \
      resc=false; \
      if(__builtin_expect(__any(rm>(float)THRL),0)){ const float dl=__builtin_fmaxf(rm,0.f); mhat+=dl; \
        _Pragma("unroll") for(int r=0;r<16;++r){C0[r]-=dl;C1[r]-=dl;} \
        _Pragma("unroll") for(int r=0;r<16;++r)negm[r]=-mhat; asm volatile("":"+v"(negm)); \
        const float f=__builtin_amdgcn_exp2f(-dl); l_reg*=f; if(hi==0)wsf[r32]=f; resc=true; } } \
    SBAR(); \
    GAPB(o[0]=__builtin_amdgcn_mfma_f32_32x32x16_bf16(PAF(0),VFR(0),o[0],0,0,0), C0,0); \
    GAPB(o[1]=__builtin_amdgcn_mfma_f32_32x32x16_bf16(PAF(0),VFR(4),o[1],0,0,0), C0,4); \
    KRD(GL,0); GAPB(o[0]=__builtin_amdgcn_mfma_f32_32x32x16_bf16(PAF(1),VFR(1),o[0],0,0,0), C0,8); \
    KRD(GL,1); GAPB(o[1]=__builtin_amdgcn_mfma_f32_32x32x16_bf16(PAF(1),VFR(5),o[1],0,0,0), C0,12); \
    KRD(GL,2); GAPB(o[0]=__builtin_amdgcn_mfma_f32_32x32x16_bf16(PAF(2),VFR(2),o[0],0,0,0), C1,0); \
    KRD(GL,3); GAPB(o[1]=__builtin_amdgcn_mfma_f32_32x32x16_bf16(PAF(2),VFR(6),o[1],0,0,0), C1,4); \
    GAPB(o[0]=__builtin_amdgcn_mfma_f32_32x32x16_bf16(PAF(3),VFR(3),o[0],0,0,0), C1,8); \
    GAPB(o[1]=__builtin_amdgcn_mfma_f32_32x32x16_bf16(PAF(3),VFR(7),o[1],0,0,0), C1,12); \
    }while(0)
  int t=1;
  #undef CMASK
  #define CMASK(P0,P1,t) do{}while(0)
  for(;t+5<NT;t+=2){
    STEP(pB0,pB1,pA0,pA1,t,true,true,true);     WAIT_BAR(3); RESC(); ROT();
    STEP(pA0,pA1,pB0,pB1,t+1,true,true,true);   WAIT_BAR(3); RESC(); ROT();
  }
  #undef CMASK
  #define CMASK(P0,P1,t) do{int jb_=(t)-(NT-4); if(jb_>=0)cmask(P0,P1,jb_,qrel,hi);}while(0)
  #define ENDW(tt) do{ if((tt)+3<NT){WAIT_BAR(3);} else if((tt)+2<NT){WAIT_BAR(1);} else {WAIT_BAR(0);} }while(0)
  for(;t+1<NT;t+=2){
    STEP(pB0,pB1,pA0,pA1,t,(t+3<NT),(t+1<NT),(t+1<NT));       ENDW(t);   RESC(); ROT();
    STEP(pA0,pA1,pB0,pB1,t+1,(t+4<NT),(t+2<NT),(t+2<NT));     ENDW(t+1); RESC(); ROT();
  }
  STEP(pB0,pB1,pA0,pA1,NT-1,false,false,false); RESC();
  { float sacc=pB0[0]+pB0[1]; _Pragma("unroll") for(int r=2;r<16;++r)sacc+=pB0[r]; _Pragma("unroll") for(int r=0;r<16;++r)sacc+=pB1[r]; l_reg+=sacc;
    pw0=(u32x4){PKW(pB0,0),PKW(pB0,2),PKW(pB0,4),PKW(pB0,6)};pw1=(u32x4){PKW(pB0,8),PKW(pB0,10),PKW(pB0,12),PKW(pB0,14)};pw2=(u32x4){PKW(pB1,0),PKW(pB1,2),PKW(pB1,4),PKW(pB1,6)};pw3=(u32x4){PKW(pB1,8),PKW(pB1,10),PKW(pB1,12),PKW(pB1,14)};
    SBAR(); pv(o,vb0+sl_cur,PAF(0),PAF(1),PAF(2),PAF(3)); }
  #undef PKW
  #undef PAF
  #undef VFR
  #undef PIN
  #undef MX3
  #undef GAPA
  #undef GAPB
  #undef EX
  #undef VRD
  #undef KRD
  #undef STEP
  #undef ENDW
  {auto rr=__builtin_amdgcn_permlane32_swap(__float_as_uint(l_reg),__float_as_uint(l_reg),false,false);l_reg=__uint_as_float(rr[0])+__uint_as_float(rr[1]);}
  if(hi==0)wsf[32+r32]=l_reg;asm volatile("s_waitcnt lgkmcnt(0)":::"memory");
  float rli[16];
  #pragma unroll
  for(int r=0;r<16;++r)rli[r]=__builtin_amdgcn_rcpf(wsf[32+crow(r,hi)]);
  bf16*Ow=O+(rowbase+q0+wid*QBLK)*DM+h*D; const bf16*Zw=Z+(rowbase+q0+wid*QBLK)*DM+h*D;
  { bf16*stg=(bf16*)(shm+LDS_OST)+wid*2048;
    #pragma unroll
    for(int r=0;r<16;++r){const int orow=crow(r,hi);
      #pragma unroll
      for(int d0=0;d0<2;++d0)stg[orow*64+d0*32+r32]=__float2bfloat16(o[d0][r]*rli[r]);}
    asm volatile("s_waitcnt lgkmcnt(0)":::"memory");
    #pragma unroll
    for(int i=0;i<4;++i){const int row=i*8+(lane>>3),ch=lane&7; const u32x4 v=*(const u32x4*)(stg+row*64+ch*8); const u32x4 zz=*(const u32x4*)(Zw+(long)row*DM+ch*8); u32x4 g_;
      #pragma unroll
      for(int e_=0;e_<4;++e_){ const float a0=__builtin_bit_cast(float,v[e_]<<16)*__builtin_bit_cast(float,zz[e_]<<16), a1=__builtin_bit_cast(float,v[e_]&0xffff0000u)*__builtin_bit_cast(float,zz[e_]&0xffff0000u); g_[e_]=cvtpk_s(a0,a1); }
      ATTN_STORE16(Ow+(long)row*DM+ch*8,g_);} }
  asm volatile("s_waitcnt lgkmcnt(0)\n\ts_barrier":::"memory");
  #undef DMA_K
  #undef DMA_V
  #undef DMA_KX
  #undef CMASK
  #undef START
  #undef RESC
  #undef ROT
}
constexpr int ATTN_LDS_BYTES=LDS_BYTES;
struct AttnTensors { const bf16* Q; const bf16* K; const bf16* V; const bf16* KX; const bf16* Z; bf16* O; };
struct AttnUnit { int bh; int qb; };
struct StaticOrder {
  int vcu;
  __device__ __forceinline__ explicit StaticOrder(int grid,int block):vcu((grid%8==0)?(block%8)*(grid/8)+block/8:block){}
  __device__ __forceinline__ bool next(int i,AttnUnit&u)const{ const int L=vcu*8+i; if(i>=8||L>=BATCH*NHEAD*NQB)return false; const int s=vcu&1,p=i>>1; u.bh=vcu>>1; u.qb=(i&1)?(15-2*p-s):(2*p+s); return true; }
  __device__ __forceinline__ void a_ready(const AttnUnit&)const{}
  __device__ __forceinline__ void done(const AttnUnit&)const{}
};
template<class Sched,int THRL=8> __device__ __forceinline__ void attn_phase(char*lds,const AttnTensors&T,const Sched&S){
  AttnUnit u;
  for(int i=0;S.next(i,u);++i){ S.a_ready(u); attn_unit<THRL>(u.bh/NHEAD,u.bh%NHEAD,u.qb,T.Q,T.K,T.V,T.KX,T.Z,T.O,lds); S.done(u); }
}
#undef SBAR
#undef WAIT_BAR
}
#define GAS __attribute__((address_space(1)))
#define LAS __attribute__((address_space(3)))
typedef unsigned short bf16;
typedef unsigned v4u __attribute__((ext_vector_type(4)));
typedef float f32x4 __attribute__((ext_vector_type(4)));
typedef short bf16x8 __attribute__((ext_vector_type(8)));
typedef GAS unsigned gu32;
typedef GAS unsigned long long gu64;
#define RLX_AGENT __ATOMIC_RELAXED, __HIP_MEMORY_SCOPE_AGENT
#define LDS_WAIT() asm volatile("s_waitcnt lgkmcnt(0)" ::: "memory")
#define VM_WAIT() asm volatile("s_waitcnt vmcnt(0)" ::: "memory")
__device__ __forceinline__ unsigned long long rt() { return __builtin_amdgcn_s_memrealtime(); }
__device__ __forceinline__ unsigned f2bf(float f) { unsigned u = __builtin_bit_cast(unsigned, f); return (u + 0x7fffu + ((u >> 16) & 1u)) >> 16; }
__device__ __forceinline__ unsigned pk2(float lo, float hi) { return f2bf(lo) | (f2bf(hi) << 16); }
#define XB_TMO      128
#define XB_XCNT(j)  (256  + 64 * (j))
#define XB_XSUB(j)  (1280 + 64 * (j))
#define XB_XGEN(j)  (2304 + 64 * (j))
#define XB_TOP      3328
#define XB_TOPGEN   3392
#define XCD_BAR_WORDS 3456
#define XB_SPIN_CAP (1u << 18)

__device__ __forceinline__ unsigned xb_ld(unsigned* p)              { return __hip_atomic_load(p, __ATOMIC_RELAXED, __HIP_MEMORY_SCOPE_AGENT); }
__device__ __forceinline__ unsigned xb_add(unsigned* p, unsigned v) { return __hip_atomic_fetch_add(p, v, __ATOMIC_RELAXED, __HIP_MEMORY_SCOPE_AGENT); }
__device__ __forceinline__ unsigned xb_xcc_id() { return (unsigned)__builtin_amdgcn_s_getreg((3 << 11) | 20) & 0xFu; }
#define XB_SPIN(cond, bar) do { unsigned _sp = 0; while (cond) { __builtin_amdgcn_s_sleep(1); \
    if ((++_sp & 255u) == 0u) { if (xb_ld(&(bar)[XB_TMO])) break; if (_sp > XB_SPIN_CAP) { atomicAdd(&(bar)[XB_TMO], 1u); break; } } } } while (0)

struct XcdBarrier {
    unsigned* bar; unsigned x;
    volatile LAS unsigned* st;
};

__device__ __forceinline__ XcdBarrier xcd_barrier_post(unsigned* bar, volatile LAS unsigned* st) {
    XcdBarrier b; b.bar = bar; b.x = xb_xcc_id(); b.st = st;
    if (threadIdx.x == 0) (void)xb_add(&bar[XB_XCNT(b.x)], 1u);
    return b;
}
__device__ __forceinline__ void xcd_barrier_complete(unsigned* bar, unsigned x, unsigned& nloc, unsigned& nx) {
    const unsigned G = gridDim.x * gridDim.y * gridDim.z;
    unsigned sum, cnt, mine, sp = 0u;
    for (;;) {
        sum = 0u; cnt = 0u; mine = 0u;
#pragma unroll
        for (unsigned j = 0; j < 16; ++j) { const unsigned c = xb_ld(&bar[XB_XCNT(j)]); sum += c; cnt += (c > 0u) ? 1u : 0u; mine = (j == x) ? c : mine; }
        if (sum == G) break;
        __builtin_amdgcn_s_sleep(1);
        if ((++sp & 255u) == 0u) { if (xb_ld(&bar[XB_TMO])) break; if (sp > XB_SPIN_CAP) { atomicAdd(&bar[XB_TMO], 1u); break; } }
    }
    nloc = mine > 0u ? mine : 1u; nx = cnt > 0u ? cnt : 1u;
}

__device__ __forceinline__ void xcd_barrier(const XcdBarrier& b) {
    asm volatile("s_waitcnt vmcnt(0)" ::: "memory");
    __syncthreads();
    if (threadIdx.x == 0) {
        unsigned* bar = b.bar;
        __builtin_amdgcn_s_waitcnt(0);
        unsigned nloc = b.st[0], nx = b.st[1];
        if (nloc == 0u) { xcd_barrier_complete(bar, b.x, nloc, nx); b.st[0] = nloc; b.st[1] = nx; }
        const unsigned old = xb_add(&bar[XB_XSUB(b.x)], 1u);
        const unsigned gen = old / nloc;
        if (old + 1u == (gen + 1u) * nloc) {
            __builtin_amdgcn_fence(__ATOMIC_RELEASE, "agent");
            asm volatile("s_waitcnt vmcnt(0)" ::: "memory");
            const unsigned og = xb_add(&bar[XB_TOP], 1u);
            const unsigned tg = og / nx;
            if (og + 1u == (tg + 1u) * nx) xb_add(&bar[XB_TOPGEN], 1u);
            else XB_SPIN(xb_ld(&bar[XB_TOPGEN]) == tg, bar);
            __builtin_amdgcn_fence(__ATOMIC_ACQUIRE, "agent");
            xb_add(&bar[XB_XGEN(b.x)], 1u);
            asm volatile("s_waitcnt vmcnt(0)" ::: "memory");
        } else {
            XB_SPIN(xb_ld(&bar[XB_XGEN(b.x)]) == gen, bar);
            __builtin_amdgcn_fence(__ATOMIC_ACQUIRE, "agent");
            asm volatile("s_waitcnt vmcnt(0)" ::: "memory");
        }
    }
    __syncthreads();
}
__device__ __forceinline__ float wave_sum(float v) {
#pragma unroll
    for (int o = 1; o < 64; o <<= 1) v += __shfl_xor(v, o);
    return v;
}
__device__ __forceinline__ void p0_transpose_item(const float* W, int K, int N, bf16* WT, int row_off, LAS float* scr, int item, int lane) {
    const int nblk = N / 32, kb = item / nblk, nb = item % nblk, k0 = 64 * kb, n0 = 32 * nb;
#pragma unroll 8
    for (int i = 0; i < 32; ++i) { const int kk = 2 * i + (lane >> 5); scr[kk * 33 + (lane & 31)] = W[(size_t)(k0 + kk) * N + n0 + (lane & 31)]; }
    LDS_WAIT(); asm volatile("" ::: "memory");
    const int c = lane & 7;
#pragma unroll
    for (int j = 0; j < 4; ++j) { const int n = (lane >> 3) + 8 * j; const LAS float* s = scr + (8 * c) * 33 + n;
        v4u o; o.x = pk2(s[0 * 33], s[1 * 33]); o.y = pk2(s[2 * 33], s[3 * 33]); o.z = pk2(s[4 * 33], s[5 * 33]); o.w = pk2(s[6 * 33], s[7 * 33]);
        *(GAS v4u*)(WT + (size_t)(row_off + n0 + n) * K + k0 + 8 * c) = o; }
    LDS_WAIT(); asm volatile("" ::: "memory");
}
struct Frame {
    LAS unsigned char* lds; volatile LAS unsigned* MISC; gu32* ctl;
    int tid, lane, wave, G;
    unsigned char* ws;
};
#define relaunder(F) do { int t_ = threadIdx.x; asm volatile("" : "+v"(t_)); (F).tid = t_; (F).lane = t_ & 63; (F).wave = __builtin_amdgcn_readfirstlane(t_ >> 6); } while (0)
typedef _Float16 half_t;
__device__ __forceinline__ float bf2f(unsigned short h) { return __builtin_bit_cast(float, (unsigned)h << 16); }
__device__ __forceinline__ float bflo(unsigned w) { return __builtin_bit_cast(float, w << 16); }
__device__ __forceinline__ float bfhi(unsigned w) { return __builtin_bit_cast(float, w & 0xffff0000u); }

__device__ __forceinline__ void p0_transpose_item2(const float* W, int K, int N, bf16* WT, LAS float* scr, int kb, int n0, int nvalid, int lane) {
    const int k0 = 64 * kb;
#pragma unroll 8
    for (int i = 0; i < 32; ++i) { const int kk = 2 * i + (lane >> 5); const int nn = lane & 31; scr[kk * 33 + nn] = (nn < nvalid) ? W[(size_t)(k0 + kk) * N + n0 + nn] : 0.f; }
    LDS_WAIT(); asm volatile("" ::: "memory");
    const int c = lane & 7;
#pragma unroll
    for (int j = 0; j < 4; ++j) { const int n = (lane >> 3) + 8 * j; const LAS float* s = scr + (8 * c) * 33 + n;
        v4u o; o.x = pk2(s[0 * 33], s[1 * 33]); o.y = pk2(s[2 * 33], s[3 * 33]); o.z = pk2(s[4 * 33], s[5 * 33]); o.w = pk2(s[6 * 33], s[7 * 33]);
        if (n < nvalid) *(GAS v4u*)(WT + (size_t)(n0 + n) * K + k0 + 8 * c) = o; }
    LDS_WAIT(); asm volatile("" ::: "memory");
}

__device__ __forceinline__ void gemv8_block(Frame& F, const float* Wm, int N, int j0, int ncols, const LAS float* atab, LAS float* part) {
    float a8[8];
#pragma unroll
    for (int b = 0; b < 8; ++b) a8[b] = 0.f;
    const int j = j0 + F.lane; const bool ok = F.lane < ncols;
    const int kbeg = F.wave * 128;
#pragma unroll 4
    for (int kk = 0; kk < 128; ++kk) { const int k = kbeg + kk; const float w = ok ? Wm[(size_t)k * N + j] : 0.f;
        const f32x4 t0 = *(const LAS f32x4*)(atab + k * 8), t1 = *(const LAS f32x4*)(atab + k * 8 + 4);
        a8[0] += t0[0] * w; a8[1] += t0[1] * w; a8[2] += t0[2] * w; a8[3] += t0[3] * w; a8[4] += t1[0] * w; a8[5] += t1[1] * w; a8[6] += t1[2] * w; a8[7] += t1[3] * w; }
#pragma unroll
    for (int b = 0; b < 8; ++b) part[(F.wave * 8 + b) * 64 + F.lane] = a8[b];
}

__device__ __forceinline__ void p0a(Frame& F, const float* const* in) {
    relaunder(F);
    const float* c = in[1]; const float* norm_g = in[2]; const float* ada_w = in[3]; const float* ada_b = in[4]; const float* lbl = in[5];
    const float* hg_w_in = in[6]; const float* hg_w_out = in[8]; const float* fx_w_in = in[9]; const float* fx_w_out = in[13];
    unsigned char* ws = F.ws;
    {
        LAS float* atab = (LAS float*)(F.lds);
        LAS float* part = (LAS float*)(F.lds + 32768);
        for (int e = F.tid; e < 8192; e += 512) { const int b = e >> 10, k = e & 1023; const float v = c[b * 1024 + k]; atab[k * 8 + b] = v / (1.0f + __expf(-v)); }
        __syncthreads();
        for (int it = blockIdx.x; it < 4 * 48; it += F.G) {
            const int l = it / 48, jb = it % 48, j0 = jb * 64;
            gemv8_block(F, ada_w + (size_t)l * 1024 * 3072, 3072, j0, 64, atab, part);
            __syncthreads();
            { const int b = F.tid >> 6, jl = F.tid & 63, j = j0 + jl; float s = ada_b[l * 3072 + j];
#pragma unroll
              for (int w = 0; w < 8; ++w) s += part[(w * 8 + b) * 64 + jl];
              const int sec = j >> 10, cc = j & 1023; const size_t o = ((size_t)l * 8 + b) * 1024 + cc;
              if (sec == 0) ((float*)(ws + WS_SH))[o] = s; else if (sec == 1) ((float*)(ws + WS_GS))[o] = norm_g[l * 1024 + cc] * (1.0f + s); else ((float*)(ws + WS_GATE))[o] = s; }
            __syncthreads();
        }
    }
    if (blockIdx.x == 0) { float* par = (float*)(ws + WS_PAR); for (int e = F.tid; e < 128; e += 512) { par[e] = in[11][e]; par[128 + e] = in[12][e]; } if (F.tid < 32) par[256 + F.tid] = in[10][F.tid]; for (int e = F.tid; e < 2048; e += 512) par[288 + e] = in[7][e]; }
    if (blockIdx.x == F.G - 1) { for (int e = F.tid; e < 1024; e += 512) { const float d = lbl[1024 + e] - lbl[e]; ((float*)(ws + WS_LB))[e] = 0.f; ((float*)(ws + WS_LB))[1024 + e] = 1.0f / (1.0f + __expf(-d)); } }
    {
        __syncthreads();
        LAS float* scr = (LAS float*)(F.lds + F.wave * 16384);
        const int gw = blockIdx.x * NWAVES + F.wave, NGW = F.G * NWAVES;
        constexpr int I_HG = 16 * 128, I_FX = 16 * 129, I_O = 16 * 32;
        constexpr int NIT = 2 * I_HG + 2 * I_FX + 4 * I_O;
        for (int it = gw; it < NIT; it += NGW) {
            int r = it;
            if (r < 2 * I_HG) { const int j = r / I_HG; r %= I_HG; p0_transpose_item2(hg_w_in + (size_t)j * 1024 * HG_IN, 1024, HG_IN, (bf16*)(ws + WS_WIN + (size_t)(2 * j) * WIN_STRIDE), scr, r / 128, (r % 128) * 32, 32, F.lane); continue; }
            r -= 2 * I_HG;
            if (r < 2 * I_FX) { const int j = r / I_FX; r %= I_FX; const int nb = r % 129; p0_transpose_item2(fx_w_in + (size_t)j * 1024 * FX_IN, 1024, FX_IN, (bf16*)(ws + WS_WIN + (size_t)(2 * j + 1) * WIN_STRIDE), scr, r / 129, nb * 32, nb == 128 ? 16 : 32, F.lane); continue; }
            r -= 2 * I_FX;
            { const int l = r / I_O; r %= I_O; const float* src = (l & 1) ? fx_w_out + (size_t)(l >> 1) * 1024 * 1024 : hg_w_out + (size_t)(l >> 1) * 1024 * 1024;
              p0_transpose_item2(src, 1024, 1024, (bf16*)(ws + WS_WOUT + (size_t)l * WOUT_STRIDE), scr, r / 32, (r % 32) * 32, 32, F.lane); }
        }
        for (int e = blockIdx.x * 512 + F.tid; e < 2 * 240 * 128; e += F.G * 512) { const int j = e / (240 * 128), q = e % (240 * 128);
            *(GAS v4u*)((bf16*)(ws + WS_WIN + (size_t)(2 * j + 1) * WIN_STRIDE) + (size_t)FX_IN * 1024 + (size_t)q * 8) = (v4u){0u, 0u, 0u, 0u}; }
    }
}

__device__ __forceinline__ void p0b(Frame& F, const float* const* in) {
    relaunder(F);
    const float* x = in[0]; const float* hg_w_in = in[6]; const float* fx_w_in = in[9];
    unsigned char* ws = F.ws;
    {
        LAS float* atab = (LAS float*)(F.lds);
        LAS float* part = (LAS float*)(F.lds + 32768);
        constexpr int NB_HG = 64, NB_FX = 68;
        for (int it = blockIdx.x; it < 2 * NB_HG + 2 * NB_FX; it += F.G) {
            int l, jb; if (it < 2 * NB_HG) { l = 2 * (it / NB_HG); jb = it % NB_HG; } else { const int r = it - 2 * NB_HG; l = 2 * (r / NB_FX) + 1; jb = r % NB_FX; }
            const bool fx = l & 1; const int N = fx ? FX_IN : HG_IN; const int j0 = jb * 64; const int ncols = (j0 + 64 <= N) ? 64 : (j0 < N ? N - j0 : 0);
            const float* Wm = fx ? fx_w_in + (size_t)(l >> 1) * 1024 * FX_IN : hg_w_in + (size_t)(l >> 1) * 1024 * HG_IN;
            const float* sh = (const float*)(ws + WS_SH) + (size_t)l * 8 * 1024;
            __syncthreads();
            for (int e = F.tid; e < 8192; e += 512) { const int b = e >> 10, k = e & 1023; atab[k * 8 + b] = sh[b * 1024 + k]; }
            __syncthreads();
            gemv8_block(F, Wm, N, j0, ncols, atab, part);
            __syncthreads();
            { const int b = F.tid >> 6, jl = F.tid & 63; float s = 0.f;
#pragma unroll
              for (int w = 0; w < 8; ++w) s += part[(w * 8 + b) * 64 + jl];
              ((float*)(ws + WS_BIAS))[((size_t)l * 8 + b) * BIAS_LD + j0 + jl] = (jl < ncols) ? s : 0.f; }
        }
    }
    {
        const int gw = blockIdx.x * NWAVES + F.wave, NGW = F.G * NWAVES;
        const float* gs = (const float*)(ws + WS_GS);
        float* rowss = (float*)(ws + WS_ROWSS);
        bf16* xs = (bf16*)(ws + WS_XS);
        for (int m = gw; m < M; m += NGW) {
            const int b = m >> 12; const GAS f32x4* xr = (const GAS f32x4*)(x + (size_t)m * 1024) + F.lane; const f32x4* gr = (const f32x4*)(gs + b * 1024) + F.lane;
            GAS unsigned long long* o8 = (GAS unsigned long long*)(xs + (size_t)m * 1024) + F.lane; float s = 0.f;
#pragma unroll
            for (int j = 0; j < 4; ++j) { const f32x4 v = xr[64 * j], g = gr[64 * j]; s += (v.x * v.x + v.y * v.y) + (v.z * v.z + v.w * v.w);
                o8[64 * j] = (unsigned long long)pk2(v.x * g.x, v.y * g.y) | ((unsigned long long)pk2(v.z * g.z, v.w * g.w) << 32); }
            s = wave_sum(s); if (F.lane == 0) rowss[m] = s;
        }
    }
}

__device__ __forceinline__ void fox_cumsum(Frame& F) {
    relaunder(F);
    unsigned char* ws = F.ws; const float* lf = (const float*)(ws + WS_LF); float* ckl = (float*)(ws + WS_CKL); bf16* kx = (bf16*)(ws + WS_KX);
    const int gw = blockIdx.x * NWAVES + F.wave, NGW = F.G * NWAVES;
    for (int bh = gw; bh < 128; bh += NGW) {
        const int b = bh >> 4, h = bh & 15; const float* p = lf + ((size_t)b * SEQ + F.lane * 64) * 16 + h;
        float sum = 0.f;
        for (int i = 0; i < 64; ++i) sum += p[i * 16];
        float incl = sum;
#pragma unroll
        for (int off = 1; off < 64; off <<= 1) { const float t = __shfl_up(incl, off); if (F.lane >= off) incl += t; }
        float run = incl - sum;
        for (int i = 0; i < 64; ++i) { run += p[i * 16]; const float c = run * LOG2E; const size_t s = (size_t)bh * SEQ + F.lane * 64 + i; ckl[s] = c;
            const float xv = -c; const unsigned h0 = f2bf(xv); const float r1 = xv - __builtin_bit_cast(float, h0 << 16); const unsigned h1 = f2bf(r1); const float r2 = r1 - __builtin_bit_cast(float, h1 << 16); const unsigned h2 = f2bf(r2);
            *(GAS v4u*)(kx + s * 8) = (v4u){h0 | (h1 << 16), h2, 0u, 0u}; }
    }
}

#if !FAST_ATTN
__device__ __forceinline__ void attn_naive(Frame& F) {
    relaunder(F);
    unsigned char* ws = F.ws;
    const bf16* Q = (const bf16*)(ws + WS_B0); const bf16* K = (const bf16*)(ws + WS_B0 + BUF_STRIDE); const bf16* V = (const bf16*)(ws + WS_B0 + 2 * BUF_STRIDE); const bf16* Z = (const bf16*)(ws + WS_B0 + 3 * BUF_STRIDE);
    const float* CKL = (const float*)(ws + WS_CKL); bf16* AO = (bf16*)(ws + WS_AO);
    LAS float* Kf = (LAS float*)(F.lds); LAS float* Vf = Kf + 4096; LAS float* ckt = Vf + 4096;
    for (int u = blockIdx.x; u < 1024; u += F.G) {
        const int qblk = 7 - (u >> 7), bh = u & 127, b = bh >> 4, h = bh & 15;
        const int t = qblk * 512 + F.tid; const size_t row = (size_t)b * SEQ + t;
        float q[64], o[64];
#pragma unroll
        for (int c8 = 0; c8 < 8; ++c8) { const v4u w = *(const GAS v4u*)(Q + row * 1024 + h * 64 + c8 * 8);
            q[c8 * 8 + 0] = bflo(w.x); q[c8 * 8 + 1] = bfhi(w.x); q[c8 * 8 + 2] = bflo(w.y); q[c8 * 8 + 3] = bfhi(w.y); q[c8 * 8 + 4] = bflo(w.z); q[c8 * 8 + 5] = bfhi(w.z); q[c8 * 8 + 6] = bflo(w.w); q[c8 * 8 + 7] = bfhi(w.w); }
#pragma unroll
        for (int d = 0; d < 64; ++d) o[d] = 0.f;
        float mx = -INFINITY, l = 0.f;
        const int ntile = (qblk + 1) * 8;
        for (int j = 0; j < ntile; ++j) {
            __syncthreads();
            { const int key = F.tid >> 3, ch = F.tid & 7; const size_t krow = (size_t)b * SEQ + j * 64 + key;
              const v4u kw = *(const GAS v4u*)(K + krow * 1024 + h * 64 + ch * 8), vw = *(const GAS v4u*)(V + krow * 1024 + h * 64 + ch * 8);
              LAS f32x4* kd = (LAS f32x4*)(Kf + key * 64 + ch * 8); LAS f32x4* vd = (LAS f32x4*)(Vf + key * 64 + ch * 8);
              kd[0] = (f32x4){bflo(kw.x), bfhi(kw.x), bflo(kw.y), bfhi(kw.y)}; kd[1] = (f32x4){bflo(kw.z), bfhi(kw.z), bflo(kw.w), bfhi(kw.w)};
              vd[0] = (f32x4){bflo(vw.x), bfhi(vw.x), bflo(vw.y), bfhi(vw.y)}; vd[1] = (f32x4){bflo(vw.z), bfhi(vw.z), bflo(vw.w), bfhi(vw.w)};
              if (F.tid < 64) ckt[F.tid] = CKL[(size_t)bh * SEQ + j * 64 + F.tid]; }
            __syncthreads();
            int kmax = t - j * 64; if (kmax > 63) kmax = 63;
            for (int key = 0; key <= kmax; ++key) {
                float s = -ckt[key];
#pragma unroll
                for (int d4 = 0; d4 < 16; ++d4) { const f32x4 kk = *(const LAS f32x4*)(Kf + key * 64 + d4 * 4); s += q[d4 * 4] * kk[0] + q[d4 * 4 + 1] * kk[1] + q[d4 * 4 + 2] * kk[2] + q[d4 * 4 + 3] * kk[3]; }
                if (s > mx) { const float a = __builtin_amdgcn_exp2f(mx - s); l *= a;
#pragma unroll
                    for (int d = 0; d < 64; ++d) o[d] *= a;
                    mx = s; }
                const float p = __builtin_amdgcn_exp2f(s - mx); l += p;
#pragma unroll
                for (int d4 = 0; d4 < 16; ++d4) { const f32x4 vv = *(const LAS f32x4*)(Vf + key * 64 + d4 * 4); o[d4 * 4] += p * vv[0]; o[d4 * 4 + 1] += p * vv[1]; o[d4 * 4 + 2] += p * vv[2]; o[d4 * 4 + 3] += p * vv[3]; }
            }
        }
        const float inv = 1.0f / l;
#pragma unroll
        for (int c8 = 0; c8 < 8; ++c8) { const v4u zw = *(const GAS v4u*)(Z + row * 1024 + h * 64 + c8 * 8); v4u w;
            w.x = pk2(o[c8 * 8 + 0] * inv * bflo(zw.x), o[c8 * 8 + 1] * inv * bfhi(zw.x)); w.y = pk2(o[c8 * 8 + 2] * inv * bflo(zw.y), o[c8 * 8 + 3] * inv * bfhi(zw.y));
            w.z = pk2(o[c8 * 8 + 4] * inv * bflo(zw.z), o[c8 * 8 + 5] * inv * bfhi(zw.z)); w.w = pk2(o[c8 * 8 + 6] * inv * bflo(zw.w), o[c8 * 8 + 7] * inv * bfhi(zw.w));
            *(GAS v4u*)(AO + row * 1024 + h * 64 + c8 * 8) = w; }
    }
}

#endif
__device__ __forceinline__ void scan_naive(Frame& F, int jlayer) {
    relaunder(F); const float* og = (const float*)(F.ws + WS_PAR) + 288 + jlayer * 1024;
    unsigned char* ws = F.ws;
    const bf16* Qb = (const bf16*)(ws + WS_B0); const half_t* Gb = (const half_t*)(ws + WS_B0 + BUF_STRIDE); const bf16* Vb = (const bf16*)(ws + WS_B0 + 2 * BUF_STRIDE); const bf16* Zb = (const bf16*)(ws + WS_B0 + 3 * BUF_STRIDE);
    bf16* AO = (bf16*)(ws + WS_AO);
    LAS float* ff = (LAS float*)(F.lds); LAS float* kk = ff + 1024; LAS float* qq = kk + 1024; LAS float* vv = qq + 1024; LAS float* po = vv + 1024;
    for (int u = blockIdx.x; u < 64; u += F.G) {
        const int b = u >> 3, h = u & 7; const int v = F.tid & 127, kq = F.tid >> 7;
        float S[32];
#pragma unroll
        for (int i = 0; i < 32; ++i) S[i] = 0.f;
        for (int tg = 0; tg < SEQ / 8; ++tg) {
            const size_t row0 = (size_t)b * SEQ + tg * 8;
#pragma unroll
            for (int r = 0; r < 2; ++r) { const int e = F.tid + 512 * r, tok = e >> 7, c = e & 127; const size_t a = (row0 + tok) * 1024 + h * 128 + c;
                const float g = (float)Gb[a]; const float f = __expf(g); ff[e] = f; kk[e] = 1.0f - f; qq[e] = bf2f(Qb[a]); vv[e] = bf2f(Vb[a]); }
            __syncthreads();
#pragma unroll 1
            for (int tok = 0; tok < 8; ++tok) {
                const float vt = vv[tok * 128 + v]; float p = 0.f;
#pragma unroll
                for (int i4 = 0; i4 < 8; ++i4) { const int k = tok * 128 + kq * 32 + i4 * 4; const f32x4 f4 = *(const LAS f32x4*)(ff + k), k4 = *(const LAS f32x4*)(kk + k), q4 = *(const LAS f32x4*)(qq + k);
#pragma unroll
                    for (int e = 0; e < 4; ++e) { S[i4 * 4 + e] = f4[e] * S[i4 * 4 + e] + k4[e] * vt; p += q4[e] * S[i4 * 4 + e]; } }
                po[(tok * 4 + kq) * 128 + v] = p;
            }
            __syncthreads();
            { const int tok = F.tid >> 6, v2 = (F.tid & 63) * 2;
              float o0 = 0.f, o1 = 0.f;
#pragma unroll
              for (int q4 = 0; q4 < 4; ++q4) { o0 += po[(tok * 4 + q4) * 128 + v2]; o1 += po[(tok * 4 + q4) * 128 + v2 + 1]; }
              const float ss = wave_sum(o0 * o0 + o1 * o1); const float rn = rsqrtf(ss * (1.0f / 128.0f) + EPS);
              const size_t a = (row0 + tok) * 1024 + h * 128 + v2; const unsigned zw = *(const GAS unsigned*)(Zb + a);
              *(GAS unsigned*)(AO + a) = pk2(o0 * rn * og[h * 128 + v2] * bflo(zw), o1 * rn * og[h * 128 + v2 + 1] * bfhi(zw)); }
        }
        __syncthreads();
    }
}

struct Args { const float* in[14]; float* out; unsigned char* ws; int ph_lo, ph_hi, li, pad; };
constexpr int N_PHASES = 2 + 4 * DEPTH;
__global__ void __launch_bounds__(NWAVES * 64, 2) fwd(Args args) {
    extern __shared__ __attribute__((aligned(16))) unsigned char lds[];
    Frame F;
    F.lds = (LAS unsigned char*)lds; F.MISC = (volatile LAS unsigned*)(F.lds + MISC_OFF);
    F.tid = threadIdx.x; F.lane = F.tid & 63; F.wave = __builtin_amdgcn_readfirstlane(F.tid >> 6); F.G = gridDim.x; F.ws = args.ws;
    F.ctl = (gu32*)(args.ws + WS_CTL);
    for (int u = F.tid; u < (LDS_BYTES - LDSCTL_OFF) / 4; u += NWAVES * 64) ((LAS unsigned*)(F.lds + LDSCTL_OFF))[u] = 0u;
    __syncthreads();
    XcdBarrier bar; bar.bar = (unsigned*)(F.ctl + CW_BAR); bar.x = 0; bar.st = nullptr;
    const bool one = (args.ph_hi - args.ph_lo) > 1;
    if (one) bar = xcd_barrier_post((unsigned*)(F.ctl + CW_BAR), F.MISC + 8);
    const int lo = args.ph_lo, hi = args.ph_hi;
#define IN(k) (lo <= (k) && (k) < hi)
#define SEAM(k) do { if (IN(k) && IN((k) + 1)) xcd_barrier(bar); } while (0)
    unsigned char* ws = args.ws;
    if (IN(0)) { p0a(F, args.in); SEAM(0); }
    if (IN(1)) { p0b(F, args.in); SEAM(1); }
    for (int p = (lo > 2 ? lo : 2); p < hi; ++p) {
        const int l = (p - 2) >> 2, sub = (p - 2) & 3, j = l >> 1; const bool fx = l & 1;
        if (sub == 0 || sub == 3) {
            const bool isout = sub == 3;
            pg8::Gemm g{(const pg8::bf16_t*)(ws + (isout ? WS_AO : WS_XS)), (const pg8::bf16_t*)(ws + (isout ? WS_WOUT + (size_t)l * WOUT_STRIDE : WS_WIN + (size_t)l * WIN_STRIDE)), M, isout ? DM : (fx ? FX_INP : HG_IN), DM};
            pg8::StaticOrder S; S.init(M, g.N, F.G, (int)blockIdx.x);
            pg8::EpiAll E; E.ws = ws; E.x0 = args.in[0]; E.xo = args.out; E.l = l; E.isout = isout ? 1 : 0;
            pg8::gemm_phase<pg8::EpiAll, pg8::StaticOrder, PG8_ALIGN, PG8_SP2>(F.lds + RING_OFF, g, S, E);
        } else if (sub == 1) {
            if (!fx) continue;
            fox_cumsum(F);
        } else {
            if (fx) {
#if FAST_ATTN
                const attn_body::AttnTensors AT{(const attn_body::bf16*)(ws + WS_B0), (const attn_body::bf16*)(ws + WS_B0 + BUF_STRIDE), (const attn_body::bf16*)(ws + WS_B0 + 2 * BUF_STRIDE),
                                                (const attn_body::bf16*)(ws + WS_KX), (const attn_body::bf16*)(ws + WS_B0 + 3 * BUF_STRIDE), (attn_body::bf16*)(ws + WS_AO)};
                const attn_body::StaticOrder SA((int)F.G, (int)blockIdx.x);
                attn_body::attn_phase<attn_body::StaticOrder>((char*)lds + RING_OFF, AT, SA);
#else
                attn_naive(F);
#endif
            } else scan_naive(F, j);
        }
        if (p + 1 < hi) xcd_barrier(bar);
    }
#undef IN
#undef SEAM
}

extern "C" void kernel_launch(void* const* d_in, const int* in_sizes, int n_in, void* d_out, int out_size, void* d_ws, size_t ws_size, hipStream_t stream) {
    static int grid = 0;
    if (grid == 0) {
        if (n_in != 14 || in_sizes[0] != M * DM || out_size != M * DM || ws_size < WS_END) { fprintf(stderr, "kernel_launch: unexpected shapes (n_in %d, in0 %d, out %d, ws %zu); nothing launched\n", n_in, n_in > 0 ? in_sizes[0] : -1, out_size, ws_size); grid = -1; return; }
        int dev = 0, cus = 0, per_cu = 0;
        if (hipGetDevice(&dev) != hipSuccess || hipDeviceGetAttribute(&cus, hipDeviceAttributeMultiprocessorCount, dev) != hipSuccess) { grid = -1; return; }
        if (hipFuncSetAttribute((const void*)fwd, hipFuncAttributeMaxDynamicSharedMemorySize, LDS_BYTES) != hipSuccess) { fprintf(stderr, "kernel_launch: hipFuncSetAttribute failed\n"); grid = -1; return; }
        if (hipOccupancyMaxActiveBlocksPerMultiprocessor(&per_cu, (const void*)fwd, NWAVES * 64, LDS_BYTES) != hipSuccess || per_cu < 1) fprintf(stderr, "kernel_launch: note: occupancy query reports %d workgroups per CU\n", per_cu);
        (void)hipGetLastError();
        grid = cus;
    }
    if (grid < 0) return;
    if (hipMemsetAsync((char*)d_ws + WS_CTL, 0, CTL_ZERO_BYTES, stream) != hipSuccess) { fprintf(stderr, "kernel_launch: hipMemsetAsync failed\n"); return; }
    Args a{};
    for (int i = 0; i < 14; ++i) a.in[i] = (const float*)d_in[i];
    a.out = (float*)d_out; a.ws = (unsigned char*)d_ws; a.li = 0; a.pad = 0;
#if MK_ONE_LAUNCH
    a.ph_lo = 0; a.ph_hi = N_PHASES;
    hipLaunchKernelGGL(fwd, dim3(grid), dim3(NWAVES * 64), LDS_BYTES, stream, a);
#else
    for (int p = 0; p < N_PHASES; ++p) {
        if (p >= 2 && ((p - 2) & 3) == 1 && (((p - 2) >> 2) & 1) == 0) continue;
        a.ph_lo = p; a.ph_hi = p + 1;
        hipLaunchKernelGGL(fwd, dim3(grid), dim3(NWAVES * 64), LDS_BYTES, stream, a);
    }
#endif
    const hipError_t le = hipPeekAtLastError();
    if (le != hipSuccess) fprintf(stderr, "kernel_launch: launch failed: %s\n", hipGetErrorName(le));
}
```

```cpp
#include <hip/hip_runtime.h>
#include <hip/hip_bf16.h>
#include <cstdio>
#include <cstdint>
#include <cmath>
#ifndef MK_ONE_LAUNCH
#define MK_ONE_LAUNCH 1
#endif
#ifndef FAST_ATTN
#define FAST_ATTN 1
#endif
#ifndef FAST_SCAN
#define FAST_SCAN 1
#endif
#ifndef SCAN_CHECK
#define SCAN_CHECK 0
#endif
constexpr int BATCH = 8, SEQ = 4096, DM = 1024, M = BATCH * SEQ, DEPTH = 4;
constexpr int HG_H = 8, HG_DK = 128, HG_IN = 4096;
constexpr int FX_H = 16, FX_HD = 64, FX_IN = 4112, FX_INP = 4352;
constexpr float EPS = 1e-6f;
constexpr float LOG2E = 1.4426950408889634f;
constexpr float C2 = 0.125f * LOG2E;

namespace pg8 {
#define PG8_LAS __attribute__((address_space(3)))
typedef unsigned short bf16_t;
typedef short bf16x8 __attribute__((ext_vector_type(8)));
typedef float f32x4 __attribute__((ext_vector_type(4)));
typedef unsigned u32x4 __attribute__((ext_vector_type(4)));
constexpr int BM = 256, BK = 64, HALF = 128, HTB = HALF * BK * 2  , STAGE_BYTES = 8 * HTB, NXCD = 8, WGM = 8;

__host__ __device__ __forceinline__ int lds_byte(int r, int c) { const int st = (r >> 4) * 2 + (c >> 5), rr = r & 15, cc = c & 31, ob = rr * 64 + cc * 2; return st * 1024 + (ob ^ (((ob >> 9) & 1) << 5)); }
__host__ __device__ __forceinline__ void stage_rc(int b, int& R, int& C) { const int st = b / 1024, sb = b % 1024, swz = sb ^ (((sb >> 9) & 1) << 5); R = (st >> 1) * 16 + swz / 64; C = (st & 1) * 32 + (swz % 64) / 2; }
__host__ __device__ __forceinline__ int perm32(int rho) { const int n = rho >> 4, i = rho & 15; return 8 * (i >> 2) + 4 * n + (i & 3); }

struct Unit { int pm, pn; };
struct Gemm { const bf16_t* A; const bf16_t* Bt; int M, N, K; };

struct StaticOrder {
    int nM, nN, nwg, G, c;
    __host__ __device__ void init(int M, int N, int G_, int c_) { nM = M / BM; nN = N / BM; nwg = nM * nN; G = G_; c = c_; }
    __host__ __device__ bool next(int i, Unit& u) const {
        const long L = (long)i * G + c; if (L >= nwg) return false;
        int wgid = (int)L; { const int q = nwg / NXCD, r = nwg % NXCD, xcd = wgid % NXCD, off = wgid / NXCD; wgid = (xcd < r ? xcd * (q + 1) : r * (q + 1) + (xcd - r) * q) + off; }
        const int nig = WGM * nN, gid = wgid / nig, fm = gid * WGM, gsz = (nM - fm) < WGM ? (nM - fm) : WGM;
        u.pm = fm + ((wgid % nig) % gsz); u.pn = (wgid % nig) / gsz; return true;
    }
    __device__ __forceinline__ void a_ready(const Unit&) const {}
    __device__ __forceinline__ void done(const Unit&) const {}
};
template <class Epi, class Sched, bool ALIGN_EPI = false, bool SP2 = false>
__device__ __forceinline__ void gemm_phase(PG8_LAS unsigned char* lds, const Gemm g, const Sched& S, const Epi& E) {
    const int tid = threadIdx.x, wid = __builtin_amdgcn_readfirstlane(tid >> 6), lane = tid & 63, wr = wid >> 2, wc = wid & 3, fr = lane & 15, fq = lane >> 4;
    const int K = g.K, nt = K / BK;
    unsigned voffA[2], voffB[2];
#pragma unroll
    for (int i = 0; i < 2; ++i) { int R, C; stage_rc(tid * 16 + i * 8192, R, C); const int Rb = Epi::PMODE == 2 ? (64 * (R >> 5) + perm32(R & 31)) : (Epi::PMODE == 1 ? ((R & ~31) + perm32(R & 31)) : R);
        voffA[i] = (unsigned)(R * K + C) * 2u; voffB[i] = (unsigned)(Rb * K + C) * 2u; }
    const size_t kstep = (size_t)(BK * 2);
    const size_t hstep = (size_t)HALF * K * 2;
    const size_t hstepB = (Epi::PMODE == 2) ? (size_t)32 * K * 2 : hstep;
    const size_t tstep = 2 * hstep;
    const unsigned ldsw = (unsigned)wid * 1024u;
    const int aoff = lds_byte(wr * 64 + fr, fq * 8), boff = lds_byte(wc * 32 + fr, fq * 8);
#define PG8_SA(b, h) (((b) * 2 + (h)) * HTB)
#define PG8_SB(b, h) ((4 + (b) * 2 + (h)) * HTB)
#define PG8_STAGE(bufoff, gbase, voff) do { _Pragma("unroll") for (int _i = 0; _i < 2; ++_i) \
        __builtin_amdgcn_global_load_lds((const unsigned*)((const char*)(gbase) + (voff)[_i]), (PG8_LAS unsigned*)(lds + (bufoff) + ldsw + _i * 8192), 16, 0, 0); } while (0)
#define PG8_LDA(dst, b, h) do { _Pragma("unroll") for (int m = 0; m < 4; ++m) _Pragma("unroll") for (int k = 0; k < 2; ++k) dst[m][k] = *(const PG8_LAS bf16x8*)(lds + PG8_SA(b, h) + aoff + m * 2048 + k * 1024); } while (0)
#define PG8_LDB(dst, b, h) do { _Pragma("unroll") for (int n = 0; n < 2; ++n) _Pragma("unroll") for (int k = 0; k < 2; ++k) dst[n][k] = *(const PG8_LAS bf16x8*)(lds + PG8_SB(b, h) + boff + n * 2048 + k * 1024); } while (0)
#define PG8_MMA(ai, bj, At, Bt) do { __builtin_amdgcn_s_setprio(1); _Pragma("unroll") for (int m = 0; m < 4; ++m) _Pragma("unroll") for (int n = 0; n < 2; ++n) _Pragma("unroll") for (int k = 0; k < 2; ++k) \
        acc[ai][bj][m][n] = __builtin_amdgcn_mfma_f32_16x16x32_bf16(Bt[n][k], At[m][k], acc[ai][bj][m][n], 0, 0, 0); __builtin_amdgcn_s_setprio(0); } while (0)
#define PG8_WAIT_V(n) asm volatile("s_waitcnt vmcnt(" #n ")" ::: "memory")
#define PG8_WAIT_L(n) asm volatile("s_waitcnt lgkmcnt(" #n ")" ::: "memory")
#define PG8_BAR __builtin_amdgcn_s_barrier()
#define PG8_SCHED __builtin_amdgcn_sched_barrier(0)
    Unit cur, nxt; int ui = 0;
    if (!S.next(0, cur)) return;
    f32x4 acc[2][2][4][2];
#pragma unroll
    for (int a = 0; a < 2; ++a)
#pragma unroll
        for (int b = 0; b < 2; ++b)
#pragma unroll
            for (int m = 0; m < 4; ++m)
#pragma unroll
                for (int n = 0; n < 2; ++n) acc[a][b][m][n] = (f32x4){0.f, 0.f, 0.f, 0.f};
    bf16x8 At[4][2], B0[2][2], B1[2][2];
    const char* cA = (const char*)g.A + (size_t)cur.pm * tstep; const char* cB = (const char*)g.Bt + (size_t)cur.pn * tstep;
    S.a_ready(cur);
    if constexpr (SP2) {
        PG8_STAGE(PG8_SB(0, 0), cB, voffB); PG8_STAGE(PG8_SB(0, 1), cB + hstepB, voffB); PG8_STAGE(PG8_SA(0, 0), cA, voffA); PG8_STAGE(PG8_SA(0, 1), cA + hstep, voffA);
        if (wr == 1) PG8_BAR;
        PG8_WAIT_V(2); PG8_BAR;
        PG8_STAGE(PG8_SB(1, 0), cB + kstep, voffB); PG8_STAGE(PG8_SA(1, 0), cA + kstep, voffA); PG8_STAGE(PG8_SB(1, 1), cB + hstepB + kstep, voffB);
        PG8_WAIT_V(6); PG8_BAR;
    } else {
        PG8_STAGE(PG8_SB(0, 0), cB, voffB); PG8_STAGE(PG8_SA(0, 0), cA, voffA); PG8_STAGE(PG8_SB(0, 1), cB + hstepB, voffB); PG8_STAGE(PG8_SA(0, 1), cA + hstep, voffA);
        if (wr == 1) PG8_BAR;
        PG8_WAIT_V(4); PG8_BAR;
        PG8_STAGE(PG8_SB(1, 0), cB + kstep, voffB); PG8_STAGE(PG8_SA(1, 0), cA + kstep, voffA); PG8_STAGE(PG8_SB(1, 1), cB + hstepB + kstep, voffB);
        PG8_WAIT_V(6); PG8_BAR;
    }
    for (;;) {
        const bool has_next = S.next(ui + 1, nxt);
        const char* nA = has_next ? (const char*)g.A + (size_t)nxt.pm * tstep : cA; const char* nB = has_next ? (const char*)g.Bt + (size_t)nxt.pn * tstep : cB;
        for (int t = 0; t < nt; t += 2) {
            const bool last = (t == nt - 2);
            const char* a1 = cA + (size_t)(t + 1) * kstep;
            const char* a2 = last ? nA : cA + (size_t)(t + 2) * kstep; const char* b2 = last ? nB : cB + (size_t)(t + 2) * kstep;
            const char* a3 = a2 + kstep; const char* b3 = b2 + kstep;
            if (last && has_next) S.a_ready(nxt);
            if constexpr (SP2) {
            PG8_LDB(B0, 0, 0); PG8_LDB(B1, 0, 1); PG8_SCHED; PG8_LDA(At, 0, 0); PG8_STAGE(PG8_SA(1, 1), a1 + hstep, voffA);
            PG8_WAIT_V(8); PG8_WAIT_L(0); PG8_BAR; PG8_MMA(0, 0, At, B0); PG8_MMA(0, 1, At, B1); PG8_BAR; PG8_SCHED;
            PG8_LDA(At, 0, 1); PG8_STAGE(PG8_SB(0, 0), b2, voffB); PG8_STAGE(PG8_SB(0, 1), b2 + hstepB, voffB); PG8_STAGE(PG8_SA(0, 0), a2, voffA);
            PG8_WAIT_V(8); PG8_WAIT_L(0); PG8_BAR; PG8_MMA(1, 0, At, B0); PG8_MMA(1, 1, At, B1); PG8_BAR; PG8_SCHED;
            PG8_LDB(B0, 1, 0); PG8_LDB(B1, 1, 1); PG8_SCHED; PG8_LDA(At, 1, 0); PG8_STAGE(PG8_SA(0, 1), a2 + hstep, voffA);
            PG8_WAIT_V(8); PG8_WAIT_L(0); PG8_BAR; PG8_MMA(0, 0, At, B0); PG8_MMA(0, 1, At, B1); PG8_BAR; PG8_SCHED;
            PG8_LDA(At, 1, 1); PG8_STAGE(PG8_SB(1, 0), b3, voffB); PG8_STAGE(PG8_SB(1, 1), b3 + hstepB, voffB); PG8_STAGE(PG8_SA(1, 0), a3, voffA);
            PG8_WAIT_V(8); PG8_WAIT_L(0); PG8_BAR; PG8_MMA(1, 0, At, B0); PG8_MMA(1, 1, At, B1); PG8_BAR; PG8_SCHED;
            } else {
            PG8_LDB(B0, 0, 0); PG8_SCHED; PG8_LDA(At, 0, 0); PG8_STAGE(PG8_SA(1, 1), a1 + hstep, voffA);
            PG8_WAIT_L(8); PG8_BAR; PG8_WAIT_L(0); PG8_MMA(0, 0, At, B0); PG8_BAR; PG8_SCHED;
            PG8_LDB(B1, 0, 1); PG8_STAGE(PG8_SB(0, 0), b2, voffB);
            PG8_BAR; PG8_WAIT_L(0); PG8_MMA(0, 1, At, B1); PG8_BAR;
            PG8_LDA(At, 0, 1); PG8_STAGE(PG8_SA(0, 0), a2, voffA);
            PG8_BAR; PG8_WAIT_L(0); PG8_MMA(1, 0, At, B0); PG8_BAR; PG8_SCHED;
            PG8_STAGE(PG8_SB(0, 1), b2 + hstepB, voffB);
            PG8_WAIT_V(6); PG8_BAR; PG8_MMA(1, 1, At, B1); PG8_BAR;
            PG8_LDB(B0, 1, 0); PG8_SCHED; PG8_LDA(At, 1, 0); PG8_STAGE(PG8_SA(0, 1), a2 + hstep, voffA);
            PG8_WAIT_L(8); PG8_BAR; PG8_WAIT_L(0); PG8_MMA(0, 0, At, B0); PG8_BAR; PG8_SCHED;
            PG8_LDB(B1, 1, 1); PG8_STAGE(PG8_SB(1, 0), b3, voffB);
            PG8_BAR; PG8_WAIT_L(0); PG8_MMA(0, 1, At, B1); PG8_BAR;
            PG8_LDA(At, 1, 1); PG8_STAGE(PG8_SA(1, 0), a3, voffA);
            PG8_BAR; PG8_WAIT_L(0); PG8_MMA(1, 0, At, B0); PG8_BAR; PG8_SCHED;
            PG8_STAGE(PG8_SB(1, 1), b3 + hstepB, voffB);
            PG8_WAIT_V(6); PG8_BAR; PG8_MMA(1, 1, At, B1); PG8_BAR;
            }
        }
        if constexpr (ALIGN_EPI) { if (wr == 0) PG8_BAR; }
        if constexpr (!Epi::AFTER_DRAIN) { E(acc, cur, wr, wc, fr, fq); S.done(cur); }
        if (!has_next) break;
#pragma unroll
        for (int a = 0; a < 2; ++a)
#pragma unroll
            for (int b = 0; b < 2; ++b)
#pragma unroll
                for (int m = 0; m < 4; ++m)
#pragma unroll
                    for (int n = 0; n < 2; ++n) acc[a][b][m][n] = (f32x4){0.f, 0.f, 0.f, 0.f};
        cur = nxt; cA = nA; cB = nB; ++ui;
        if constexpr (ALIGN_EPI) { if (wr == 1) PG8_BAR; }
    }
    PG8_WAIT_V(0);
    if constexpr (!ALIGN_EPI) { if (wr == 0) PG8_BAR; }
    PG8_BAR;
    if constexpr (Epi::AFTER_DRAIN) { E.fused(acc, cur, wr, wc, fr, fq, lds, wid, lane); S.done(cur); }
#undef PG8_SA
#undef PG8_SB
#undef PG8_STAGE
#undef PG8_LDA
#undef PG8_LDB
#undef PG8_MMA
#undef PG8_WAIT_V
#undef PG8_WAIT_L
#undef PG8_BAR
#undef PG8_SCHED
}
}

#ifndef PG8_SP2
#define PG8_SP2 true
#endif
#ifndef PG8_ALIGN
#define PG8_ALIGN true
#endif
constexpr size_t MiB = 1u << 20;
constexpr size_t WS_CTL = 0, CTL_ZERO_BYTES = 1 * MiB;
constexpr size_t WS_ROWSS = 65536;
constexpr size_t WS_WIN = 4 * MiB, WIN_STRIDE = 10 * MiB;
constexpr size_t WS_WOUT = 44 * MiB, WOUT_STRIDE = 2 * MiB;
constexpr size_t WS_XS = 64 * MiB;
constexpr size_t WS_B0 = 128 * MiB, BUF_STRIDE = 64 * MiB;
constexpr size_t WS_AO = 384 * MiB;
constexpr size_t WS_MISC = 448 * MiB;
constexpr size_t WS_GS = WS_MISC, WS_SH = WS_MISC + 128 * 1024, WS_GATE = WS_MISC + 256 * 1024, WS_LB = WS_MISC + 384 * 1024;
constexpr size_t WS_PAR = WS_MISC + 400 * 1024;
constexpr size_t WS_BIAS = WS_MISC + 1 * MiB;
constexpr size_t WS_LF = WS_MISC + 2 * MiB;
constexpr size_t WS_CKL = WS_MISC + 4 * MiB;
constexpr size_t WS_KX = WS_MISC + 6 * MiB;
constexpr size_t WS_SLOC = WS_MISC + 16 * MiB;
constexpr size_t WS_DTOT = WS_MISC + 32 * MiB;
constexpr size_t WS_END = WS_MISC + 34 * MiB;
constexpr int CW_TMO = 0, CW_CODE = 1, CW_BAR = 4096;
constexpr int BIAS_LD = FX_INP;

constexpr int RING_OFF = 0, RING_BYTES = 131072;
constexpr int LDSCTL_OFF = RING_BYTES, MISC_OFF = LDSCTL_OFF + 320;
constexpr int LDS_BYTES = 147456;
constexpr int NWAVES = 8;

namespace pg8 {
#define PG8_GAS __attribute__((address_space(1)))
__device__ __forceinline__ unsigned cvt_pk_bf16(float lo, float hi) { unsigned r; asm volatile("v_cvt_pk_bf16_f32 %0, %1, %2" : "=v"(r) : "v"(lo), "v"(hi)); return r; }
typedef _Float16 f16x2 __attribute__((ext_vector_type(2)));
__device__ __forceinline__ unsigned cvt_pk_f16(float lo, float hi) { f16x2 v = {(_Float16)lo, (_Float16)hi}; return __builtin_bit_cast(unsigned, v); }
__device__ __forceinline__ float fast_sigmoid(float v) { return __builtin_amdgcn_rcpf(1.0f + __expf(-v)); }
__device__ __forceinline__ float log_sigmoid(float v) { return fminf(v, 0.f) - __logf(1.0f + __expf(-fabsf(v))); }

struct EpiAll {
    static constexpr int PMODE = 2; static constexpr bool AFTER_DRAIN = false;
    unsigned char* ws; const float* x0; float* xo; int l; int isout;
    __device__ __forceinline__ void operator()(const f32x4 (&acc)[2][2][4][2], const Unit& u, int wr_, int wc_, int fr_, int fq_) const {
        if (isout) epi_out(acc, u, wr_, wc_, fr_, fq_); else epi_in(acc, u, wr_, wc_, fr_, fq_);
    }
    __device__ __forceinline__ void epi_in(const f32x4 (&acc)[2][2][4][2], const Unit& u, int wr_, int wc_, int fr_, int fq_) const {
        unsigned char* w = ws; int wr = wr_, wc = wc_, fr = fr_, fq = fq_, ll = l;
        asm volatile("" : "+s"(w), "+s"(ll), "+s"(wr), "+s"(wc), "+v"(fr), "+v"(fq));
        const int kind = ll & 1, jj = ll >> 1;
        const PG8_GAS float* rowss = (const PG8_GAS float*)(w + WS_ROWSS) + (size_t)ll * M;
        const int nb = BIAS_LD; const PG8_GAS float* bias = (const PG8_GAS float*)(w + WS_BIAS) + (size_t)ll * 8 * BIAS_LD;
        PG8_GAS bf16_t* obase = (PG8_GAS bf16_t*)(w + WS_B0); const size_t ostride = BUF_STRIDE / 2;
        const PG8_GAS float* lb = (kind == 0 && jj > 0) ? (const PG8_GAS float*)(w + WS_LB) + jj * 1024 : nullptr;
        const PG8_GAS float* qg = (const PG8_GAS float*)(w + WS_PAR) + jj * 64; const PG8_GAS float* kg = (const PG8_GAS float*)(w + WS_PAR) + 128 + jj * 64; const PG8_GAS float* bfg = (const PG8_GAS float*)(w + WS_PAR) + 256 + jj * 16;
        PG8_GAS float* lf = (PG8_GAS float*)(w + WS_LF);
        const int t = u.pn >> 2, b = u.pm >> 4;
        const int crel = 64 * wc + 8 * fq, gcol0 = u.pn * 256 + crel, ocol0 = (u.pn & 3) * 256 + crel;
        f32x4 bv[2][2], pv[2][2];
#pragma unroll
        for (int bj = 0; bj < 2; ++bj)
#pragma unroll
            for (int n = 0; n < 2; ++n) {
                bv[bj][n] = *(const PG8_GAS f32x4*)(bias + (size_t)b * nb + gcol0 + 32 * bj + 4 * n);
                pv[bj][n] = (f32x4){0.f, 0.f, 0.f, 0.f};
                if (kind == 0) { if (t == 1 && lb) pv[bj][n] = *(const PG8_GAS f32x4*)(lb + ocol0 + 32 * bj + 4 * n); }
                else { if (t == 0) pv[bj][n] = *(const PG8_GAS f32x4*)(qg + 32 * bj + 8 * fq + 4 * n) * C2; else if (t == 1) pv[bj][n] = *(const PG8_GAS f32x4*)(kg + 32 * bj + 8 * fq + 4 * n); }
            }
        PG8_GAS bf16_t* ob = obase + (size_t)(t & 3) * ostride;
#pragma unroll
        for (int ai = 0; ai < 2; ++ai)
#pragma unroll
            for (int m = 0; m < 4; ++m) {
                const int row = u.pm * 256 + ai * 128 + wr * 64 + m * 16 + fr;
                const float rstd = rsqrtf(rowss[row] * (1.0f / 1024.0f) + EPS);
                f32x4 v[2][2];
#pragma unroll
                for (int bj = 0; bj < 2; ++bj)
#pragma unroll
                    for (int n = 0; n < 2; ++n) v[bj][n] = acc[ai][bj][m][n] * rstd + bv[bj][n];
                if (kind == 1 && t == 4) {
                    if (wc == 0 && fq < 2) {
#pragma unroll
                        for (int n = 0; n < 2; ++n) { const f32x4 bb = *(const PG8_GAS f32x4*)(bfg + 8 * fq + 4 * n); f32x4 o;
#pragma unroll
                            for (int e = 0; e < 4; ++e) o[e] = log_sigmoid(v[0][n][e] + bb[e]);
                            *(PG8_GAS f32x4*)(lf + (size_t)row * 16 + 8 * fq + 4 * n) = o; }
                    }
                    continue;
                }
                bool half16 = false;
                if (kind == 0) {
                    if (t == 1) {
                        half16 = true;
#pragma unroll
                        for (int bj = 0; bj < 2; ++bj)
#pragma unroll
                            for (int n = 0; n < 2; ++n)
#pragma unroll
                                for (int e = 0; e < 4; ++e) { const float fl = v[bj][n][e];
                                    v[bj][n][e] = lb ? __logf(pv[bj][n][e] + (1.0f - pv[bj][n][e]) * fast_sigmoid(fl)) : log_sigmoid(fl); }
                    } else if (t == 3) {
#pragma unroll
                        for (int bj = 0; bj < 2; ++bj)
#pragma unroll
                            for (int n = 0; n < 2; ++n)
#pragma unroll
                                for (int e = 0; e < 4; ++e) { const float z = v[bj][n][e]; v[bj][n][e] = z * fast_sigmoid(z); }
                    }
                } else {
                    if (t <= 1) {
                        float ss = 0.f;
#pragma unroll
                        for (int bj = 0; bj < 2; ++bj)
#pragma unroll
                            for (int n = 0; n < 2; ++n) { const f32x4 x = v[bj][n]; ss += (x[0] * x[0] + x[1] * x[1]) + (x[2] * x[2] + x[3] * x[3]); }
                        ss += __shfl_xor(ss, 16); ss += __shfl_xor(ss, 32);
                        const float rn = rsqrtf(ss * (1.0f / 64.0f) + EPS);
#pragma unroll
                        for (int bj = 0; bj < 2; ++bj)
#pragma unroll
                            for (int n = 0; n < 2; ++n) v[bj][n] = v[bj][n] * rn * pv[bj][n];
                    } else if (t == 3) {
#pragma unroll
                        for (int bj = 0; bj < 2; ++bj)
#pragma unroll
                            for (int n = 0; n < 2; ++n)
#pragma unroll
                                for (int e = 0; e < 4; ++e) { const float z = v[bj][n][e]; v[bj][n][e] = z * fast_sigmoid(z); }
                    }
                }
                PG8_GAS bf16_t* rowp = ob + (size_t)row * 1024 + ocol0;
#pragma unroll
                for (int bj = 0; bj < 2; ++bj) { u32x4 w;
                    if (half16) { w.x = cvt_pk_f16(v[bj][0][0], v[bj][0][1]); w.y = cvt_pk_f16(v[bj][0][2], v[bj][0][3]); w.z = cvt_pk_f16(v[bj][1][0], v[bj][1][1]); w.w = cvt_pk_f16(v[bj][1][2], v[bj][1][3]); }
                    else { w.x = cvt_pk_bf16(v[bj][0][0], v[bj][0][1]); w.y = cvt_pk_bf16(v[bj][0][2], v[bj][0][3]); w.z = cvt_pk_bf16(v[bj][1][0], v[bj][1][1]); w.w = cvt_pk_bf16(v[bj][1][2], v[bj][1][3]); }
                    *(PG8_GAS u32x4*)(rowp + 32 * bj) = w; }
            }
    }

    __device__ __forceinline__ void epi_out(const f32x4 (&acc)[2][2][4][2], const Unit& u, int wr_, int wc_, int fr_, int fq_) const {
        unsigned char* w = ws; int wr = wr_, wc = wc_, fr = fr_, fq = fq_, ll = l; const float* xin_ = (l == 0) ? x0 : xo; float* xout_ = xo;
        asm volatile("" : "+s"(w), "+s"(ll), "+s"(wr), "+s"(wc), "+v"(fr), "+v"(fq), "+s"(xin_), "+s"(xout_));
        const PG8_GAS float* xin = (const PG8_GAS float*)xin_; PG8_GAS float* xout = (PG8_GAS float*)xout_;
        const PG8_GAS float* gate = (const PG8_GAS float*)(w + WS_GATE) + (size_t)ll * 8 * 1024;
        const PG8_GAS float* gsn = (ll + 1 < DEPTH) ? (const PG8_GAS float*)(w + WS_GS) + (size_t)(ll + 1) * 8 * 1024 : nullptr;
        PG8_GAS bf16_t* xs = (PG8_GAS bf16_t*)(w + WS_XS); float* rowssn = (float*)(w + WS_ROWSS) + (size_t)(ll + 1 < DEPTH ? ll + 1 : 0) * M;
        const int b = u.pm >> 4, col0 = u.pn * 256 + 64 * wc + 8 * fq;
        f32x4 gv[2][2], sv[2][2];
#pragma unroll
        for (int bj = 0; bj < 2; ++bj)
#pragma unroll
            for (int n = 0; n < 2; ++n) { gv[bj][n] = *(const PG8_GAS f32x4*)(gate + b * 1024 + col0 + 32 * bj + 4 * n);
                sv[bj][n] = gsn ? *(const PG8_GAS f32x4*)(gsn + b * 1024 + col0 + 32 * bj + 4 * n) : (f32x4){0.f, 0.f, 0.f, 0.f}; }
#pragma unroll
        for (int ai = 0; ai < 2; ++ai)
#pragma unroll
            for (int m = 0; m < 4; ++m) {
                const int row = u.pm * 256 + ai * 128 + wr * 64 + m * 16 + fr; float ss = 0.f;
#pragma unroll
                for (int bj = 0; bj < 2; ++bj) { const size_t off = (size_t)row * 1024 + col0 + 32 * bj;
                    const f32x4 y0 = *(const PG8_GAS f32x4*)(xin + off) + gv[bj][0] * acc[ai][bj][m][0], y1 = *(const PG8_GAS f32x4*)(xin + off + 4) + gv[bj][1] * acc[ai][bj][m][1];
                    *(PG8_GAS f32x4*)(xout + off) = y0; *(PG8_GAS f32x4*)(xout + off + 4) = y1;
                    ss += (y0[0] * y0[0] + y0[1] * y0[1]) + (y0[2] * y0[2] + y0[3] * y0[3]) + (y1[0] * y1[0] + y1[1] * y1[1]) + (y1[2] * y1[2] + y1[3] * y1[3]);
                    if (gsn) { const f32x4 a0 = y0 * sv[bj][0], a1 = y1 * sv[bj][1]; u32x4 w; w.x = cvt_pk_bf16(a0[0], a0[1]); w.y = cvt_pk_bf16(a0[2], a0[3]); w.z = cvt_pk_bf16(a1[0], a1[1]); w.w = cvt_pk_bf16(a1[2], a1[3]);
                        *(PG8_GAS u32x4*)(xs + off) = w; } }
                if (gsn) { ss += __shfl_xor(ss, 16); ss += __shfl_xor(ss, 32); if (fq == 0) atomicAdd(rowssn + row, ss); }
            }
    }
};
}
#include <hip/hip_bf16.h>
#include <cmath>
namespace attn_body {
using bf16=__hip_bfloat16;
using bf16x8=__attribute__((ext_vector_type(8)))short;
using s16x4=__attribute__((ext_vector_type(4)))short;
using f32x16=__attribute__((ext_vector_type(16)))float;
using u32x4=__attribute__((ext_vector_type(4)))unsigned;
constexpr int BATCH=8,NHEAD=16,SEQ=4096,D=64,DM=NHEAD*D;
constexpr int NW=8,QBLK=32,QB=QBLK*NW,KVBLK=64,NQB=SEQ/QB;
constexpr int ATTN_PITCH=DM, ATTN_UNIT_ROWS=QB;
__device__ __forceinline__ int crow(int r,int hi){return (r&3)+8*(r>>2)+4*hi;}
#define SBAR() __builtin_amdgcn_sched_barrier(0)
__device__ __forceinline__ void cmask(f32x16&p0,f32x16&p1,int jb,int qrel,int hi){
  const float NEG=-INFINITY; int kb=64*jb+4*hi;
  #pragma unroll
  for(int r=0;r<16;++r){int kv=kb+(r&3)+8*(r>>2); if(kv>qrel)p0[r]=NEG; if(kv+32>qrel)p1[r]=NEG;}
}

constexpr int NSLOT=3, SLOTB=8192;
constexpr int LDS_K=0, LDS_V=NSLOT*SLOTB, LDS_KX=2*NSLOT*SLOTB, LDS_WS=LDS_KX+4*1024, LDS_OST=LDS_WS+NW*64*4, LDS_BYTES=LDS_OST+NW*4096;
constexpr float C2=0.125f*1.4426950408889634f;
__device__ __forceinline__ void glds16(const void*sbase,unsigned voff,unsigned lds_dst){unsigned keep;
  asm volatile("s_mov_b32 %0, m0\n\ts_mov_b32 m0, %3\n\ts_nop 0\n\tglobal_load_lds_dwordx4 %1, %2\n\ts_mov_b32 m0, %0":"=&s"(keep):"v"(voff),"s"(sbase),"s"(lds_dst):"memory");}
__device__ __forceinline__ float max3f(float a,float b,float c){float r;asm("v_max3_f32 %0, %1, %2, %3":"=v"(r):"v"(a),"v"(b),"v"(c));return r;}
__device__ __forceinline__ float max2f(float a,float b){float r;asm("v_max_f32_e32 %0, %1, %2":"=v"(r):"v"(a),"v"(b));return r;}
__device__ __forceinline__ float fadd_s(float a,float b){float r;asm("v_add_f32_e32 %0, %1, %2":"=v"(r):"v"(a),"v"(b));return r;}
__device__ __forceinline__ float fsub_s(float a,float b){float r;asm("v_sub_f32_e32 %0, %1, %2":"=v"(r):"v"(a),"v"(b));return r;}
typedef float f32x2_t __attribute__((ext_vector_type(2))); typedef __bf16 bf16x2_t __attribute__((ext_vector_type(2)));
__device__ __forceinline__ unsigned cvtpk_s(float lo,float hi){f32x2_t v={lo,hi};bf16x2_t b=__builtin_convertvector(v,bf16x2_t);return __builtin_bit_cast(unsigned,b);}
#define WAIT_BAR(N) asm volatile("s_waitcnt vmcnt(" #N ") lgkmcnt(0)\n\ts_barrier":::"memory")

__device__ __forceinline__ void qkt(f32x16&p0,f32x16&p1,const char*Kslot,const char*KXslot,const bf16x8*qr,const f32x16&negm,int r32,int hi){
  const char*kb=Kslot+hi*1024+r32*16;
  #pragma unroll
  for(int d0=0;d0<4;++d0){
    const bf16x8 b0=*reinterpret_cast<const bf16x8*>(kb+d0*2048);
    const bf16x8 b1=*reinterpret_cast<const bf16x8*>(kb+d0*2048+512);
    if(d0==0){p0=__builtin_amdgcn_mfma_f32_32x32x16_bf16(b0,qr[0],negm,0,0,0);p1=__builtin_amdgcn_mfma_f32_32x32x16_bf16(b1,qr[0],negm,0,0,0);}
    else{p0=__builtin_amdgcn_mfma_f32_32x32x16_bf16(b0,qr[d0],p0,0,0,0);p1=__builtin_amdgcn_mfma_f32_32x32x16_bf16(b1,qr[d0],p1,0,0,0);}}
  { const bf16x8 e0=*reinterpret_cast<const bf16x8*>(KXslot+r32*16), e1=*reinterpret_cast<const bf16x8*>(KXslot+r32*16+512);
    p0=__builtin_amdgcn_mfma_f32_32x32x16_bf16(e0,qr[4],p0,0,0,0);p1=__builtin_amdgcn_mfma_f32_32x32x16_bf16(e1,qr[4],p1,0,0,0);}
}
typedef __attribute__((address_space(3))) const char* lds_cptr;
typedef short v4i16_t __attribute__((ext_vector_type(4)));
__device__ __forceinline__ void kload8(bf16x8*kf,lds_cptr kp){
  kf[0]=*(const __attribute__((address_space(3))) bf16x8*)(kp);      kf[1]=*(const __attribute__((address_space(3))) bf16x8*)(kp+512);
  kf[2]=*(const __attribute__((address_space(3))) bf16x8*)(kp+2048); kf[3]=*(const __attribute__((address_space(3))) bf16x8*)(kp+2560);
  kf[4]=*(const __attribute__((address_space(3))) bf16x8*)(kp+4096); kf[5]=*(const __attribute__((address_space(3))) bf16x8*)(kp+4608);
  kf[6]=*(const __attribute__((address_space(3))) bf16x8*)(kp+6144); kf[7]=*(const __attribute__((address_space(3))) bf16x8*)(kp+6656);
}
__device__ __forceinline__ void kload2(bf16x8*kf,lds_cptr kp,int j){ kf[2*j]=*(const __attribute__((address_space(3))) bf16x8*)(kp+j*2048); kf[2*j+1]=*(const __attribute__((address_space(3))) bf16x8*)(kp+j*2048+512); }
__device__ __forceinline__ s16x4 vtr(lds_cptr p){ return __builtin_bit_cast(s16x4,__builtin_amdgcn_ds_read_tr16_b64_v4i16((__attribute__((address_space(3))) v4i16_t*)p)); }
__device__ __forceinline__ float rowmax(const f32x16&p0,const f32x16&p1){
  float a=max3f(p0[0],p0[1],p1[0]),b=max3f(p0[2],p0[3],p1[1]);a=max3f(a,p1[2],p1[3]);
  #pragma unroll
  for(int r=4;r<16;r+=4){a=max3f(a,p0[r],p0[r+1]);b=max3f(b,p0[r+2],p0[r+3]);a=max3f(a,p1[r],p1[r+1]);b=max3f(b,p1[r+2],p1[r+3]);}
  const float m=max2f(a,b);
  auto rr=__builtin_amdgcn_permlane32_swap(__float_as_uint(m),__float_as_uint(m),false,false);
  return max2f(__uint_as_float(rr[0]),__uint_as_float(rr[1]));
}
__device__ __forceinline__ void pv(f32x16*o,int vb,bf16x8 pa0,bf16x8 pa1,bf16x8 pa2,bf16x8 pa3){
  #pragma unroll
  for(int d0=0;d0<2;++d0){s16x4 lo[4],hi[4];
    #pragma unroll
    for(int ks=0;ks<4;++ks){
      asm volatile("ds_read_b64_tr_b16 %0,%1 offset:%c2":"=&v"(lo[ks]):"v"(vb),"i"(d0*4096+ks*1024):"memory");
      asm volatile("ds_read_b64_tr_b16 %0,%1 offset:%c2":"=&v"(hi[ks]):"v"(vb),"i"(d0*4096+ks*1024+512):"memory");}
    asm volatile("s_waitcnt lgkmcnt(0)":::"memory");SBAR();
    #define PK(k) (bf16x8){lo[k][0],lo[k][1],lo[k][2],lo[k][3],hi[k][0],hi[k][1],hi[k][2],hi[k][3]}
    o[d0]=__builtin_amdgcn_mfma_f32_32x32x16_bf16(pa0,PK(0),o[d0],0,0,0);
    o[d0]=__builtin_amdgcn_mfma_f32_32x32x16_bf16(pa1,PK(1),o[d0],0,0,0);
    o[d0]=__builtin_amdgcn_mfma_f32_32x32x16_bf16(pa2,PK(2),o[d0],0,0,0);
    o[d0]=__builtin_amdgcn_mfma_f32_32x32x16_bf16(pa3,PK(3),o[d0],0,0,0);
    #undef PK
  }
}

#ifndef ATTN_STORE16
#define ATTN_STORE16(p,v) (*(u32x4*)(p)=(v))
#endif
template<int THRL> __device__ __forceinline__ void attn_unit(int b,int h,int qb,const bf16*Q,const bf16*__restrict__ K,const bf16*__restrict__ V,const bf16*__restrict__ KX,const bf16*__restrict__ Z,bf16*O,char*shm){
  int tid_=threadIdx.x; asm volatile("":"+v"(tid_));
  const int tid=tid_,lane=tid&63,r32=lane&31,hi=lane>>5; const int wid=__builtin_amdgcn_readfirstlane(tid>>6);
  const long rowbase=(long)b*SEQ; const int q0=qb*QB;
  const bf16*Qw=Q+(rowbase+q0+wid*QBLK)*DM+h*D;
  const bf16*Kh=K+rowbase*DM+h*D,*Vh=V+rowbase*DM+h*D; const bf16*KXh=KX+((long)(b*NHEAD+h)*SEQ)*8;
  const unsigned lds0=(unsigned)(uintptr_t)shm;
  float*wsf=(float*)(shm+LDS_WS)+wid*64;
  const unsigned koff=(unsigned)(lane*DM+wid*8)*2u;
  const unsigned voff=(unsigned)((16*(wid&3)+(lane>>2))*DM+(wid>>2)*32+(lane&3)*8)*2u;
  const unsigned kdst=lds0+LDS_K+wid*1024, vdst=lds0+LDS_V+wid*1024, kxdst=lds0+LDS_KX+wid*128;
  const unsigned kxoff=(unsigned)(8*wid+(lane&7))*16u;
  #define DMA_K(t,slot) glds16(Kh+(long)(t)*KVBLK*DM,koff,(unsigned)__builtin_amdgcn_readfirstlane(kdst+(slot)))
  #define DMA_V(t,slot) glds16(Vh+(long)(t)*KVBLK*DM,voff,(unsigned)__builtin_amdgcn_readfirstlane(vdst+(slot)))
  #define DMA_KX(t) do{ const unsigned d_=(unsigned)__builtin_amdgcn_readfirstlane(kxdst+(((t)&3)<<10)); if(lane<8) glds16(KXh+(long)(t)*KVBLK*8,kxoff,d_); }while(0)
  const int vb0=(int)(lds0+LDS_V)+((lane>>4)&1)*32+(lane&3)*8+(4*hi+((lane&15)>>2))*64;
  const char*Kbase=shm+LDS_K; const char*KXbase=shm+LDS_KX; bf16x8 kf[8];
  const lds_cptr shm3=(lds_cptr)shm; const lds_cptr kp0=shm3+LDS_K+hi*1024+r32*16; const lds_cptr vp0=shm3+LDS_V+((lane>>4)&1)*32+(lane&3)*8+(4*hi+((lane&15)>>2))*64; const lds_cptr kxp0=shm3+LDS_KX+r32*16;
  const int NT=(q0+QB)/KVBLK;
  DMA_K(0,0);DMA_KX(0);DMA_V(0,0);DMA_K(1,SLOTB);DMA_KX(1);
  bf16x8 qr[5];
  { const short one_=hi?(short)0:(short)0x3F80; qr[4]=(bf16x8){one_,one_,one_,0,0,0,0,0}; }
  #pragma unroll
  for(int d0=0;d0<4;++d0)qr[d0]=*reinterpret_cast<const bf16x8*>(&Qw[(long)r32*DM+d0*16+hi*8]);
  float mhat=0.f,l_reg=0.f;f32x16 o[2];o[0]=f32x16{};o[1]=f32x16{};f32x16 negm=f32x16{};asm volatile("":"+v"(negm));
  const int qrel=wid*QBLK+r32;
  #define CMASK(P0,P1,t) do{int jb_=(t)-(NT-4); if(jb_>=0)cmask(P0,P1,jb_,qrel,hi);}while(0)
  bool resc=false;
  #define START(P0,P1) do{ const float rm=rowmax(P0,P1); resc=false; \
    { const float dl=rm; mhat=fadd_s(mhat,dl); \
      _Pragma("unroll") for(int r=0;r<16;++r){P0[r]=fsub_s(P0[r],dl);P1[r]=fsub_s(P1[r],dl);} \
      _Pragma("unroll") for(int r=0;r<16;++r)negm[r]=-mhat; asm volatile("":"+v"(negm)); } \
    _Pragma("unroll") for(int r=0;r<16;++r)P0[r]=__builtin_amdgcn_exp2f(P0[r]); }while(0)
  #define RESC() do{ if(resc){ asm volatile("s_waitcnt lgkmcnt(0)":::"memory"); \
      _Pragma("unroll") for(int d_=0;d_<2;++d_) _Pragma("unroll") for(int r=0;r<16;++r)o[d_][r]*=wsf[crow(r,hi)]; } }while(0)
  f32x16 pA0,pA1,pB0,pB1;
  int sl_prev=0,sl_cur=0,sl_next=SLOTB;
  #define ROT() do{sl_prev=sl_cur;sl_cur=sl_next;sl_next=(sl_next==(NSLOT-1)*SLOTB)?0:sl_next+SLOTB;}while(0)
  DMA_K(2,2*SLOTB);DMA_KX(2);
  WAIT_BAR(5);
  qkt(pA0,pA1,Kbase,KXbase,qr,negm,r32,hi);asm volatile("s_nop 15\n\ts_nop 7":"+v"(pA0),"+v"(pA1));CMASK(pA0,pA1,0);
  START(pA0,pA1);
  _Pragma("unroll") for(int r=0;r<16;++r)pA1[r]=__builtin_amdgcn_exp2f(pA1[r]);
  WAIT_BAR(0);
  DMA_K(3,0);DMA_KX(3);DMA_V(1,SLOTB);
  ROT();
  kload8(kf,kp0+sl_cur);
  WAIT_BAR(3);
  s16x4 vlo[8],vhi[8]; u32x4 pw0,pw1,pw2,pw3;
  #define PKW(P,B) cvtpk_s(P[B],P[B+1])
  #define PAF(k) __builtin_bit_cast(bf16x8,pw##k)
  #define VFR(i) (bf16x8){vlo[i][0],vlo[i][1],vlo[i][2],vlo[i][3],vhi[i][0],vhi[i][1],vhi[i][2],vhi[i][3]}
  #define PIN(x) asm volatile("":"+v"(x))
  #define MX3(a,b,c) __builtin_fmaxf(__builtin_fmaxf((a),(b)),(c))
  #define GAPA(MF,A0,A1,A2,A3,W0,W1,PW) do{ MF; sacc+=A0; sacc+=A1; sacc+=A2; sacc+=A3; PIN(sacc); W0; W1; PIN(PW); SBAR(); }while(0)
  #define EX(v) __builtin_amdgcn_exp2f(v)
  #define GAPB(MF,X,B) do{ MF; X[B]=EX(X[B]); X[B+1]=EX(X[B+1]); X[B+2]=EX(X[B+2]); X[B+3]=EX(X[B+3]); PIN(X); SBAR(); }while(0)
  #define VRD(i) do{ vlo[i]=vtr(vp_+(((i)>>2)*4096+((i)&3)*1024)); vhi[i]=vtr(vp_+(((i)>>2)*4096+((i)&3)*1024+512)); }while(0)
  #define KRD(G,j) do{ if(G){ kload2(kf,kp0+sl_next,j); SBAR(); } }while(0)
  #define STEP(C0,C1,P0,P1,t,GK,GV,GL) do{ SBAR(); \
    const lds_cptr vp_=vp0+sl_prev; \
    VRD(0); SBAR(); float sacc=(P0[0]+P0[1]); \
    GAPA(C0=__builtin_amdgcn_mfma_f32_32x32x16_bf16(kf[0],qr[0],negm,0,0,0), P0[2],P0[3],P0[4],P0[5],     pw0[0]=PKW(P0,0), pw0[1]=PKW(P0,2), pw0); \
    VRD(4); SBAR(); GAPA(C1=__builtin_amdgcn_mfma_f32_32x32x16_bf16(kf[1],qr[0],negm,0,0,0), P0[6],P0[7],P0[8],P0[9],     pw0[2]=PKW(P0,4), pw0[3]=PKW(P0,6), pw0); \
    VRD(1); SBAR(); GAPA(C0=__builtin_amdgcn_mfma_f32_32x32x16_bf16(kf[2],qr[1],C0,0,0,0),   P0[10],P0[11],P0[12],P0[13], pw1[0]=PKW(P0,8), pw1[1]=PKW(P0,10), pw1); \
    VRD(5); SBAR(); GAPA(C1=__builtin_amdgcn_mfma_f32_32x32x16_bf16(kf[3],qr[1],C1,0,0,0),   P0[14],P0[15],P1[0],P1[1],   pw1[2]=PKW(P0,12),pw1[3]=PKW(P0,14), pw1); \
    VRD(2); SBAR(); GAPA(C0=__builtin_amdgcn_mfma_f32_32x32x16_bf16(kf[4],qr[2],C0,0,0,0),   P1[2],P1[3],P1[4],P1[5],     pw2[0]=PKW(P1,0), pw2[1]=PKW(P1,2), pw2); \
    VRD(6); SBAR(); GAPA(C1=__builtin_amdgcn_mfma_f32_32x32x16_bf16(kf[5],qr[2],C1,0,0,0),   P1[6],P1[7],P1[8],P1[9],     pw2[2]=PKW(P1,4), pw2[3]=PKW(P1,6), pw2); \
    VRD(3); SBAR(); GAPA(C0=__builtin_amdgcn_mfma_f32_32x32x16_bf16(kf[6],qr[3],C0,0,0,0),   P1[10],P1[11],P1[12],P1[13], pw3[0]=PKW(P1,8), pw3[1]=PKW(P1,10), pw3); \
    VRD(7); SBAR(); GAPA(C1=__builtin_amdgcn_mfma_f32_32x32x16_bf16(kf[7],qr[3],C1,0,0,0),   P1[14],P1[15],0.f,0.f,       pw3[2]=PKW(P1,12),pw3[3]=PKW(P1,14), pw3); \
    { const lds_cptr xp_=kxp0+(((t)&3)<<10); const bf16x8 e0_=*(const __attribute__((address_space(3))) bf16x8*)(xp_), e1_=*(const __attribute__((address_space(3))) bf16x8*)(xp_+512); \
      C0=__builtin_amdgcn_mfma_f32_32x32x16_bf16(e0_,qr[4],C0,0,0,0); C1=__builtin_amdgcn_mfma_f32_32x32x16_bf16(e1_,qr[4],C1,0,0,0); SBAR(); } \
    l_reg+=sacc; \
    if(GK){DMA_K((t)+3,sl_cur);DMA_KX((t)+3);} if(GV){DMA_V((t)+1,sl_next);} \
    CMASK(C0,C1,t); \
    { float a=MX3(C0[0],C0[1],C1[0]),b=MX3(C0[2],C0[3],C1[1]); a=MX3(a,C1[2],C1[3]); \
      _Pragma("unroll") for(int r=4;r<16;r+=4){a=MX3(a,C0[r],C0[r+1]);b=MX3(b,C0[r+2],C0[r+3]);a=MX3(a,C1[r],C1[r+1]);b=MX3(b,C1[r+2],C1[r+3]);} \
      float rm=__builtin_fmaxf(a,b); { auto rr=__builtin_amdgcn_permlane32_swap(__float_as_uint(rm),__float_as_uint(rm),false,false); rm=__builtin_fmaxf(__uint_as_float(rr[0]),__uint_as_float(rr[1])); } \
      resc=false; \
      if(__builtin_expect(__any(rm>(float)THRL),0)){ const float dl=__builtin_fmaxf(rm,0.f); mhat+=dl; \
        _Pragma("unroll") for(int r=0;r<16;++r){C0[r]-=dl;C1[r]-=dl;} \
        _Pragma("unroll") for(int r=0;r<16;++r)negm[r]=-mhat; asm volatile("":"+v"(negm)); \
        const float f=__builtin_amdgcn_exp2f(-dl); l_reg*=f; if(hi==0)wsf[r32]=f; resc=true; } } \
    SBAR(); \
    GAPB(o[0]=__builtin_amdgcn_mfma_f32_32x32x16_bf16(PAF(0),VFR(0),o[0],0,0,0), C0,0); \
    GAPB(o[1]=__builtin_amdgcn_mfma_f32_32x32x16_bf16(PAF(0),VFR(4),o[1],0,0,0), C0,4); \
    KRD(GL,0); GAPB(o[0]=__builtin_amdgcn_mfma_f32_32x32x16_bf16(PAF(1),VFR(1),o[0],0,0,0), C0,8); \
    KRD(GL,1); GAPB(o[1]=__builtin_amdgcn_mfma_f32_32x32x16_bf16(PAF(1),VFR(5),o[1],0,0,0), C0,12); \
    KRD(GL,2); GAPB(o[0]=__builtin_amdgcn_mfma_f32_32x32x16_bf16(PAF(2),VFR(2),o[0],0,0,0), C1,0); \
    KRD(GL,3); GAPB(o[1]=__builtin_amdgcn_mfma_f32_32x32x16_bf16(PAF(2),VFR(6),o[1],0,0,0), C1,4); \
    GAPB(o[0]=__builtin_amdgcn_mfma_f32_32x32x16_bf16(PAF(3),VFR(3),o[0],0,0,0), C1,8); \
    GAPB(o[1]=__builtin_amdgcn_mfma_f32_32x32x16_bf16(PAF(3),VFR(7),o[1],0,0,0), C1,12); \
    }while(0)
  int t=1;
  #undef CMASK
  #define CMASK(P0,P1,t) do{}while(0)
  for(;t+5<NT;t+=2){
    STEP(pB0,pB1,pA0,pA1,t,true,true,true);     WAIT_BAR(3); RESC(); ROT();
    STEP(pA0,pA1,pB0,pB1,t+1,true,true,true);   WAIT_BAR(3); RESC(); ROT();
  }
  #undef CMASK
  #define CMASK(P0,P1,t) do{int jb_=(t)-(NT-4); if(jb_>=0)cmask(P0,P1,jb_,qrel,hi);}while(0)
  #define ENDW(tt) do{ if((tt)+3<NT){WAIT_BAR(3);} else if((tt)+2<NT){WAIT_BAR(1);} else {WAIT_BAR(0);} }while(0)
  for(;t+1<NT;t+=2){
    STEP(pB0,pB1,pA0,pA1,t,(t+3<NT),(t+1<NT),(t+1<NT));       ENDW(t);   RESC(); ROT();
    STEP(pA0,pA1,pB0,pB1,t+1,(t+4<NT),(t+2<NT),(t+2<NT));     ENDW(t+1); RESC(); ROT();
  }
  STEP(pB0,pB1,pA0,pA1,NT-1,false,false,false); RESC();
  { float sacc=pB0[0]+pB0[1]; _Pragma("unroll") for(int r=2;r<16;++r)sacc+=pB0[r]; _Pragma("unroll") for(int r=0;r<16;++r)sacc+=pB1[r]; l_reg+=sacc;
    pw0=(u32x4){PKW(pB0,0),PKW(pB0,2),PKW(pB0,4),PKW(pB0,6)};pw1=(u32x4){PKW(pB0,8),PKW(pB0,10),PKW(pB0,12),PKW(pB0,14)};pw2=(u32x4){PKW(pB1,0),PKW(pB1,2),PKW(pB1,4),PKW(pB1,6)};pw3=(u32x4){PKW(pB1,8),PKW(pB1,10),PKW(pB1,12),PKW(pB1,14)};
    SBAR(); pv(o,vb0+sl_cur,PAF(0),PAF(1),PAF(2),PAF(3)); }
  #undef PKW
  #undef PAF
  #undef VFR
  #undef PIN
  #undef MX3
  #undef GAPA
  #undef GAPB
  #undef EX
  #undef VRD
  #undef KRD
  #undef STEP
  #undef ENDW
  {auto rr=__builtin_amdgcn_permlane32_swap(__float_as_uint(l_reg),__float_as_uint(l_reg),false,false);l_reg=__uint_as_float(rr[0])+__uint_as_float(rr[1]);}
  if(hi==0)wsf[32+r32]=l_reg;asm volatile("s_waitcnt lgkmcnt(0)":::"memory");
  float rli[16];
  #pragma unroll
  for(int r=0;r<16;++r)rli[r]=__builtin_amdgcn_rcpf(wsf[32+crow(r,hi)]);
  bf16*Ow=O+(rowbase+q0+wid*QBLK)*DM+h*D; const bf16*Zw=Z+(rowbase+q0+wid*QBLK)*DM+h*D;
  { bf16*stg=(bf16*)(shm+LDS_OST)+wid*2048;
    #pragma unroll
    for(int r=0;r<16;++r){const int orow=crow(r,hi);
      #pragma unroll
      for(int d0=0;d0<2;++d0)stg[orow*64+d0*32+r32]=__float2bfloat16(o[d0][r]*rli[r]);}
    asm volatile("s_waitcnt lgkmcnt(0)":::"memory");
    #pragma unroll
    for(int i=0;i<4;++i){const int row=i*8+(lane>>3),ch=lane&7; const u32x4 v=*(const u32x4*)(stg+row*64+ch*8); const u32x4 zz=*(const u32x4*)(Zw+(long)row*DM+ch*8); u32x4 g_;
      #pragma unroll
      for(int e_=0;e_<4;++e_){ const float a0=__builtin_bit_cast(float,v[e_]<<16)*__builtin_bit_cast(float,zz[e_]<<16), a1=__builtin_bit_cast(float,v[e_]&0xffff0000u)*__builtin_bit_cast(float,zz[e_]&0xffff0000u); g_[e_]=cvtpk_s(a0,a1); }
      ATTN_STORE16(Ow+(long)row*DM+ch*8,g_);} }
  asm volatile("s_waitcnt lgkmcnt(0)\n\ts_barrier":::"memory");
  #undef DMA_K
  #undef DMA_V
  #undef DMA_KX
  #undef CMASK
  #undef START
  #undef RESC
  #undef ROT
}
constexpr int ATTN_LDS_BYTES=LDS_BYTES;
struct AttnTensors { const bf16* Q; const bf16* K; const bf16* V; const bf16* KX; const bf16* Z; bf16* O; };
struct AttnUnit { int bh; int qb; };
struct StaticOrder {
  int vcu;
  __device__ __forceinline__ explicit StaticOrder(int grid,int block):vcu((grid%8==0)?(block%8)*(grid/8)+block/8:block){}
  __device__ __forceinline__ bool next(int i,AttnUnit&u)const{ const int L=vcu*8+i; if(i>=8||L>=BATCH*NHEAD*NQB)return false; const int s=vcu&1,p=i>>1; u.bh=vcu>>1; u.qb=(i&1)?(15-2*p-s):(2*p+s); return true; }
  __device__ __forceinline__ void a_ready(const AttnUnit&)const{}
  __device__ __forceinline__ void done(const AttnUnit&)const{}
};
template<class Sched,int THRL=8> __device__ __forceinline__ void attn_phase(char*lds,const AttnTensors&T,const Sched&S){
  AttnUnit u;
  for(int i=0;S.next(i,u);++i){ S.a_ready(u); attn_unit<THRL>(u.bh/NHEAD,u.bh%NHEAD,u.qb,T.Q,T.K,T.V,T.KX,T.Z,T.O,lds); S.done(u); }
}
#undef SBAR
#undef WAIT_BAR
}
#define GAS __attribute__((address_space(1)))
#define LAS __attribute__((address_space(3)))
typedef unsigned short bf16;
typedef unsigned v4u __attribute__((ext_vector_type(4)));
typedef float f32x4 __attribute__((ext_vector_type(4)));
typedef short bf16x8 __attribute__((ext_vector_type(8)));
typedef GAS unsigned gu32;
typedef GAS unsigned long long gu64;
#define RLX_AGENT __ATOMIC_RELAXED, __HIP_MEMORY_SCOPE_AGENT
#define LDS_WAIT() asm volatile("s_waitcnt lgkmcnt(0)" ::: "memory")
#define VM_WAIT() asm volatile("s_waitcnt vmcnt(0)" ::: "memory")
__device__ __forceinline__ unsigned long long rt() { return __builtin_amdgcn_s_memrealtime(); }
__device__ __forceinline__ unsigned f2bf(float f) { unsigned u = __builtin_bit_cast(unsigned, f); return (u + 0x7fffu + ((u >> 16) & 1u)) >> 16; }
__device__ __forceinline__ unsigned pk2(float lo, float hi) { return f2bf(lo) | (f2bf(hi) << 16); }
#define XB_TMO      128
#define XB_XCNT(j)  (256  + 64 * (j))
#define XB_XSUB(j)  (1280 + 64 * (j))
#define XB_XGEN(j)  (2304 + 64 * (j))
#define XB_TOP      3328
#define XB_TOPGEN   3392
#define XCD_BAR_WORDS 3456
#define XB_SPIN_CAP (1u << 18)

__device__ __forceinline__ unsigned xb_ld(unsigned* p)              { return __hip_atomic_load(p, __ATOMIC_RELAXED, __HIP_MEMORY_SCOPE_AGENT); }
__device__ __forceinline__ unsigned xb_add(unsigned* p, unsigned v) { return __hip_atomic_fetch_add(p, v, __ATOMIC_RELAXED, __HIP_MEMORY_SCOPE_AGENT); }
__device__ __forceinline__ unsigned xb_xcc_id() { return (unsigned)__builtin_amdgcn_s_getreg((3 << 11) | 20) & 0xFu; }
#define XB_SPIN(cond, bar) do { unsigned _sp = 0; while (cond) { __builtin_amdgcn_s_sleep(1); \
    if ((++_sp & 255u) == 0u) { if (xb_ld(&(bar)[XB_TMO])) break; if (_sp > XB_SPIN_CAP) { atomicAdd(&(bar)[XB_TMO], 1u); break; } } } } while (0)

struct XcdBarrier {
    unsigned* bar; unsigned x;
    volatile LAS unsigned* st;
};

__device__ __forceinline__ XcdBarrier xcd_barrier_post(unsigned* bar, volatile LAS unsigned* st) {
    XcdBarrier b; b.bar = bar; b.x = xb_xcc_id(); b.st = st;
    if (threadIdx.x == 0) (void)xb_add(&bar[XB_XCNT(b.x)], 1u);
    return b;
}
__device__ __forceinline__ void xcd_barrier_complete(unsigned* bar, unsigned x, unsigned& nloc, unsigned& nx) {
    const unsigned G = gridDim.x * gridDim.y * gridDim.z;
    unsigned sum, cnt, mine, sp = 0u;
    for (;;) {
        sum = 0u; cnt = 0u; mine = 0u;
#pragma unroll
        for (unsigned j = 0; j < 16; ++j) { const unsigned c = xb_ld(&bar[XB_XCNT(j)]); sum += c; cnt += (c > 0u) ? 1u : 0u; mine = (j == x) ? c : mine; }
        if (sum == G) break;
        __builtin_amdgcn_s_sleep(1);
        if ((++sp & 255u) == 0u) { if (xb_ld(&bar[XB_TMO])) break; if (sp > XB_SPIN_CAP) { atomicAdd(&bar[XB_TMO], 1u); break; } }
    }
    nloc = mine > 0u ? mine : 1u; nx = cnt > 0u ? cnt : 1u;
}

__device__ __forceinline__ void xcd_barrier(const XcdBarrier& b) {
    asm volatile("s_waitcnt vmcnt(0)" ::: "memory");
    __syncthreads();
    if (threadIdx.x == 0) {
        unsigned* bar = b.bar;
        __builtin_amdgcn_s_waitcnt(0);
        unsigned nloc = b.st[0], nx = b.st[1];
        if (nloc == 0u) { xcd_barrier_complete(bar, b.x, nloc, nx); b.st[0] = nloc; b.st[1] = nx; }
        const unsigned old = xb_add(&bar[XB_XSUB(b.x)], 1u);
        const unsigned gen = old / nloc;
        if (old + 1u == (gen + 1u) * nloc) {
            __builtin_amdgcn_fence(__ATOMIC_RELEASE, "agent");
            asm volatile("s_waitcnt vmcnt(0)" ::: "memory");
            const unsigned og = xb_add(&bar[XB_TOP], 1u);
            const unsigned tg = og / nx;
            if (og + 1u == (tg + 1u) * nx) xb_add(&bar[XB_TOPGEN], 1u);
            else XB_SPIN(xb_ld(&bar[XB_TOPGEN]) == tg, bar);
            __builtin_amdgcn_fence(__ATOMIC_ACQUIRE, "agent");
            xb_add(&bar[XB_XGEN(b.x)], 1u);
            asm volatile("s_waitcnt vmcnt(0)" ::: "memory");
        } else {
            XB_SPIN(xb_ld(&bar[XB_XGEN(b.x)]) == gen, bar);
            __builtin_amdgcn_fence(__ATOMIC_ACQUIRE, "agent");
            asm volatile("s_waitcnt vmcnt(0)" ::: "memory");
        }
    }
    __syncthreads();
}
__device__ __forceinline__ float wave_sum(float v) {
#pragma unroll
    for (int o = 1; o < 64; o <<= 1) v += __shfl_xor(v, o);
    return v;
}
__device__ __forceinline__ void p0_transpose_item(const float* W, int K, int N, bf16* WT, int row_off, LAS float* scr, int item, int lane) {
    const int nblk = N / 32, kb = item / nblk, nb = item % nblk, k0 = 64 * kb, n0 = 32 * nb;
#pragma unroll 8
    for (int i = 0; i < 32; ++i) { const int kk = 2 * i + (lane >> 5); scr[kk * 33 + (lane & 31)] = W[(size_t)(k0 + kk) * N + n0 + (lane & 31)]; }
    LDS_WAIT(); asm volatile("" ::: "memory");
    const int c = lane & 7;
#pragma unroll
    for (int j = 0; j < 4; ++j) { const int n = (lane >> 3) + 8 * j; const LAS float* s = scr + (8 * c) * 33 + n;
        v4u o; o.x = pk2(s[0 * 33], s[1 * 33]); o.y = pk2(s[2 * 33], s[3 * 33]); o.z = pk2(s[4 * 33], s[5 * 33]); o.w = pk2(s[6 * 33], s[7 * 33]);
        *(GAS v4u*)(WT + (size_t)(row_off + n0 + n) * K + k0 + 8 * c) = o; }
    LDS_WAIT(); asm volatile("" ::: "memory");
}
struct Frame {
    LAS unsigned char* lds; volatile LAS unsigned* MISC; gu32* ctl;
    int tid, lane, wave, G;
    unsigned char* ws;
};
#define relaunder(F) do { int t_ = threadIdx.x; asm volatile("" : "+v"(t_)); (F).tid = t_; (F).lane = t_ & 63; (F).wave = __builtin_amdgcn_readfirstlane(t_ >> 6); } while (0)
typedef _Float16 half_t;
__device__ __forceinline__ float bf2f(unsigned short h) { return __builtin_bit_cast(float, (unsigned)h << 16); }
__device__ __forceinline__ float bflo(unsigned w) { return __builtin_bit_cast(float, w << 16); }
__device__ __forceinline__ float bfhi(unsigned w) { return __builtin_bit_cast(float, w & 0xffff0000u); }

__device__ __forceinline__ void p0_transpose_item2(const float* W, int K, int N, bf16* WT, LAS float* scr, int kb, int n0, int nvalid, int lane) {
    const int k0 = 64 * kb;
#pragma unroll 8
    for (int i = 0; i < 32; ++i) { const int kk = 2 * i + (lane >> 5); const int nn = lane & 31; scr[kk * 33 + nn] = (nn < nvalid) ? W[(size_t)(k0 + kk) * N + n0 + nn] : 0.f; }
    LDS_WAIT(); asm volatile("" ::: "memory");
    const int c = lane & 7;
#pragma unroll
    for (int j = 0; j < 4; ++j) { const int n = (lane >> 3) + 8 * j; const LAS float* s = scr + (8 * c) * 33 + n;
        v4u o; o.x = pk2(s[0 * 33], s[1 * 33]); o.y = pk2(s[2 * 33], s[3 * 33]); o.z = pk2(s[4 * 33], s[5 * 33]); o.w = pk2(s[6 * 33], s[7 * 33]);
        if (n < nvalid) *(GAS v4u*)(WT + (size_t)(n0 + n) * K + k0 + 8 * c) = o; }
    LDS_WAIT(); asm volatile("" ::: "memory");
}

__device__ __forceinline__ void gemv8_block(Frame& F, const float* Wm, int N, int j0, int ncols, const LAS float* atab, LAS float* part) {
    float a8[8];
#pragma unroll
    for (int b = 0; b < 8; ++b) a8[b] = 0.f;
    const int j = j0 + F.lane; const bool ok = F.lane < ncols;
    const int kbeg = F.wave * 128;
#pragma unroll 4
    for (int kk = 0; kk < 128; ++kk) { const int k = kbeg + kk; const float w = ok ? Wm[(size_t)k * N + j] : 0.f;
        const f32x4 t0 = *(const LAS f32x4*)(atab + k * 8), t1 = *(const LAS f32x4*)(atab + k * 8 + 4);
        a8[0] += t0[0] * w; a8[1] += t0[1] * w; a8[2] += t0[2] * w; a8[3] += t0[3] * w; a8[4] += t1[0] * w; a8[5] += t1[1] * w; a8[6] += t1[2] * w; a8[7] += t1[3] * w; }
#pragma unroll
    for (int b = 0; b < 8; ++b) part[(F.wave * 8 + b) * 64 + F.lane] = a8[b];
}

__device__ __forceinline__ void p0a(Frame& F, const float* const* in) {
    relaunder(F);
    const float* c = in[1]; const float* norm_g = in[2]; const float* ada_w = in[3]; const float* ada_b = in[4]; const float* lbl = in[5];
    const float* hg_w_in = in[6]; const float* hg_w_out = in[8]; const float* fx_w_in = in[9]; const float* fx_w_out = in[13];
    unsigned char* ws = F.ws;
    {
        LAS float* atab = (LAS float*)(F.lds);
        LAS float* part = (LAS float*)(F.lds + 32768);
        for (int e = F.tid; e < 8192; e += 512) { const int b = e >> 10, k = e & 1023; const float v = c[b * 1024 + k]; atab[k * 8 + b] = v / (1.0f + __expf(-v)); }
        __syncthreads();
        for (int it = blockIdx.x; it < 4 * 48; it += F.G) {
            const int l = it / 48, jb = it % 48, j0 = jb * 64;
            gemv8_block(F, ada_w + (size_t)l * 1024 * 3072, 3072, j0, 64, atab, part);
            __syncthreads();
            { const int b = F.tid >> 6, jl = F.tid & 63, j = j0 + jl; float s = ada_b[l * 3072 + j];
#pragma unroll
              for (int w = 0; w < 8; ++w) s += part[(w * 8 + b) * 64 + jl];
              const int sec = j >> 10, cc = j & 1023; const size_t o = ((size_t)l * 8 + b) * 1024 + cc;
              if (sec == 0) ((float*)(ws + WS_SH))[o] = s; else if (sec == 1) ((float*)(ws + WS_GS))[o] = norm_g[l * 1024 + cc] * (1.0f + s); else ((float*)(ws + WS_GATE))[o] = s; }
            __syncthreads();
        }
    }
    if (blockIdx.x == 0) { float* par = (float*)(ws + WS_PAR); for (int e = F.tid; e < 128; e += 512) { par[e] = in[11][e]; par[128 + e] = in[12][e]; } if (F.tid < 32) par[256 + F.tid] = in[10][F.tid]; for (int e = F.tid; e < 2048; e += 512) par[288 + e] = in[7][e]; }
    if (blockIdx.x == F.G - 1) { for (int e = F.tid; e < 1024; e += 512) { const float d = lbl[1024 + e] - lbl[e]; ((float*)(ws + WS_LB))[e] = 0.f; ((float*)(ws + WS_LB))[1024 + e] = 1.0f / (1.0f + __expf(-d)); } }
    {
        __syncthreads();
        LAS float* scr = (LAS float*)(F.lds + F.wave * 16384);
        const int gw = blockIdx.x * NWAVES + F.wave, NGW = F.G * NWAVES;
        constexpr int I_HG = 16 * 128, I_FX = 16 * 129, I_O = 16 * 32;
        constexpr int NIT = 2 * I_HG + 2 * I_FX + 4 * I_O;
        for (int it = gw; it < NIT; it += NGW) {
            int r = it;
            if (r < 2 * I_HG) { const int j = r / I_HG; r %= I_HG; p0_transpose_item2(hg_w_in + (size_t)j * 1024 * HG_IN, 1024, HG_IN, (bf16*)(ws + WS_WIN + (size_t)(2 * j) * WIN_STRIDE), scr, r / 128, (r % 128) * 32, 32, F.lane); continue; }
            r -= 2 * I_HG;
            if (r < 2 * I_FX) { const int j = r / I_FX; r %= I_FX; const int nb = r % 129; p0_transpose_item2(fx_w_in + (size_t)j * 1024 * FX_IN, 1024, FX_IN, (bf16*)(ws + WS_WIN + (size_t)(2 * j + 1) * WIN_STRIDE), scr, r / 129, nb * 32, nb == 128 ? 16 : 32, F.lane); continue; }
            r -= 2 * I_FX;
            { const int l = r / I_O; r %= I_O; const float* src = (l & 1) ? fx_w_out + (size_t)(l >> 1) * 1024 * 1024 : hg_w_out + (size_t)(l >> 1) * 1024 * 1024;
              p0_transpose_item2(src, 1024, 1024, (bf16*)(ws + WS_WOUT + (size_t)l * WOUT_STRIDE), scr, r / 32, (r % 32) * 32, 32, F.lane); }
        }
        for (int e = blockIdx.x * 512 + F.tid; e < 2 * 240 * 128; e += F.G * 512) { const int j = e / (240 * 128), q = e % (240 * 128);
            *(GAS v4u*)((bf16*)(ws + WS_WIN + (size_t)(2 * j + 1) * WIN_STRIDE) + (size_t)FX_IN * 1024 + (size_t)q * 8) = (v4u){0u, 0u, 0u, 0u}; }
    }
}

__device__ __forceinline__ void p0b(Frame& F, const float* const* in) {
    relaunder(F);
    const float* x = in[0]; const float* hg_w_in = in[6]; const float* fx_w_in = in[9];
    unsigned char* ws = F.ws;
    {
        LAS float* atab = (LAS float*)(F.lds);
        LAS float* part = (LAS float*)(F.lds + 32768);
        constexpr int NB_HG = 64, NB_FX = 68;
        for (int it = blockIdx.x; it < 2 * NB_HG + 2 * NB_FX; it += F.G) {
            int l, jb; if (it < 2 * NB_HG) { l = 2 * (it / NB_HG); jb = it % NB_HG; } else { const int r = it - 2 * NB_HG; l = 2 * (r / NB_FX) + 1; jb = r % NB_FX; }
            const bool fx = l & 1; const int N = fx ? FX_IN : HG_IN; const int j0 = jb * 64; const int ncols = (j0 + 64 <= N) ? 64 : (j0 < N ? N - j0 : 0);
            const float* Wm = fx ? fx_w_in + (size_t)(l >> 1) * 1024 * FX_IN : hg_w_in + (size_t)(l >> 1) * 1024 * HG_IN;
            const float* sh = (const float*)(ws + WS_SH) + (size_t)l * 8 * 1024;
            __syncthreads();
            for (int e = F.tid; e < 8192; e += 512) { const int b = e >> 10, k = e & 1023; atab[k * 8 + b] = sh[b * 1024 + k]; }
            __syncthreads();
            gemv8_block(F, Wm, N, j0, ncols, atab, part);
            __syncthreads();
            { const int b = F.tid >> 6, jl = F.tid & 63; float s = 0.f;
#pragma unroll
              for (int w = 0; w < 8; ++w) s += part[(w * 8 + b) * 64 + jl];
              ((float*)(ws + WS_BIAS))[((size_t)l * 8 + b) * BIAS_LD + j0 + jl] = (jl < ncols) ? s : 0.f; }
        }
    }
    {
        const int gw = blockIdx.x * NWAVES + F.wave, NGW = F.G * NWAVES;
        const float* gs = (const float*)(ws + WS_GS);
        float* rowss = (float*)(ws + WS_ROWSS);
        bf16* xs = (bf16*)(ws + WS_XS);
        for (int m = gw; m < M; m += NGW) {
            const int b = m >> 12; const GAS f32x4* xr = (const GAS f32x4*)(x + (size_t)m * 1024) + F.lane; const f32x4* gr = (const f32x4*)(gs + b * 1024) + F.lane;
            GAS unsigned long long* o8 = (GAS unsigned long long*)(xs + (size_t)m * 1024) + F.lane; float s = 0.f;
#pragma unroll
            for (int j = 0; j < 4; ++j) { const f32x4 v = xr[64 * j], g = gr[64 * j]; s += (v.x * v.x + v.y * v.y) + (v.z * v.z + v.w * v.w);
                o8[64 * j] = (unsigned long long)pk2(v.x * g.x, v.y * g.y) | ((unsigned long long)pk2(v.z * g.z, v.w * g.w) << 32); }
            s = wave_sum(s); if (F.lane == 0) rowss[m] = s;
        }
    }
}

__device__ __forceinline__ void fox_cumsum(Frame& F) {
    relaunder(F);
    unsigned char* ws = F.ws; const float* lf = (const float*)(ws + WS_LF); float* ckl = (float*)(ws + WS_CKL); bf16* kx = (bf16*)(ws + WS_KX);
    const int gw = blockIdx.x * NWAVES + F.wave, NGW = F.G * NWAVES;
    for (int bh = gw; bh < 128; bh += NGW) {
        const int b = bh >> 4, h = bh & 15; const float* p = lf + ((size_t)b * SEQ + F.lane * 64) * 16 + h;
        float sum = 0.f;
        for (int i = 0; i < 64; ++i) sum += p[i * 16];
        float incl = sum;
#pragma unroll
        for (int off = 1; off < 64; off <<= 1) { const float t = __shfl_up(incl, off); if (F.lane >= off) incl += t; }
        float run = incl - sum;
        for (int i = 0; i < 64; ++i) { run += p[i * 16]; const float c = run * LOG2E; const size_t s = (size_t)bh * SEQ + F.lane * 64 + i; ckl[s] = c;
            const float xv = -c; const unsigned h0 = f2bf(xv); const float r1 = xv - __builtin_bit_cast(float, h0 << 16); const unsigned h1 = f2bf(r1); const float r2 = r1 - __builtin_bit_cast(float, h1 << 16); const unsigned h2 = f2bf(r2);
            *(GAS v4u*)(kx + s * 8) = (v4u){h0 | (h1 << 16), h2, 0u, 0u}; }
    }
}

#if !FAST_ATTN
__device__ __forceinline__ void attn_naive(Frame& F) {
    relaunder(F);
    unsigned char* ws = F.ws;
    const bf16* Q = (const bf16*)(ws + WS_B0); const bf16* K = (const bf16*)(ws + WS_B0 + BUF_STRIDE); const bf16* V = (const bf16*)(ws + WS_B0 + 2 * BUF_STRIDE); const bf16* Z = (const bf16*)(ws + WS_B0 + 3 * BUF_STRIDE);
    const float* CKL = (const float*)(ws + WS_CKL); bf16* AO = (bf16*)(ws + WS_AO);
    LAS float* Kf = (LAS float*)(F.lds); LAS float* Vf = Kf + 4096; LAS float* ckt = Vf + 4096;
    for (int u = blockIdx.x; u < 1024; u += F.G) {
        const int qblk = 7 - (u >> 7), bh = u & 127, b = bh >> 4, h = bh & 15;
        const int t = qblk * 512 + F.tid; const size_t row = (size_t)b * SEQ + t;
        float q[64], o[64];
#pragma unroll
        for (int c8 = 0; c8 < 8; ++c8) { const v4u w = *(const GAS v4u*)(Q + row * 1024 + h * 64 + c8 * 8);
            q[c8 * 8 + 0] = bflo(w.x); q[c8 * 8 + 1] = bfhi(w.x); q[c8 * 8 + 2] = bflo(w.y); q[c8 * 8 + 3] = bfhi(w.y); q[c8 * 8 + 4] = bflo(w.z); q[c8 * 8 + 5] = bfhi(w.z); q[c8 * 8 + 6] = bflo(w.w); q[c8 * 8 + 7] = bfhi(w.w); }
#pragma unroll
        for (int d = 0; d < 64; ++d) o[d] = 0.f;
        float mx = -INFINITY, l = 0.f;
        const int ntile = (qblk + 1) * 8;
        for (int j = 0; j < ntile; ++j) {
            __syncthreads();
            { const int key = F.tid >> 3, ch = F.tid & 7; const size_t krow = (size_t)b * SEQ + j * 64 + key;
              const v4u kw = *(const GAS v4u*)(K + krow * 1024 + h * 64 + ch * 8), vw = *(const GAS v4u*)(V + krow * 1024 + h * 64 + ch * 8);
              LAS f32x4* kd = (LAS f32x4*)(Kf + key * 64 + ch * 8); LAS f32x4* vd = (LAS f32x4*)(Vf + key * 64 + ch * 8);
              kd[0] = (f32x4){bflo(kw.x), bfhi(kw.x), bflo(kw.y), bfhi(kw.y)}; kd[1] = (f32x4){bflo(kw.z), bfhi(kw.z), bflo(kw.w), bfhi(kw.w)};
              vd[0] = (f32x4){bflo(vw.x), bfhi(vw.x), bflo(vw.y), bfhi(vw.y)}; vd[1] = (f32x4){bflo(vw.z), bfhi(vw.z), bflo(vw.w), bfhi(vw.w)};
              if (F.tid < 64) ckt[F.tid] = CKL[(size_t)bh * SEQ + j * 64 + F.tid]; }
            __syncthreads();
            int kmax = t - j * 64; if (kmax > 63) kmax = 63;
            for (int key = 0; key <= kmax; ++key) {
                float s = -ckt[key];
#pragma unroll
                for (int d4 = 0; d4 < 16; ++d4) { const f32x4 kk = *(const LAS f32x4*)(Kf + key * 64 + d4 * 4); s += q[d4 * 4] * kk[0] + q[d4 * 4 + 1] * kk[1] + q[d4 * 4 + 2] * kk[2] + q[d4 * 4 + 3] * kk[3]; }
                if (s > mx) { const float a = __builtin_amdgcn_exp2f(mx - s); l *= a;
#pragma unroll
                    for (int d = 0; d < 64; ++d) o[d] *= a;
                    mx = s; }
                const float p = __builtin_amdgcn_exp2f(s - mx); l += p;
#pragma unroll
                for (int d4 = 0; d4 < 16; ++d4) { const f32x4 vv = *(const LAS f32x4*)(Vf + key * 64 + d4 * 4); o[d4 * 4] += p * vv[0]; o[d4 * 4 + 1] += p * vv[1]; o[d4 * 4 + 2] += p * vv[2]; o[d4 * 4 + 3] += p * vv[3]; }
            }
        }
        const float inv = 1.0f / l;
#pragma unroll
        for (int c8 = 0; c8 < 8; ++c8) { const v4u zw = *(const GAS v4u*)(Z + row * 1024 + h * 64 + c8 * 8); v4u w;
            w.x = pk2(o[c8 * 8 + 0] * inv * bflo(zw.x), o[c8 * 8 + 1] * inv * bfhi(zw.x)); w.y = pk2(o[c8 * 8 + 2] * inv * bflo(zw.y), o[c8 * 8 + 3] * inv * bfhi(zw.y));
            w.z = pk2(o[c8 * 8 + 4] * inv * bflo(zw.z), o[c8 * 8 + 5] * inv * bfhi(zw.z)); w.w = pk2(o[c8 * 8 + 6] * inv * bflo(zw.w), o[c8 * 8 + 7] * inv * bfhi(zw.w));
            *(GAS v4u*)(AO + row * 1024 + h * 64 + c8 * 8) = w; }
    }
}

#endif
#if !FAST_SCAN
__device__ __forceinline__ void scan_naive(Frame& F, int jlayer) {
    relaunder(F); const float* og = (const float*)(F.ws + WS_PAR) + 288 + jlayer * 1024;
    unsigned char* ws = F.ws;
    const bf16* Qb = (const bf16*)(ws + WS_B0); const half_t* Gb = (const half_t*)(ws + WS_B0 + BUF_STRIDE); const bf16* Vb = (const bf16*)(ws + WS_B0 + 2 * BUF_STRIDE); const bf16* Zb = (const bf16*)(ws + WS_B0 + 3 * BUF_STRIDE);
    bf16* AO = (bf16*)(ws + WS_AO);
    LAS float* ff = (LAS float*)(F.lds); LAS float* kk = ff + 1024; LAS float* qq = kk + 1024; LAS float* vv = qq + 1024; LAS float* po = vv + 1024;
    for (int u = blockIdx.x; u < 64; u += F.G) {
        const int b = u >> 3, h = u & 7; const int v = F.tid & 127, kq = F.tid >> 7;
        float S[32];
#pragma unroll
        for (int i = 0; i < 32; ++i) S[i] = 0.f;
        for (int tg = 0; tg < SEQ / 8; ++tg) {
            const size_t row0 = (size_t)b * SEQ + tg * 8;
#pragma unroll
            for (int r = 0; r < 2; ++r) { const int e = F.tid + 512 * r, tok = e >> 7, c = e & 127; const size_t a = (row0 + tok) * 1024 + h * 128 + c;
                const float g = (float)Gb[a]; const float f = __expf(g); ff[e] = f; kk[e] = 1.0f - f; qq[e] = bf2f(Qb[a]); vv[e] = bf2f(Vb[a]); }
            __syncthreads();
#pragma unroll 1
            for (int tok = 0; tok < 8; ++tok) {
                const float vt = vv[tok * 128 + v]; float p = 0.f;
#pragma unroll
                for (int i4 = 0; i4 < 8; ++i4) { const int k = tok * 128 + kq * 32 + i4 * 4; const f32x4 f4 = *(const LAS f32x4*)(ff + k), k4 = *(const LAS f32x4*)(kk + k), q4 = *(const LAS f32x4*)(qq + k);
#pragma unroll
                    for (int e = 0; e < 4; ++e) { S[i4 * 4 + e] = f4[e] * S[i4 * 4 + e] + k4[e] * vt; p += q4[e] * S[i4 * 4 + e]; } }
                po[(tok * 4 + kq) * 128 + v] = p;
            }
            __syncthreads();
            { const int tok = F.tid >> 6, v2 = (F.tid & 63) * 2;
              float o0 = 0.f, o1 = 0.f;
#pragma unroll
              for (int q4 = 0; q4 < 4; ++q4) { o0 += po[(tok * 4 + q4) * 128 + v2]; o1 += po[(tok * 4 + q4) * 128 + v2 + 1]; }
              const float ss = wave_sum(o0 * o0 + o1 * o1); const float rn = rsqrtf(ss * (1.0f / 128.0f) + EPS);
              const size_t a = (row0 + tok) * 1024 + h * 128 + v2; const unsigned zw = *(const GAS unsigned*)(Zb + a);
              *(GAS unsigned*)(AO + a) = pk2(o0 * rn * og[h * 128 + v2] * bflo(zw), o1 * rn * og[h * 128 + v2 + 1] * bfhi(zw)); }
        }
        __syncthreads();
    }
}

#endif
namespace hg {
typedef short bf16x8 __attribute__((ext_vector_type(8)));
typedef short bf16x4 __attribute__((ext_vector_type(4)));
constexpr int QS = 272, KS = 80;
constexpr int OFF_Q = 0, OFF_K = 32 * QS, OFF_KD = 2 * 32 * QS, OFF_VT = OFF_KD + 128 * KS, OFF_DE = OFF_VT + 128 * KS, BUF = OFF_DE + 512;
constexpr int OFF_SSQ = 2 * BUF;
static_assert(OFF_SSQ + 2048 <= RING_BYTES, "scan LDS");
#define HG_MFMA(a, b, c) __builtin_amdgcn_mfma_f32_16x16x32_bf16(a, b, c, 0, 0, 0)
__device__ __forceinline__ bf16x8 cat8(bf16x4 lo, bf16x4 hi) { return (bf16x8){lo[0], lo[1], lo[2], lo[3], hi[0], hi[1], hi[2], hi[3]}; }
typedef float f32x2_t __attribute__((ext_vector_type(2))); typedef __bf16 bf16x2_t __attribute__((ext_vector_type(2)));
__device__ __forceinline__ unsigned cvtpk(float lo, float hi) { f32x2_t v = {lo, hi}; bf16x2_t b = __builtin_convertvector(v, bf16x2_t); return __builtin_bit_cast(unsigned, b); }
__device__ __forceinline__ bf16x8 pack8(f32x4 a, f32x4 b) { v4u r; r.x = cvtpk(a[0], a[1]); r.y = cvtpk(a[2], a[3]); r.z = cvtpk(b[0], b[1]); r.w = cvtpk(b[2], b[3]); return __builtin_bit_cast(bf16x8, r); }

__device__ __forceinline__ void scan_fast(Frame& F, int jlayer) {
    relaunder(F);
    unsigned char* ws = F.ws;
    const GAS bf16* Qb = (const GAS bf16*)(ws + WS_B0); const GAS half_t* Gb = (const GAS half_t*)(ws + WS_B0 + BUF_STRIDE); const GAS bf16* Vb = (const GAS bf16*)(ws + WS_B0 + 2 * BUF_STRIDE); const GAS bf16* Zb = (const GAS bf16*)(ws + WS_B0 + 3 * BUF_STRIDE);
    GAS bf16* AO = (GAS bf16*)(ws + WS_AO); const GAS float* og = (const GAS float*)(ws + WS_PAR) + 288 + jlayer * 1024;
    const int tid = F.tid, lane = F.lane, w = F.wave, fr = lane & 15, q4 = lane >> 4;
    LAS unsigned char* L = F.lds;
    LAS float* ssq = (LAS float*)(L + OFF_SSQ);
    constexpr int NSUB = SEQ / 32;
    for (int u = blockIdx.x; u < BATCH * HG_H; u += F.G) {
        const int b = u >> 3, h = u & 7; const size_t rowbase = (size_t)b * SEQ; const int colbase = h * 128;
        f32x4 S[8];
#pragma unroll
        for (int T = 0; T < 8; ++T) S[T] = (f32x4){0.f, 0.f, 0.f, 0.f};
        f32x4 Zp[2]; Zp[0] = (f32x4){0.f, 0.f, 0.f, 0.f}; Zp[1] = Zp[0];
        const int pc = 16 * w + fr;
        unsigned short qh[8]; half_t gh[8]; v4u vraw;
#define HG_LOAD(n_) do { const size_t r0_ = rowbase + (size_t)(n_) * 32; \
            _Pragma("unroll") for (int i = 0; i < 8; ++i) { const size_t a_ = (r0_ + 8 * q4 + i) * 1024 + colbase + pc; qh[i] = Qb[a_]; gh[i] = Gb[a_]; } \
            vraw = *(const GAS v4u*)(Vb + (r0_ + (tid >> 4)) * 1024 + colbase + (tid & 15) * 8); } while (0)
        HG_LOAD(0);
        for (int n = 0; n <= NSUB; ++n) {
            LAS unsigned char* buf = L + (n & 1) * BUF;
            if (n < NSUB) {
                float bcum[8]; float run = 0.f;
#pragma unroll
                for (int i = 0; i < 8; ++i) { run += (float)gh[i]; bcum[i] = run; }
                float x = run; float y = __shfl_up(x, 16); if (q4 >= 1) x += y; y = __shfl_up(x, 32); if (q4 >= 2) x += y;
                const float excl = x - run; const float E = __shfl(x, 48 + fr);
                unsigned kdp[8];
#pragma unroll
                for (int i = 0; i < 8; ++i) { const float bc = excl + bcum[i]; const float qv = bf2f(qh[i]); const float kk = 1.0f - __expf((float)gh[i]);
                    const int t = 8 * q4 + i;
                    *(LAS unsigned short*)(buf + OFF_Q + t * QS + pc * 2) = (unsigned short)f2bf(qv * __expf(bc));
                    *(LAS unsigned short*)(buf + OFF_K + t * QS + pc * 2) = (unsigned short)f2bf(kk * __expf(fminf(-bc, 80.f)));
                    kdp[i] = f2bf(kk * __expf(E - bc)); }
                *(LAS v4u*)(buf + OFF_KD + pc * KS + q4 * 16) = (v4u){kdp[0] | (kdp[1] << 16), kdp[2] | (kdp[3] << 16), kdp[4] | (kdp[5] << 16), kdp[6] | (kdp[7] << 16)};
                if (q4 == 0) *(LAS float*)(buf + OFF_DE + pc * 4) = __expf(E);
                { const int tok = tid >> 4, ch = tid & 15; LAS unsigned char* vp = buf + OFF_VT + (ch * 8) * KS + tok * 2;
                  *(LAS unsigned short*)(vp + 0 * KS) = (unsigned short)(vraw.x & 0xffffu); *(LAS unsigned short*)(vp + 1 * KS) = (unsigned short)(vraw.x >> 16);
                  *(LAS unsigned short*)(vp + 2 * KS) = (unsigned short)(vraw.y & 0xffffu); *(LAS unsigned short*)(vp + 3 * KS) = (unsigned short)(vraw.y >> 16);
                  *(LAS unsigned short*)(vp + 4 * KS) = (unsigned short)(vraw.z & 0xffffu); *(LAS unsigned short*)(vp + 5 * KS) = (unsigned short)(vraw.z >> 16);
                  *(LAS unsigned short*)(vp + 6 * KS) = (unsigned short)(vraw.w & 0xffffu); *(LAS unsigned short*)(vp + 7 * KS) = (unsigned short)(vraw.w >> 16); }
            }
            if (n > 0) {
#pragma unroll
                for (int ti = 0; ti < 2; ++ti) { float p = (Zp[ti][0] * Zp[ti][0] + Zp[ti][1] * Zp[ti][1]) + (Zp[ti][2] * Zp[ti][2] + Zp[ti][3] * Zp[ti][3]);
                    p += __shfl_xor(p, 16); p += __shfl_xor(p, 32); if (q4 == 0) ssq[(((n - 1) & 1) * 8 + w) * 32 + 16 * ti + fr] = p; }
            }
            __syncthreads();
            if (n > 0) {
                const size_t r0 = rowbase + (size_t)(n - 1) * 32; const int vcol = colbase + 16 * w + 4 * q4; const f32x4 gg = *(const GAS f32x4*)(og + vcol);
#pragma unroll
                for (int ti = 0; ti < 2; ++ti) { float tot = 0.f;
#pragma unroll
                    for (int ww = 0; ww < 8; ++ww) tot += ssq[(((n - 1) & 1) * 8 + ww) * 32 + 16 * ti + fr];
                    const float rn = rsqrtf(tot * (1.0f / 128.0f) + EPS); const size_t a = (r0 + 16 * ti + fr) * 1024 + vcol;
                    const unsigned long long zz = *(const GAS unsigned long long*)(Zb + a); const unsigned z0 = (unsigned)zz, z1 = (unsigned)(zz >> 32);
                    const unsigned o0 = cvtpk(Zp[ti][0] * rn * gg[0] * bflo(z0), Zp[ti][1] * rn * gg[1] * bfhi(z0)), o1 = cvtpk(Zp[ti][2] * rn * gg[2] * bflo(z1), Zp[ti][3] * rn * gg[3] * bfhi(z1));
                    *(GAS unsigned long long*)(AO + a) = (unsigned long long)o0 | ((unsigned long long)o1 << 32); }
            }
            if (n >= NSUB) break;
            if (n + 1 < NSUB) HG_LOAD(n + 1);
            const LAS unsigned char* Qr0 = buf + OFF_Q + fr * QS; const LAS unsigned char* Qr1 = Qr0 + 16 * QS;
            const LAS unsigned char* Kr0 = buf + OFF_K + fr * QS; const LAS unsigned char* Kr1 = Kr0 + 16 * QS;
            const LAS unsigned char* Vr = buf + OFF_VT + (16 * w + fr) * KS;
            f32x4 Z0 = (f32x4){0.f, 0.f, 0.f, 0.f}, Z1 = Z0, X00 = Z0, X01 = Z0, X11 = Z0;
#pragma unroll
            for (int ks = 0; ks < 4; ++ks) {
                const bf16x8 Sa = pack8(S[2 * ks], S[2 * ks + 1]);
                const int cb = (32 * ks + 4 * q4) * 2;
                const bf16x8 Bq0 = cat8(*(const LAS bf16x4*)(Qr0 + cb), *(const LAS bf16x4*)(Qr0 + cb + 32)), Bq1 = cat8(*(const LAS bf16x4*)(Qr1 + cb), *(const LAS bf16x4*)(Qr1 + cb + 32));
                Z0 = HG_MFMA(Sa, Bq0, Z0); Z1 = HG_MFMA(Sa, Bq1, Z1);
                const int cn = (32 * ks + 8 * q4) * 2;
                const bf16x8 a0 = *(const LAS bf16x8*)(Kr0 + cn), a1 = *(const LAS bf16x8*)(Kr1 + cn), b0 = *(const LAS bf16x8*)(Qr0 + cn), b1 = *(const LAS bf16x8*)(Qr1 + cn);
                X00 = HG_MFMA(a0, b0, X00); X01 = HG_MFMA(a0, b1, X01); X11 = HG_MFMA(a1, b1, X11);
            }
#pragma unroll
            for (int e = 0; e < 4; ++e) { const bool keep = (4 * q4 + e) <= fr; X00[e] = keep ? X00[e] : 0.f; X11[e] = keep ? X11[e] : 0.f; }
            { const bf16x8 P0 = pack8(X00, (f32x4){0.f, 0.f, 0.f, 0.f}), P1 = pack8(X01, X11);
              const bf16x8 Av = cat8(*(const LAS bf16x4*)(Vr + 8 * q4), *(const LAS bf16x4*)(Vr + 32 + 8 * q4));
              Z0 = HG_MFMA(Av, P0, Z0); Z1 = HG_MFMA(Av, P1, Z1); }
            { const bf16x8 Bv = *(const LAS bf16x8*)(Vr + 16 * q4);
#pragma unroll
              for (int T = 0; T < 8; ++T) { const bf16x8 a = *(const LAS bf16x8*)(buf + OFF_KD + (16 * T + fr) * KS + 16 * q4); const f32x4 de = *(const LAS f32x4*)(buf + OFF_DE + (16 * T + 4 * q4) * 4);
                  S[T] = HG_MFMA(a, Bv, S[T] * de); } }
            Zp[0] = Z0; Zp[1] = Z1;
        }
#undef HG_LOAD
        __syncthreads();
    }
}
#undef HG_MFMA
}
struct Args { const float* in[14]; float* out; unsigned char* ws; int ph_lo, ph_hi, li, pad; };
constexpr int N_PHASES = 2 + 4 * DEPTH;
__global__ void __launch_bounds__(NWAVES * 64, 2) fwd(Args args) {
    extern __shared__ __attribute__((aligned(16))) unsigned char lds[];
    Frame F;
    F.lds = (LAS unsigned char*)lds; F.MISC = (volatile LAS unsigned*)(F.lds + MISC_OFF);
    F.tid = threadIdx.x; F.lane = F.tid & 63; F.wave = __builtin_amdgcn_readfirstlane(F.tid >> 6); F.G = gridDim.x; F.ws = args.ws;
    F.ctl = (gu32*)(args.ws + WS_CTL);
    for (int u = F.tid; u < (LDS_BYTES - LDSCTL_OFF) / 4; u += NWAVES * 64) ((LAS unsigned*)(F.lds + LDSCTL_OFF))[u] = 0u;
    __syncthreads();
    XcdBarrier bar; bar.bar = (unsigned*)(F.ctl + CW_BAR); bar.x = 0; bar.st = nullptr;
    const bool one = (args.ph_hi - args.ph_lo) > 1;
    if (one) bar = xcd_barrier_post((unsigned*)(F.ctl + CW_BAR), F.MISC + 8);
    const int lo = args.ph_lo, hi = args.ph_hi;
#define IN(k) (lo <= (k) && (k) < hi)
#define SEAM(k) do { if (IN(k) && IN((k) + 1)) xcd_barrier(bar); } while (0)
    unsigned char* ws = args.ws;
    if (IN(0)) { p0a(F, args.in); SEAM(0); }
    if (IN(1)) { p0b(F, args.in); SEAM(1); }
    for (int p = (lo > 2 ? lo : 2); p < hi; ++p) {
        const int l = (p - 2) >> 2, sub = (p - 2) & 3, j = l >> 1; const bool fx = l & 1;
        if (sub == 0 || sub == 3) {
            const bool isout = sub == 3;
            pg8::Gemm g{(const pg8::bf16_t*)(ws + (isout ? WS_AO : WS_XS)), (const pg8::bf16_t*)(ws + (isout ? WS_WOUT + (size_t)l * WOUT_STRIDE : WS_WIN + (size_t)l * WIN_STRIDE)), M, isout ? DM : (fx ? FX_INP : HG_IN), DM};
            pg8::StaticOrder S; S.init(M, g.N, F.G, (int)blockIdx.x);
            pg8::EpiAll E; E.ws = ws; E.x0 = args.in[0]; E.xo = args.out; E.l = l; E.isout = isout ? 1 : 0;
            pg8::gemm_phase<pg8::EpiAll, pg8::StaticOrder, PG8_ALIGN, PG8_SP2>(F.lds + RING_OFF, g, S, E);
        } else if (sub == 1) {
            if (!fx) continue;
            fox_cumsum(F);
        } else {
            if (fx) {
#if FAST_ATTN
                const attn_body::AttnTensors AT{(const attn_body::bf16*)(ws + WS_B0), (const attn_body::bf16*)(ws + WS_B0 + BUF_STRIDE), (const attn_body::bf16*)(ws + WS_B0 + 2 * BUF_STRIDE),
                                                (const attn_body::bf16*)(ws + WS_KX), (const attn_body::bf16*)(ws + WS_B0 + 3 * BUF_STRIDE), (attn_body::bf16*)(ws + WS_AO)};
                const attn_body::StaticOrder SA((int)F.G, (int)blockIdx.x);
                attn_body::attn_phase<attn_body::StaticOrder>((char*)lds + RING_OFF, AT, SA);
#else
                attn_naive(F);
#endif
            } else {
#if FAST_SCAN
                hg::scan_fast(F, j);
#else
                scan_naive(F, j);
#endif
            }
        }
        if (p + 1 < hi) xcd_barrier(bar);
    }
#undef IN
#undef SEAM
}

extern "C" void kernel_launch(void* const* d_in, const int* in_sizes, int n_in, void* d_out, int out_size, void* d_ws, size_t ws_size, hipStream_t stream) {
    static int grid = 0;
    if (grid == 0) {
        if (n_in != 14 || in_sizes[0] != M * DM || out_size != M * DM || ws_size < WS_END) { fprintf(stderr, "kernel_launch: unexpected shapes (n_in %d, in0 %d, out %d, ws %zu); nothing launched\n", n_in, n_in > 0 ? in_sizes[0] : -1, out_size, ws_size); grid = -1; return; }
        int dev = 0, cus = 0, per_cu = 0;
        if (hipGetDevice(&dev) != hipSuccess || hipDeviceGetAttribute(&cus, hipDeviceAttributeMultiprocessorCount, dev) != hipSuccess) { grid = -1; return; }
        if (hipFuncSetAttribute((const void*)fwd, hipFuncAttributeMaxDynamicSharedMemorySize, LDS_BYTES) != hipSuccess) { fprintf(stderr, "kernel_launch: hipFuncSetAttribute failed\n"); grid = -1; return; }
        if (hipOccupancyMaxActiveBlocksPerMultiprocessor(&per_cu, (const void*)fwd, NWAVES * 64, LDS_BYTES) != hipSuccess || per_cu < 1) fprintf(stderr, "kernel_launch: note: occupancy query reports %d workgroups per CU\n", per_cu);
        (void)hipGetLastError();
        grid = cus;
    }
    if (grid < 0) return;
    if (hipMemsetAsync((char*)d_ws + WS_CTL, 0, CTL_ZERO_BYTES, stream) != hipSuccess) { fprintf(stderr, "kernel_launch: hipMemsetAsync failed\n"); return; }
    Args a{};
    for (int i = 0; i < 14; ++i) a.in[i] = (const float*)d_in[i];
    a.out = (float*)d_out; a.ws = (unsigned char*)d_ws; a.li = 0; a.pad = 0;
#if MK_ONE_LAUNCH
    a.ph_lo = 0; a.ph_hi = N_PHASES;
    hipLaunchKernelGGL(fwd, dim3(grid), dim3(NWAVES * 64), LDS_BYTES, stream, a);
#else
    for (int p = 0; p < N_PHASES; ++p) {
        if (p >= 2 && ((p - 2) & 3) == 1 && (((p - 2) >> 2) & 1) == 0) continue;
        a.ph_lo = p; a.ph_hi = p + 1;
        hipLaunchKernelGGL(fwd, dim3(grid), dim3(NWAVES * 64), LDS_BYTES, stream, a);
    }
#endif
    const hipError_t le = hipPeekAtLastError();
    if (le != hipSuccess) fprintf(stderr, "kernel_launch: launch failed: %s\n", hipGetErrorName(le));
}
```

```cpp
#include <hip/hip_runtime.h>
#include <hip/hip_bf16.h>
#include <cstdio>
#include <cstdint>
#include <cmath>
#ifndef MK_ONE_LAUNCH
#define MK_ONE_LAUNCH 1
#endif
#ifndef FAST_ATTN
#define FAST_ATTN 1
#endif
#ifndef FAST_SCAN
#define FAST_SCAN 1
#endif
#ifndef SCAN_CHECK
#define SCAN_CHECK 0
#endif
#ifndef PROBE_DOUBLE
#define PROBE_DOUBLE 0
#endif
constexpr int BATCH = 8, SEQ = 4096, DM = 1024, M = BATCH * SEQ, DEPTH = 4;
constexpr int HG_H = 8, HG_DK = 128, HG_IN = 4096;
constexpr int FX_H = 16, FX_HD = 64, FX_IN = 4112, FX_INP = 4352;
constexpr float EPS = 1e-6f;
constexpr float LOG2E = 1.4426950408889634f;
constexpr float C2 = 0.125f * LOG2E;

namespace pg8 {
#define PG8_LAS __attribute__((address_space(3)))
typedef unsigned short bf16_t;
typedef short bf16x8 __attribute__((ext_vector_type(8)));
typedef float f32x4 __attribute__((ext_vector_type(4)));
typedef unsigned u32x4 __attribute__((ext_vector_type(4)));
constexpr int BM = 256, BK = 64, HALF = 128, HTB = HALF * BK * 2  , STAGE_BYTES = 8 * HTB, NXCD = 8, WGM = 8;

__host__ __device__ __forceinline__ int lds_byte(int r, int c) { const int st = (r >> 4) * 2 + (c >> 5), rr = r & 15, cc = c & 31, ob = rr * 64 + cc * 2; return st * 1024 + (ob ^ (((ob >> 9) & 1) << 5)); }
__host__ __device__ __forceinline__ void stage_rc(int b, int& R, int& C) { const int st = b / 1024, sb = b % 1024, swz = sb ^ (((sb >> 9) & 1) << 5); R = (st >> 1) * 16 + swz / 64; C = (st & 1) * 32 + (swz % 64) / 2; }
__host__ __device__ __forceinline__ int perm32(int rho) { const int n = rho >> 4, i = rho & 15; return 8 * (i >> 2) + 4 * n + (i & 3); }

struct Unit { int pm, pn; };
struct Gemm { const bf16_t* A; const bf16_t* Bt; int M, N, K; };

struct StaticOrder {
    int nM, nN, nwg, G, c;
    __host__ __device__ void init(int M, int N, int G_, int c_) { nM = M / BM; nN = N / BM; nwg = nM * nN; G = G_; c = c_; }
    __host__ __device__ bool next(int i, Unit& u) const {
        const long L = (long)i * G + c; if (L >= nwg) return false;
        int wgid = (int)L; { const int q = nwg / NXCD, r = nwg % NXCD, xcd = wgid % NXCD, off = wgid / NXCD; wgid = (xcd < r ? xcd * (q + 1) : r * (q + 1) + (xcd - r) * q) + off; }
        const int nig = WGM * nN, gid = wgid / nig, fm = gid * WGM, gsz = (nM - fm) < WGM ? (nM - fm) : WGM;
        u.pm = fm + ((wgid % nig) % gsz); u.pn = (wgid % nig) / gsz; return true;
    }
    __device__ __forceinline__ void a_ready(const Unit&) const {}
    __device__ __forceinline__ void done(const Unit&) const {}
};
template <class Epi, class Sched, bool ALIGN_EPI = false, bool SP2 = false>
__device__ __forceinline__ void gemm_phase(PG8_LAS unsigned char* lds, const Gemm g, const Sched& S, const Epi& E) {
    int tid_ = threadIdx.x; asm volatile("" : "+v"(tid_));
    const int tid = tid_, wid = __builtin_amdgcn_readfirstlane(tid >> 6), lane = tid & 63, wr = wid >> 2, wc = wid & 3, fr = lane & 15, fq = lane >> 4;
    const int K = g.K, nt = K / BK;
    unsigned voffA[2], voffB[2];
#pragma unroll
    for (int i = 0; i < 2; ++i) { int R, C; stage_rc(tid * 16 + i * 8192, R, C); const int Rb = Epi::PMODE == 2 ? (64 * (R >> 5) + perm32(R & 31)) : (Epi::PMODE == 1 ? ((R & ~31) + perm32(R & 31)) : R);
        voffA[i] = (unsigned)(R * K + C) * 2u; voffB[i] = (unsigned)(Rb * K + C) * 2u; }
    const size_t kstep = (size_t)(BK * 2);
    const size_t hstep = (size_t)HALF * K * 2;
    const size_t hstepB = (Epi::PMODE == 2) ? (size_t)32 * K * 2 : hstep;
    const size_t tstep = 2 * hstep;
    const unsigned ldsw = (unsigned)wid * 1024u;
    const int aoff = lds_byte(wr * 64 + fr, fq * 8), boff = lds_byte(wc * 32 + fr, fq * 8);
#define PG8_SA(b, h) (((b) * 2 + (h)) * HTB)
#define PG8_SB(b, h) ((4 + (b) * 2 + (h)) * HTB)
#define PG8_STAGE(bufoff, gbase, voff) do { _Pragma("unroll") for (int _i = 0; _i < 2; ++_i) \
        __builtin_amdgcn_global_load_lds((const unsigned*)((const char*)(gbase) + (voff)[_i]), (PG8_LAS unsigned*)(lds + (bufoff) + ldsw + _i * 8192), 16, 0, 0); } while (0)
#define PG8_LDA(dst, b, h) do { _Pragma("unroll") for (int m = 0; m < 4; ++m) _Pragma("unroll") for (int k = 0; k < 2; ++k) dst[m][k] = *(const PG8_LAS bf16x8*)(lds + PG8_SA(b, h) + aoff + m * 2048 + k * 1024); } while (0)
#define PG8_LDB(dst, b, h) do { _Pragma("unroll") for (int n = 0; n < 2; ++n) _Pragma("unroll") for (int k = 0; k < 2; ++k) dst[n][k] = *(const PG8_LAS bf16x8*)(lds + PG8_SB(b, h) + boff + n * 2048 + k * 1024); } while (0)
#define PG8_MMA(ai, bj, At, Bt) do { __builtin_amdgcn_s_setprio(1); _Pragma("unroll") for (int m = 0; m < 4; ++m) _Pragma("unroll") for (int n = 0; n < 2; ++n) _Pragma("unroll") for (int k = 0; k < 2; ++k) \
        acc[ai][bj][m][n] = __builtin_amdgcn_mfma_f32_16x16x32_bf16(Bt[n][k], At[m][k], acc[ai][bj][m][n], 0, 0, 0); __builtin_amdgcn_s_setprio(0); } while (0)
#define PG8_WAIT_V(n) asm volatile("s_waitcnt vmcnt(" #n ")" ::: "memory")
#define PG8_WAIT_L(n) asm volatile("s_waitcnt lgkmcnt(" #n ")" ::: "memory")
#define PG8_BAR __builtin_amdgcn_s_barrier()
#define PG8_SCHED __builtin_amdgcn_sched_barrier(0)
    Unit cur, nxt; int ui = 0;
    if (!S.next(0, cur)) return;
    f32x4 acc[2][2][4][2];
#pragma unroll
    for (int a = 0; a < 2; ++a)
#pragma unroll
        for (int b = 0; b < 2; ++b)
#pragma unroll
            for (int m = 0; m < 4; ++m)
#pragma unroll
                for (int n = 0; n < 2; ++n) acc[a][b][m][n] = (f32x4){0.f, 0.f, 0.f, 0.f};
    bf16x8 At[4][2], B0[2][2], B1[2][2];
    const char* cA = (const char*)g.A + (size_t)cur.pm * tstep; const char* cB = (const char*)g.Bt + (size_t)cur.pn * tstep;
    S.a_ready(cur);
    if constexpr (SP2) {
        PG8_STAGE(PG8_SB(0, 0), cB, voffB); PG8_STAGE(PG8_SB(0, 1), cB + hstepB, voffB); PG8_STAGE(PG8_SA(0, 0), cA, voffA); PG8_STAGE(PG8_SA(0, 1), cA + hstep, voffA);
        if (wr == 1) PG8_BAR;
        PG8_WAIT_V(2); PG8_BAR;
        PG8_STAGE(PG8_SB(1, 0), cB + kstep, voffB); PG8_STAGE(PG8_SA(1, 0), cA + kstep, voffA); PG8_STAGE(PG8_SB(1, 1), cB + hstepB + kstep, voffB);
        PG8_WAIT_V(6); PG8_BAR;
    } else {
        PG8_STAGE(PG8_SB(0, 0), cB, voffB); PG8_STAGE(PG8_SA(0, 0), cA, voffA); PG8_STAGE(PG8_SB(0, 1), cB + hstepB, voffB); PG8_STAGE(PG8_SA(0, 1), cA + hstep, voffA);
        if (wr == 1) PG8_BAR;
        PG8_WAIT_V(4); PG8_BAR;
        PG8_STAGE(PG8_SB(1, 0), cB + kstep, voffB); PG8_STAGE(PG8_SA(1, 0), cA + kstep, voffA); PG8_STAGE(PG8_SB(1, 1), cB + hstepB + kstep, voffB);
        PG8_WAIT_V(6); PG8_BAR;
    }
    for (;;) {
        const bool has_next = S.next(ui + 1, nxt);
        const char* nA = has_next ? (const char*)g.A + (size_t)nxt.pm * tstep : cA; const char* nB = has_next ? (const char*)g.Bt + (size_t)nxt.pn * tstep : cB;
        for (int t = 0; t < nt; t += 2) {
            const bool last = (t == nt - 2);
            const char* a1 = cA + (size_t)(t + 1) * kstep;
            const char* a2 = last ? nA : cA + (size_t)(t + 2) * kstep; const char* b2 = last ? nB : cB + (size_t)(t + 2) * kstep;
            const char* a3 = a2 + kstep; const char* b3 = b2 + kstep;
            if (last && has_next) S.a_ready(nxt);
            if constexpr (SP2) {
            PG8_LDB(B0, 0, 0); PG8_LDB(B1, 0, 1); PG8_SCHED; PG8_LDA(At, 0, 0); PG8_STAGE(PG8_SA(1, 1), a1 + hstep, voffA);
            PG8_WAIT_V(8); PG8_WAIT_L(0); PG8_BAR; PG8_MMA(0, 0, At, B0); PG8_MMA(0, 1, At, B1); PG8_BAR; PG8_SCHED;
            PG8_LDA(At, 0, 1); PG8_STAGE(PG8_SB(0, 0), b2, voffB); PG8_STAGE(PG8_SB(0, 1), b2 + hstepB, voffB); PG8_STAGE(PG8_SA(0, 0), a2, voffA);
            PG8_WAIT_V(8); PG8_WAIT_L(0); PG8_BAR; PG8_MMA(1, 0, At, B0); PG8_MMA(1, 1, At, B1); PG8_BAR; PG8_SCHED;
            PG8_LDB(B0, 1, 0); PG8_LDB(B1, 1, 1); PG8_SCHED; PG8_LDA(At, 1, 0); PG8_STAGE(PG8_SA(0, 1), a2 + hstep, voffA);
            PG8_WAIT_V(8); PG8_WAIT_L(0); PG8_BAR; PG8_MMA(0, 0, At, B0); PG8_MMA(0, 1, At, B1); PG8_BAR; PG8_SCHED;
            PG8_LDA(At, 1, 1); PG8_STAGE(PG8_SB(1, 0), b3, voffB); PG8_STAGE(PG8_SB(1, 1), b3 + hstepB, voffB); PG8_STAGE(PG8_SA(1, 0), a3, voffA);
            PG8_WAIT_V(8); PG8_WAIT_L(0); PG8_BAR; PG8_MMA(1, 0, At, B0); PG8_MMA(1, 1, At, B1); PG8_BAR; PG8_SCHED;
            } else {
            PG8_LDB(B0, 0, 0); PG8_SCHED; PG8_LDA(At, 0, 0); PG8_STAGE(PG8_SA(1, 1), a1 + hstep, voffA);
            PG8_WAIT_L(8); PG8_BAR; PG8_WAIT_L(0); PG8_MMA(0, 0, At, B0); PG8_BAR; PG8_SCHED;
            PG8_LDB(B1, 0, 1); PG8_STAGE(PG8_SB(0, 0), b2, voffB);
            PG8_BAR; PG8_WAIT_L(0); PG8_MMA(0, 1, At, B1); PG8_BAR;
            PG8_LDA(At, 0, 1); PG8_STAGE(PG8_SA(0, 0), a2, voffA);
            PG8_BAR; PG8_WAIT_L(0); PG8_MMA(1, 0, At, B0); PG8_BAR; PG8_SCHED;
            PG8_STAGE(PG8_SB(0, 1), b2 + hstepB, voffB);
            PG8_WAIT_V(6); PG8_BAR; PG8_MMA(1, 1, At, B1); PG8_BAR;
            PG8_LDB(B0, 1, 0); PG8_SCHED; PG8_LDA(At, 1, 0); PG8_STAGE(PG8_SA(0, 1), a2 + hstep, voffA);
            PG8_WAIT_L(8); PG8_BAR; PG8_WAIT_L(0); PG8_MMA(0, 0, At, B0); PG8_BAR; PG8_SCHED;
            PG8_LDB(B1, 1, 1); PG8_STAGE(PG8_SB(1, 0), b3, voffB);
            PG8_BAR; PG8_WAIT_L(0); PG8_MMA(0, 1, At, B1); PG8_BAR;
            PG8_LDA(At, 1, 1); PG8_STAGE(PG8_SA(1, 0), a3, voffA);
            PG8_BAR; PG8_WAIT_L(0); PG8_MMA(1, 0, At, B0); PG8_BAR; PG8_SCHED;
            PG8_STAGE(PG8_SB(1, 1), b3 + hstepB, voffB);
            PG8_WAIT_V(6); PG8_BAR; PG8_MMA(1, 1, At, B1); PG8_BAR;
            }
        }
        if constexpr (ALIGN_EPI) { if (wr == 0) PG8_BAR; }
        if constexpr (!Epi::AFTER_DRAIN) { E(acc, cur, wr, wc, fr, fq); S.done(cur); }
        if (!has_next) break;
#pragma unroll
        for (int a = 0; a < 2; ++a)
#pragma unroll
            for (int b = 0; b < 2; ++b)
#pragma unroll
                for (int m = 0; m < 4; ++m)
#pragma unroll
                    for (int n = 0; n < 2; ++n) acc[a][b][m][n] = (f32x4){0.f, 0.f, 0.f, 0.f};
        cur = nxt; cA = nA; cB = nB; ++ui;
        if constexpr (ALIGN_EPI) { if (wr == 1) PG8_BAR; }
    }
    PG8_WAIT_V(0);
    if constexpr (!ALIGN_EPI) { if (wr == 0) PG8_BAR; }
    PG8_BAR;
    if constexpr (Epi::AFTER_DRAIN) { E.fused(acc, cur, wr, wc, fr, fq, lds, wid, lane); S.done(cur); }
#undef PG8_SA
#undef PG8_SB
#undef PG8_STAGE
#undef PG8_LDA
#undef PG8_LDB
#undef PG8_MMA
#undef PG8_WAIT_V
#undef PG8_WAIT_L
#undef PG8_BAR
#undef PG8_SCHED
}
}

#ifndef PG8_SP2
#define PG8_SP2 true
#endif
#ifndef PG8_ALIGN
#define PG8_ALIGN true
#endif
constexpr size_t MiB = 1u << 20;
constexpr size_t WS_CTL = 0, CTL_ZERO_BYTES = 1 * MiB;
constexpr size_t WS_ROWSS = 65536;
constexpr size_t WS_WIN = 4 * MiB, WIN_STRIDE = 10 * MiB;
constexpr size_t WS_WOUT = 44 * MiB, WOUT_STRIDE = 2 * MiB;
constexpr size_t WS_XS = 64 * MiB;
constexpr size_t WS_B0 = 128 * MiB, BUF_STRIDE = 64 * MiB;
constexpr size_t WS_AO = 384 * MiB;
constexpr size_t WS_MISC = 448 * MiB;
constexpr size_t WS_GS = WS_MISC, WS_SH = WS_MISC + 128 * 1024, WS_GATE = WS_MISC + 256 * 1024, WS_LB = WS_MISC + 384 * 1024;
constexpr size_t WS_PAR = WS_MISC + 400 * 1024;
constexpr size_t WS_BIAS = WS_MISC + 1 * MiB;
constexpr size_t WS_LF = WS_MISC + 2 * MiB;
constexpr size_t WS_CKL = WS_MISC + 4 * MiB;
constexpr size_t WS_KX = WS_MISC + 6 * MiB;
constexpr size_t WS_SLOC = WS_MISC + 16 * MiB;
constexpr size_t WS_DTOT = WS_MISC + 32 * MiB;
constexpr size_t WS_END = WS_MISC + 34 * MiB;
constexpr int CW_TMO = 0, CW_CODE = 1, CW_BAR = 4096;
constexpr int BIAS_LD = FX_INP;

constexpr int RING_OFF = 0, RING_BYTES = 131072;
constexpr int LDSCTL_OFF = RING_BYTES, MISC_OFF = LDSCTL_OFF + 320;
constexpr int LDS_BYTES = 147456;
constexpr int NWAVES = 8;

namespace pg8 {
#define PG8_GAS __attribute__((address_space(1)))
__device__ __forceinline__ unsigned cvt_pk_bf16(float lo, float hi) { unsigned r; asm volatile("v_cvt_pk_bf16_f32 %0, %1, %2" : "=v"(r) : "v"(lo), "v"(hi)); return r; }
typedef _Float16 f16x2 __attribute__((ext_vector_type(2)));
__device__ __forceinline__ unsigned cvt_pk_f16(float lo, float hi) { f16x2 v = {(_Float16)lo, (_Float16)hi}; return __builtin_bit_cast(unsigned, v); }
__device__ __forceinline__ float fast_sigmoid(float v) { return __builtin_amdgcn_rcpf(1.0f + __builtin_amdgcn_exp2f(v * -LOG2E)); }
__device__ __forceinline__ float fast_log(float v) { return __builtin_amdgcn_logf(v) * 0.6931471805599453f; }
__device__ __forceinline__ float log_sigmoid(float v) { return fminf(v, 0.f) - fast_log(1.0f + __builtin_amdgcn_exp2f(fabsf(v) * -LOG2E)); }

struct EpiAll {
    static constexpr int PMODE = 2; static constexpr bool AFTER_DRAIN = false;
    unsigned char* ws; const float* x0; float* xo; int l; int isout;
    __device__ __forceinline__ void operator()(const f32x4 (&acc)[2][2][4][2], const Unit& u, int wr_, int wc_, int fr_, int fq_) const {
        if (isout) epi_out(acc, u, wr_, wc_, fr_, fq_); else epi_in(acc, u, wr_, wc_, fr_, fq_);
    }
    __device__ __forceinline__ void epi_in(const f32x4 (&acc)[2][2][4][2], const Unit& u, int wr_, int wc_, int fr_, int fq_) const {
        unsigned char* w = ws; int wr = wr_, wc = wc_, fr = fr_, fq = fq_, ll = l;
        asm volatile("" : "+s"(w), "+s"(ll), "+s"(wr), "+s"(wc), "+v"(fr), "+v"(fq));
        const int kind = ll & 1, jj = ll >> 1;
        const PG8_GAS float* rowss = (const PG8_GAS float*)(w + WS_ROWSS) + (size_t)ll * M;
        const int nb = BIAS_LD; const PG8_GAS float* bias = (const PG8_GAS float*)(w + WS_BIAS) + (size_t)ll * 8 * BIAS_LD;
        PG8_GAS bf16_t* obase = (PG8_GAS bf16_t*)(w + WS_B0); const size_t ostride = BUF_STRIDE / 2;
        const PG8_GAS float* lb = (kind == 0 && jj > 0) ? (const PG8_GAS float*)(w + WS_LB) + jj * 1024 : nullptr;
        const PG8_GAS float* qg = (const PG8_GAS float*)(w + WS_PAR) + jj * 64; const PG8_GAS float* kg = (const PG8_GAS float*)(w + WS_PAR) + 128 + jj * 64;
        const int t = u.pn >> 2, b = u.pm >> 4;
        const int crel = 64 * wc + 8 * fq, gcol0 = u.pn * 256 + crel, ocol0 = (u.pn & 3) * 256 + crel;
        f32x4 bv[2][2], pv[2][2];
#pragma unroll
        for (int bj = 0; bj < 2; ++bj)
#pragma unroll
            for (int n = 0; n < 2; ++n) {
                bv[bj][n] = *(const PG8_GAS f32x4*)(bias + (size_t)b * nb + gcol0 + 32 * bj + 4 * n);
                pv[bj][n] = (f32x4){0.f, 0.f, 0.f, 0.f};
                if (kind == 0) { if (t == 1 && lb) pv[bj][n] = *(const PG8_GAS f32x4*)(lb + ocol0 + 32 * bj + 4 * n); }
                else { if (t == 0) pv[bj][n] = *(const PG8_GAS f32x4*)(qg + 32 * bj + 8 * fq + 4 * n) * C2; else if (t == 1) pv[bj][n] = *(const PG8_GAS f32x4*)(kg + 32 * bj + 8 * fq + 4 * n); }
            }
        PG8_GAS bf16_t* ob = obase + (size_t)(t & 3) * ostride;
        float rs[2][4];
#pragma unroll
        for (int ai = 0; ai < 2; ++ai)
#pragma unroll
            for (int m = 0; m < 4; ++m) rs[ai][m] = rowss[u.pm * 256 + ai * 128 + wr * 64 + m * 16 + fr];
#pragma unroll
        for (int ai = 0; ai < 2; ++ai)
#pragma unroll
            for (int m = 0; m < 4; ++m) {
                const int row = u.pm * 256 + ai * 128 + wr * 64 + m * 16 + fr;
                const float rstd = rsqrtf(rs[ai][m] * (1.0f / 1024.0f) + EPS);
                f32x4 v[2][2];
#pragma unroll
                for (int bj = 0; bj < 2; ++bj)
#pragma unroll
                    for (int n = 0; n < 2; ++n) v[bj][n] = acc[ai][bj][m][n] * rstd + bv[bj][n];
                bool half16 = false;
                if (kind == 0) {
                    if (t == 1) {
                        half16 = true;
#pragma unroll
                        for (int bj = 0; bj < 2; ++bj)
#pragma unroll
                            for (int n = 0; n < 2; ++n)
#pragma unroll
                                for (int e = 0; e < 4; ++e) { const float fl = v[bj][n][e];
                                    v[bj][n][e] = lb ? fast_log(pv[bj][n][e] + (1.0f - pv[bj][n][e]) * fast_sigmoid(fl)) : log_sigmoid(fl); }
                    } else if (t == 3) {
#pragma unroll
                        for (int bj = 0; bj < 2; ++bj)
#pragma unroll
                            for (int n = 0; n < 2; ++n)
#pragma unroll
                                for (int e = 0; e < 4; ++e) { const float z = v[bj][n][e]; v[bj][n][e] = z * fast_sigmoid(z); }
                    }
                } else {
                    if (t <= 1) {
                        float ss = 0.f;
#pragma unroll
                        for (int bj = 0; bj < 2; ++bj)
#pragma unroll
                            for (int n = 0; n < 2; ++n) { const f32x4 x = v[bj][n]; ss += (x[0] * x[0] + x[1] * x[1]) + (x[2] * x[2] + x[3] * x[3]); }
                        ss += __shfl_xor(ss, 16); ss += __shfl_xor(ss, 32);
                        const float rn = rsqrtf(ss * (1.0f / 64.0f) + EPS);
#pragma unroll
                        for (int bj = 0; bj < 2; ++bj)
#pragma unroll
                            for (int n = 0; n < 2; ++n) v[bj][n] = v[bj][n] * rn * pv[bj][n];
                    } else if (t == 3) {
#pragma unroll
                        for (int bj = 0; bj < 2; ++bj)
#pragma unroll
                            for (int n = 0; n < 2; ++n)
#pragma unroll
                                for (int e = 0; e < 4; ++e) { const float z = v[bj][n][e]; v[bj][n][e] = z * fast_sigmoid(z); }
                    }
                }
                PG8_GAS bf16_t* rowp = ob + (size_t)row * 1024 + ocol0;
#pragma unroll
                for (int bj = 0; bj < 2; ++bj) { u32x4 w;
                    if (half16) { w.x = cvt_pk_f16(v[bj][0][0], v[bj][0][1]); w.y = cvt_pk_f16(v[bj][0][2], v[bj][0][3]); w.z = cvt_pk_f16(v[bj][1][0], v[bj][1][1]); w.w = cvt_pk_f16(v[bj][1][2], v[bj][1][3]); }
                    else { w.x = cvt_pk_bf16(v[bj][0][0], v[bj][0][1]); w.y = cvt_pk_bf16(v[bj][0][2], v[bj][0][3]); w.z = cvt_pk_bf16(v[bj][1][0], v[bj][1][1]); w.w = cvt_pk_bf16(v[bj][1][2], v[bj][1][3]); }
                    *(PG8_GAS u32x4*)(rowp + 32 * bj) = w; }
            }
    }

    __device__ __forceinline__ void epi_out(const f32x4 (&acc)[2][2][4][2], const Unit& u, int wr_, int wc_, int fr_, int fq_) const {
        unsigned char* w = ws; int wr = wr_, wc = wc_, fr = fr_, fq = fq_, ll = l; const float* xin_ = (l == 0) ? x0 : xo; float* xout_ = xo;
        asm volatile("" : "+s"(w), "+s"(ll), "+s"(wr), "+s"(wc), "+v"(fr), "+v"(fq), "+s"(xin_), "+s"(xout_));
        const PG8_GAS float* xin = (const PG8_GAS float*)xin_; PG8_GAS float* xout = (PG8_GAS float*)xout_;
        const PG8_GAS float* gate = (const PG8_GAS float*)(w + WS_GATE) + (size_t)ll * 8 * 1024;
        const PG8_GAS float* gsn = (ll + 1 < DEPTH) ? (const PG8_GAS float*)(w + WS_GS) + (size_t)(ll + 1) * 8 * 1024 : nullptr;
        PG8_GAS bf16_t* xs = (PG8_GAS bf16_t*)(w + WS_XS); float* rowssn = (float*)(w + WS_ROWSS) + (size_t)(ll + 1 < DEPTH ? ll + 1 : 0) * M;
        const int b = u.pm >> 4, col0 = u.pn * 256 + 64 * wc + 8 * fq;
        f32x4 gv[2][2], sv[2][2];
#pragma unroll
        for (int bj = 0; bj < 2; ++bj)
#pragma unroll
            for (int n = 0; n < 2; ++n) { gv[bj][n] = *(const PG8_GAS f32x4*)(gate + b * 1024 + col0 + 32 * bj + 4 * n);
                sv[bj][n] = gsn ? *(const PG8_GAS f32x4*)(gsn + b * 1024 + col0 + 32 * bj + 4 * n) : (f32x4){0.f, 0.f, 0.f, 0.f}; }
#pragma unroll
        for (int ai = 0; ai < 2; ++ai)
#pragma unroll
            for (int m = 0; m < 4; ++m) {
                const int row = u.pm * 256 + ai * 128 + wr * 64 + m * 16 + fr; float ss = 0.f;
#pragma unroll
                for (int bj = 0; bj < 2; ++bj) { const size_t off = (size_t)row * 1024 + col0 + 32 * bj;
                    const f32x4 y0 = *(const PG8_GAS f32x4*)(xin + off) + gv[bj][0] * acc[ai][bj][m][0], y1 = *(const PG8_GAS f32x4*)(xin + off + 4) + gv[bj][1] * acc[ai][bj][m][1];
                    *(PG8_GAS f32x4*)(xout + off) = y0; *(PG8_GAS f32x4*)(xout + off + 4) = y1;
                    ss += (y0[0] * y0[0] + y0[1] * y0[1]) + (y0[2] * y0[2] + y0[3] * y0[3]) + (y1[0] * y1[0] + y1[1] * y1[1]) + (y1[2] * y1[2] + y1[3] * y1[3]);
                    if (gsn) { const f32x4 a0 = y0 * sv[bj][0], a1 = y1 * sv[bj][1]; u32x4 w; w.x = cvt_pk_bf16(a0[0], a0[1]); w.y = cvt_pk_bf16(a0[2], a0[3]); w.z = cvt_pk_bf16(a1[0], a1[1]); w.w = cvt_pk_bf16(a1[2], a1[3]);
                        *(PG8_GAS u32x4*)(xs + off) = w; } }
                if (gsn) { ss += __shfl_xor(ss, 16); ss += __shfl_xor(ss, 32); if (fq == 0) atomicAdd(rowssn + row, ss); }
            }
    }
};
}
#include <hip/hip_bf16.h>
#include <cmath>
namespace attn_body {
using bf16=__hip_bfloat16;
using bf16x8=__attribute__((ext_vector_type(8)))short;
using s16x4=__attribute__((ext_vector_type(4)))short;
using f32x16=__attribute__((ext_vector_type(16)))float;
using u32x4=__attribute__((ext_vector_type(4)))unsigned;
constexpr int BATCH=8,NHEAD=16,SEQ=4096,D=64,DM=NHEAD*D;
constexpr int NW=8,QBLK=32,QB=QBLK*NW,KVBLK=64,NQB=SEQ/QB;
constexpr int ATTN_PITCH=DM, ATTN_UNIT_ROWS=QB;
__device__ __forceinline__ int crow(int r,int hi){return (r&3)+8*(r>>2)+4*hi;}
#define SBAR() __builtin_amdgcn_sched_barrier(0)
__device__ __forceinline__ void cmask(f32x16&p0,f32x16&p1,int jb,int qrel,int hi){
  const float NEG=-INFINITY; int kb=64*jb+4*hi;
  #pragma unroll
  for(int r=0;r<16;++r){int kv=kb+(r&3)+8*(r>>2); if(kv>qrel)p0[r]=NEG; if(kv+32>qrel)p1[r]=NEG;}
}

constexpr size_t ATT_WS_Q=WS_B0, ATT_WS_K=WS_B0+BUF_STRIDE, ATT_WS_V=WS_B0+2*BUF_STRIDE, ATT_WS_Z=WS_B0+3*BUF_STRIDE, ATT_WS_KX=WS_KX, ATT_WS_CKL=WS_CKL, ATT_WS_O=WS_AO;
constexpr int NSLOT=3, SLOTB=8192;
constexpr int LDS_K=0, LDS_V=NSLOT*SLOTB, LDS_KX=2*NSLOT*SLOTB, LDS_WS=LDS_KX+4*1024, LDS_OST=LDS_WS+NW*64*4, LDS_BYTES=LDS_OST+NW*4096;
constexpr float C2=0.125f*1.4426950408889634f;
__device__ __forceinline__ void glds16(const void*sbase,unsigned voff,unsigned lds_dst){unsigned keep;
  asm volatile("s_mov_b32 %0, m0\n\ts_mov_b32 m0, %3\n\ts_nop 0\n\tglobal_load_lds_dwordx4 %1, %2\n\ts_mov_b32 m0, %0":"=&s"(keep):"v"(voff),"s"(sbase),"s"(lds_dst):"memory");}
__device__ __forceinline__ float max3f(float a,float b,float c){float r;asm("v_max3_f32 %0, %1, %2, %3":"=v"(r):"v"(a),"v"(b),"v"(c));return r;}
__device__ __forceinline__ float max2f(float a,float b){float r;asm("v_max_f32_e32 %0, %1, %2":"=v"(r):"v"(a),"v"(b));return r;}
__device__ __forceinline__ float fadd_s(float a,float b){float r;asm("v_add_f32_e32 %0, %1, %2":"=v"(r):"v"(a),"v"(b));return r;}
__device__ __forceinline__ float fsub_s(float a,float b){float r;asm("v_sub_f32_e32 %0, %1, %2":"=v"(r):"v"(a),"v"(b));return r;}
typedef float f32x2_t __attribute__((ext_vector_type(2))); typedef __bf16 bf16x2_t __attribute__((ext_vector_type(2)));
__device__ __forceinline__ unsigned cvtpk_s(float lo,float hi){f32x2_t v={lo,hi};bf16x2_t b=__builtin_convertvector(v,bf16x2_t);return __builtin_bit_cast(unsigned,b);}
#define WAIT_BAR(N) asm volatile("s_waitcnt vmcnt(" #N ") lgkmcnt(0)\n\ts_barrier":::"memory")

__device__ __forceinline__ void qkt(f32x16&p0,f32x16&p1,const char*Kslot,const char*KXslot,const bf16x8*qr,const f32x16&negm,int r32,int hi){
  const char*kb=Kslot+hi*1024+r32*16;
  #pragma unroll
  for(int d0=0;d0<4;++d0){
    const bf16x8 b0=*reinterpret_cast<const bf16x8*>(kb+d0*2048);
    const bf16x8 b1=*reinterpret_cast<const bf16x8*>(kb+d0*2048+512);
    if(d0==0){p0=__builtin_amdgcn_mfma_f32_32x32x16_bf16(b0,qr[0],negm,0,0,0);p1=__builtin_amdgcn_mfma_f32_32x32x16_bf16(b1,qr[0],negm,0,0,0);}
    else{p0=__builtin_amdgcn_mfma_f32_32x32x16_bf16(b0,qr[d0],p0,0,0,0);p1=__builtin_amdgcn_mfma_f32_32x32x16_bf16(b1,qr[d0],p1,0,0,0);}}
  { const bf16x8 e0=*reinterpret_cast<const bf16x8*>(KXslot+r32*16), e1=*reinterpret_cast<const bf16x8*>(KXslot+r32*16+512);
    p0=__builtin_amdgcn_mfma_f32_32x32x16_bf16(e0,qr[4],p0,0,0,0);p1=__builtin_amdgcn_mfma_f32_32x32x16_bf16(e1,qr[4],p1,0,0,0);}
}
typedef __attribute__((address_space(3))) const char* lds_cptr;
typedef short v4i16_t __attribute__((ext_vector_type(4)));
__device__ __forceinline__ void kload8(bf16x8*kf,lds_cptr kp){
  kf[0]=*(const __attribute__((address_space(3))) bf16x8*)(kp);      kf[1]=*(const __attribute__((address_space(3))) bf16x8*)(kp+512);
  kf[2]=*(const __attribute__((address_space(3))) bf16x8*)(kp+2048); kf[3]=*(const __attribute__((address_space(3))) bf16x8*)(kp+2560);
  kf[4]=*(const __attribute__((address_space(3))) bf16x8*)(kp+4096); kf[5]=*(const __attribute__((address_space(3))) bf16x8*)(kp+4608);
  kf[6]=*(const __attribute__((address_space(3))) bf16x8*)(kp+6144); kf[7]=*(const __attribute__((address_space(3))) bf16x8*)(kp+6656);
}
__device__ __forceinline__ void kload2(bf16x8*kf,lds_cptr kp,int j){ kf[2*j]=*(const __attribute__((address_space(3))) bf16x8*)(kp+j*2048); kf[2*j+1]=*(const __attribute__((address_space(3))) bf16x8*)(kp+j*2048+512); }
__device__ __forceinline__ s16x4 vtr(lds_cptr p){ return __builtin_bit_cast(s16x4,__builtin_amdgcn_ds_read_tr16_b64_v4i16((__attribute__((address_space(3))) v4i16_t*)p)); }
__device__ __forceinline__ float rowmax(const f32x16&p0,const f32x16&p1){
  float a=max3f(p0[0],p0[1],p1[0]),b=max3f(p0[2],p0[3],p1[1]);a=max3f(a,p1[2],p1[3]);
  #pragma unroll
  for(int r=4;r<16;r+=4){a=max3f(a,p0[r],p0[r+1]);b=max3f(b,p0[r+2],p0[r+3]);a=max3f(a,p1[r],p1[r+1]);b=max3f(b,p1[r+2],p1[r+3]);}
  const float m=max2f(a,b);
  auto rr=__builtin_amdgcn_permlane32_swap(__float_as_uint(m),__float_as_uint(m),false,false);
  return max2f(__uint_as_float(rr[0]),__uint_as_float(rr[1]));
}
__device__ __forceinline__ void pv(f32x16*o,int vb,bf16x8 pa0,bf16x8 pa1,bf16x8 pa2,bf16x8 pa3){
  #pragma unroll
  for(int d0=0;d0<2;++d0){s16x4 lo[4],hi[4];
    #pragma unroll
    for(int ks=0;ks<4;++ks){
      asm volatile("ds_read_b64_tr_b16 %0,%1 offset:%c2":"=&v"(lo[ks]):"v"(vb),"i"(d0*4096+ks*1024):"memory");
      asm volatile("ds_read_b64_tr_b16 %0,%1 offset:%c2":"=&v"(hi[ks]):"v"(vb),"i"(d0*4096+ks*1024+512):"memory");}
    asm volatile("s_waitcnt lgkmcnt(0)":::"memory");SBAR();
    #define PK(k) (bf16x8){lo[k][0],lo[k][1],lo[k][2],lo[k][3],hi[k][0],hi[k][1],hi[k][2],hi[k][3]}
    o[d0]=__builtin_amdgcn_mfma_f32_32x32x16_bf16(pa0,PK(0),o[d0],0,0,0);
    o[d0]=__builtin_amdgcn_mfma_f32_32x32x16_bf16(pa1,PK(1),o[d0],0,0,0);
    o[d0]=__builtin_amdgcn_mfma_f32_32x32x16_bf16(pa2,PK(2),o[d0],0,0,0);
    o[d0]=__builtin_amdgcn_mfma_f32_32x32x16_bf16(pa3,PK(3),o[d0],0,0,0);
    #undef PK
  }
}

#ifndef ATTN_STORE16
#define ATTN_STORE16(p,v) (*(u32x4*)(p)=(v))
#endif
template<int THRL> __device__ __forceinline__ void attn_unit(int b,int h,int qb,unsigned char*wsb,float Tthr,char*shm){
  asm volatile("":"+s"(wsb));
  const bf16*Q=(const bf16*)(wsb+ATT_WS_Q); const bf16*__restrict__ K=(const bf16*)(wsb+ATT_WS_K); const bf16*__restrict__ V=(const bf16*)(wsb+ATT_WS_V); const bf16*__restrict__ KX=(const bf16*)(wsb+ATT_WS_KX);
  const bf16*__restrict__ Z=(const bf16*)(wsb+ATT_WS_Z); const float*__restrict__ CKL=(const float*)(wsb+ATT_WS_CKL); bf16*O=(bf16*)(wsb+ATT_WS_O);
  int tid_=threadIdx.x; asm volatile("":"+v"(tid_));
  const int tid=tid_,lane=tid&63,r32=lane&31,hi=lane>>5; const int wid=__builtin_amdgcn_readfirstlane(tid>>6);
  const long rowbase=(long)b*SEQ; const int q0=qb*QB;
  const bf16*Qw=Q+(rowbase+q0+wid*QBLK)*DM+h*D;
  const bf16*Kh=K+rowbase*DM+h*D,*Vh=V+rowbase*DM+h*D; const bf16*KXh=KX+((long)(b*NHEAD+h)*SEQ)*8;
  int j0=0;
  { const float*ck=CKL+(long)(b*NHEAD+h)*SEQ; const int nfull=q0/KVBLK; const float cq=ck[q0]; const float ce=(lane<nfull)?ck[KVBLK*lane+KVBLK-1]:0.f;
    const bool sk=(lane<nfull)&&((cq-ce)<-Tthr); const unsigned long long bal=__ballot(sk); j0=__builtin_amdgcn_readfirstlane((int)__builtin_ctzll(~bal))&~1; }
  Kh+=(long)j0*KVBLK*DM; Vh+=(long)j0*KVBLK*DM; KXh+=(long)j0*KVBLK*8;
  const unsigned lds0=(unsigned)(uintptr_t)shm;
  float*wsf=(float*)(shm+LDS_WS)+wid*64;
  const unsigned koff=(unsigned)(lane*DM+wid*8)*2u;
  const unsigned voff=(unsigned)((16*(wid&3)+(lane>>2))*DM+(wid>>2)*32+(lane&3)*8)*2u;
  const unsigned kdst=lds0+LDS_K+wid*1024, vdst=lds0+LDS_V+wid*1024, kxdst=lds0+LDS_KX+wid*128;
  const unsigned kxoff=(unsigned)(8*wid+(lane&7))*16u;
  #define DMA_K(t,slot) glds16(Kh+(long)(t)*KVBLK*DM,koff,(unsigned)__builtin_amdgcn_readfirstlane(kdst+(slot)))
  #define DMA_V(t,slot) glds16(Vh+(long)(t)*KVBLK*DM,voff,(unsigned)__builtin_amdgcn_readfirstlane(vdst+(slot)))
  #define DMA_KX(t) do{ const unsigned d_=(unsigned)__builtin_amdgcn_readfirstlane(kxdst+(((t)&3)<<10)); if(lane<8) glds16(KXh+(long)(t)*KVBLK*8,kxoff,d_); }while(0)
  const int vb0=(int)(lds0+LDS_V)+((lane>>4)&1)*32+(lane&3)*8+(4*hi+((lane&15)>>2))*64;
  const char*Kbase=shm+LDS_K; const char*KXbase=shm+LDS_KX; bf16x8 kf[8];
  const lds_cptr shm3=(lds_cptr)shm; const lds_cptr kp0=shm3+LDS_K+hi*1024+r32*16; const lds_cptr vp0=shm3+LDS_V+((lane>>4)&1)*32+(lane&3)*8+(4*hi+((lane&15)>>2))*64; const lds_cptr kxp0=shm3+LDS_KX+r32*16;
  const int NT=(q0+QB)/KVBLK-j0;
  DMA_K(0,0);DMA_KX(0);DMA_V(0,0);DMA_K(1,SLOTB);DMA_KX(1);
  bf16x8 qr[5];
  { const short one_=hi?(short)0:(short)0x3F80; qr[4]=(bf16x8){one_,one_,one_,0,0,0,0,0}; }
  #pragma unroll
  for(int d0=0;d0<4;++d0)qr[d0]=*reinterpret_cast<const bf16x8*>(&Qw[(long)r32*DM+d0*16+hi*8]);
  float mhat=0.f,l_reg=0.f;f32x16 o[2];o[0]=f32x16{};o[1]=f32x16{};f32x16 negm=f32x16{};asm volatile("":"+v"(negm));
  const int qrel=wid*QBLK+r32;
  #define CMASK(P0,P1,t) do{int jb_=(t)-(NT-4); if(jb_>=0)cmask(P0,P1,jb_,qrel,hi);}while(0)
  bool resc=false;
  #define START(P0,P1) do{ const float rm=rowmax(P0,P1); resc=false; \
    { const float dl=rm; mhat=fadd_s(mhat,dl); \
      _Pragma("unroll") for(int r=0;r<16;++r){P0[r]=fsub_s(P0[r],dl);P1[r]=fsub_s(P1[r],dl);} \
      _Pragma("unroll") for(int r=0;r<16;++r)negm[r]=-mhat; asm volatile("":"+v"(negm)); } \
    _Pragma("unroll") for(int r=0;r<16;++r)P0[r]=__builtin_amdgcn_exp2f(P0[r]); }while(0)
  #define RESC() do{ if(resc){ asm volatile("s_waitcnt lgkmcnt(0)":::"memory"); \
      _Pragma("unroll") for(int d_=0;d_<2;++d_) _Pragma("unroll") for(int r=0;r<16;++r)o[d_][r]*=wsf[crow(r,hi)]; } }while(0)
  f32x16 pA0,pA1,pB0,pB1;
  int sl_prev=0,sl_cur=0,sl_next=SLOTB;
  #define ROT() do{sl_prev=sl_cur;sl_cur=sl_next;sl_next=(sl_next==(NSLOT-1)*SLOTB)?0:sl_next+SLOTB;}while(0)
  DMA_K(2,2*SLOTB);DMA_KX(2);
  WAIT_BAR(5);
  qkt(pA0,pA1,Kbase,KXbase,qr,negm,r32,hi);asm volatile("s_nop 15\n\ts_nop 7":"+v"(pA0),"+v"(pA1));CMASK(pA0,pA1,0);
  START(pA0,pA1);
  _Pragma("unroll") for(int r=0;r<16;++r)pA1[r]=__builtin_amdgcn_exp2f(pA1[r]);
  WAIT_BAR(0);
  DMA_K(3,0);DMA_KX(3);DMA_V(1,SLOTB);
  ROT();
  kload8(kf,kp0+sl_cur);
  WAIT_BAR(3);
  s16x4 vlo[8],vhi[8]; u32x4 pw0,pw1,pw2,pw3;
  #define PKW(P,B) cvtpk_s(P[B],P[B+1])
  #define PAF(k) __builtin_bit_cast(bf16x8,pw##k)
  #define VFR(i) (bf16x8){vlo[i][0],vlo[i][1],vlo[i][2],vlo[i][3],vhi[i][0],vhi[i][1],vhi[i][2],vhi[i][3]}
  #define PIN(x) asm volatile("":"+v"(x))
  #define MX3(a,b,c) __builtin_fmaxf(__builtin_fmaxf((a),(b)),(c))
  #define GAPA(MF,A0,A1,A2,A3,W0,W1,PW) do{ MF; sacc+=A0; sacc+=A1; sacc+=A2; sacc+=A3; PIN(sacc); W0; W1; PIN(PW); SBAR(); }while(0)
  #define EX(v) __builtin_amdgcn_exp2f(v)
  #define GAPB(MF,X,B) do{ MF; X[B]=EX(X[B]); X[B+1]=EX(X[B+1]); X[B+2]=EX(X[B+2]); X[B+3]=EX(X[B+3]); PIN(X); SBAR(); }while(0)
  #define VRD(i) do{ vlo[i]=vtr(vp_+(((i)>>2)*4096+((i)&3)*1024)); vhi[i]=vtr(vp_+(((i)>>2)*4096+((i)&3)*1024+512)); }while(0)
  #define KRD(G,j) do{ if(G){ kload2(kf,kp0+sl_next,j); SBAR(); } }while(0)
  #define STEP(C0,C1,P0,P1,t,GK,GV,GL) do{ SBAR(); \
    const lds_cptr vp_=vp0+sl_prev; \
    VRD(0); SBAR(); float sacc=(P0[0]+P0[1]); \
    GAPA(C0=__builtin_amdgcn_mfma_f32_32x32x16_bf16(kf[0],qr[0],negm,0,0,0), P0[2],P0[3],P0[4],P0[5],     pw0[0]=PKW(P0,0), pw0[1]=PKW(P0,2), pw0); \
    VRD(4); SBAR(); GAPA(C1=__builtin_amdgcn_mfma_f32_32x32x16_bf16(kf[1],qr[0],negm,0,0,0), P0[6],P0[7],P0[8],P0[9],     pw0[2]=PKW(P0,4), pw0[3]=PKW(P0,6), pw0); \
    VRD(1); SBAR(); GAPA(C0=__builtin_amdgcn_mfma_f32_32x32x16_bf16(kf[2],qr[1],C0,0,0,0),   P0[10],P0[11],P0[12],P0[13], pw1[0]=PKW(P0,8), pw1[1]=PKW(P0,10), pw1); \
    VRD(5); SBAR(); GAPA(C1=__builtin_amdgcn_mfma_f32_32x32x16_bf16(kf[3],qr[1],C1,0,0,0),   P0[14],P0[15],P1[0],P1[1],   pw1[2]=PKW(P0,12),pw1[3]=PKW(P0,14), pw1); \
    VRD(2); SBAR(); GAPA(C0=__builtin_amdgcn_mfma_f32_32x32x16_bf16(kf[4],qr[2],C0,0,0,0),   P1[2],P1[3],P1[4],P1[5],     pw2[0]=PKW(P1,0), pw2[1]=PKW(P1,2), pw2); \
    VRD(6); SBAR(); GAPA(C1=__builtin_amdgcn_mfma_f32_32x32x16_bf16(kf[5],qr[2],C1,0,0,0),   P1[6],P1[7],P1[8],P1[9],     pw2[2]=PKW(P1,4), pw2[3]=PKW(P1,6), pw2); \
    VRD(3); SBAR(); GAPA(C0=__builtin_amdgcn_mfma_f32_32x32x16_bf16(kf[6],qr[3],C0,0,0,0),   P1[10],P1[11],P1[12],P1[13], pw3[0]=PKW(P1,8), pw3[1]=PKW(P1,10), pw3); \
    VRD(7); SBAR(); GAPA(C1=__builtin_amdgcn_mfma_f32_32x32x16_bf16(kf[7],qr[3],C1,0,0,0),   P1[14],P1[15],0.f,0.f,       pw3[2]=PKW(P1,12),pw3[3]=PKW(P1,14), pw3); \
    { const lds_cptr xp_=kxp0+(((t)&3)<<10); const bf16x8 e0_=*(const __attribute__((address_space(3))) bf16x8*)(xp_), e1_=*(const __attribute__((address_space(3))) bf16x8*)(xp_+512); \
      C0=__builtin_amdgcn_mfma_f32_32x32x16_bf16(e0_,qr[4],C0,0,0,0); C1=__builtin_amdgcn_mfma_f32_32x32x16_bf16(e1_,qr[4],C1,0,0,0); SBAR(); } \
    l_reg+=sacc; \
    if(GK){DMA_K((t)+3,sl_cur);DMA_KX((t)+3);} if(GV){DMA_V((t)+1,sl_next);} \
    CMASK(C0,C1,t); \
    { float a=MX3(C0[0],C0[1],C1[0]),b=MX3(C0[2],C0[3],C1[1]); a=MX3(a,C1[2],C1[3]); \
      _Pragma("unroll") for(int r=4;r<16;r+=4){a=MX3(a,C0[r],C0[r+1]);b=MX3(b,C0[r+2],C0[r+3]);a=MX3(a,C1[r],C1[r+1]);b=MX3(b,C1[r+2],C1[r+3]);} \
      float rm=__builtin_fmaxf(a,b); { auto rr=__builtin_amdgcn_permlane32_swap(__float_as_uint(rm),__float_as_uint(rm),false,false); rm=__builtin_fmaxf(__uint_as_float(rr[0]),__uint_as_float(rr[1])); } \
      resc=false; \
      if(__builtin_expect(__any(rm>(float)THRL),0)){ const float dl=__builtin_fmaxf(rm,0.f); mhat+=dl; \
        _Pragma("unroll") for(int r=0;r<16;++r){C0[r]-=dl;C1[r]-=dl;} \
        _Pragma("unroll") for(int r=0;r<16;++r)negm[r]=-mhat; asm volatile("":"+v"(negm)); \
        const float f=__builtin_amdgcn_exp2f(-dl); l_reg*=f; if(hi==0)wsf[r32]=f; resc=true; } } \
    SBAR(); \
    GAPB(o[0]=__builtin_amdgcn_mfma_f32_32x32x16_bf16(PAF(0),VFR(0),o[0],0,0,0), C0,0); \
    GAPB(o[1]=__builtin_amdgcn_mfma_f32_32x32x16_bf16(PAF(0),VFR(4),o[1],0,0,0), C0,4); \
    KRD(GL,0); GAPB(o[0]=__builtin_amdgcn_mfma_f32_32x32x16_bf16(PAF(1),VFR(1),o[0],0,0,0), C0,8); \
    KRD(GL,1); GAPB(o[1]=__builtin_amdgcn_mfma_f32_32x32x16_bf16(PAF(1),VFR(5),o[1],0,0,0), C0,12); \
    KRD(GL,2); GAPB(o[0]=__builtin_amdgcn_mfma_f32_32x32x16_bf16(PAF(2),VFR(2),o[0],0,0,0), C1,0); \
    KRD(GL,3); GAPB(o[1]=__builtin_amdgcn_mfma_f32_32x32x16_bf16(PAF(2),VFR(6),o[1],0,0,0), C1,4); \
    GAPB(o[0]=__builtin_amdgcn_mfma_f32_32x32x16_bf16(PAF(3),VFR(3),o[0],0,0,0), C1,8); \
    GAPB(o[1]=__builtin_amdgcn_mfma_f32_32x32x16_bf16(PAF(3),VFR(7),o[1],0,0,0), C1,12); \
    }while(0)
  int t=1;
  #undef CMASK
  #define CMASK(P0,P1,t) do{}while(0)
  for(;t+5<NT;t+=2){
    STEP(pB0,pB1,pA0,pA1,t,true,true,true);     WAIT_BAR(3); RESC(); ROT();
    STEP(pA0,pA1,pB0,pB1,t+1,true,true,true);   WAIT_BAR(3); RESC(); ROT();
  }
  #undef CMASK
  #define CMASK(P0,P1,t) do{int jb_=(t)-(NT-4); if(jb_>=0)cmask(P0,P1,jb_,qrel,hi);}while(0)
  #define ENDW(tt) do{ if((tt)+3<NT){WAIT_BAR(3);} else if((tt)+2<NT){WAIT_BAR(1);} else {WAIT_BAR(0);} }while(0)
  for(;t+1<NT;t+=2){
    STEP(pB0,pB1,pA0,pA1,t,(t+3<NT),(t+1<NT),(t+1<NT));       ENDW(t);   RESC(); ROT();
    STEP(pA0,pA1,pB0,pB1,t+1,(t+4<NT),(t+2<NT),(t+2<NT));     ENDW(t+1); RESC(); ROT();
  }
  STEP(pB0,pB1,pA0,pA1,NT-1,false,false,false); RESC();
  { float sacc=pB0[0]+pB0[1]; _Pragma("unroll") for(int r=2;r<16;++r)sacc+=pB0[r]; _Pragma("unroll") for(int r=0;r<16;++r)sacc+=pB1[r]; l_reg+=sacc;
    pw0=(u32x4){PKW(pB0,0),PKW(pB0,2),PKW(pB0,4),PKW(pB0,6)};pw1=(u32x4){PKW(pB0,8),PKW(pB0,10),PKW(pB0,12),PKW(pB0,14)};pw2=(u32x4){PKW(pB1,0),PKW(pB1,2),PKW(pB1,4),PKW(pB1,6)};pw3=(u32x4){PKW(pB1,8),PKW(pB1,10),PKW(pB1,12),PKW(pB1,14)};
    SBAR(); pv(o,vb0+sl_cur,PAF(0),PAF(1),PAF(2),PAF(3)); }
  #undef PKW
  #undef PAF
  #undef VFR
  #undef PIN
  #undef MX3
  #undef GAPA
  #undef GAPB
  #undef EX
  #undef VRD
  #undef KRD
  #undef STEP
  #undef ENDW
  {auto rr=__builtin_amdgcn_permlane32_swap(__float_as_uint(l_reg),__float_as_uint(l_reg),false,false);l_reg=__uint_as_float(rr[0])+__uint_as_float(rr[1]);}
  if(hi==0)wsf[32+r32]=l_reg;asm volatile("s_waitcnt lgkmcnt(0)":::"memory");
  float rli[16];
  #pragma unroll
  for(int r=0;r<16;++r)rli[r]=__builtin_amdgcn_rcpf(wsf[32+crow(r,hi)]);
  bf16*Ow=O+(rowbase+q0+wid*QBLK)*DM+h*D; const bf16*Zw=Z+(rowbase+q0+wid*QBLK)*DM+h*D;
  { bf16*stg=(bf16*)(shm+LDS_OST)+wid*2048;
    #pragma unroll
    for(int r=0;r<16;++r){const int orow=crow(r,hi);
      #pragma unroll
      for(int d0=0;d0<2;++d0)stg[orow*64+d0*32+r32]=__float2bfloat16(o[d0][r]*rli[r]);}
    asm volatile("s_waitcnt lgkmcnt(0)":::"memory");
    #pragma unroll
    for(int i=0;i<4;++i){const int row=i*8+(lane>>3),ch=lane&7; const u32x4 v=*(const u32x4*)(stg+row*64+ch*8); const u32x4 zz=*(const u32x4*)(Zw+(long)row*DM+ch*8); u32x4 g_;
      #pragma unroll
      for(int e_=0;e_<4;++e_){ const float a0=__builtin_bit_cast(float,v[e_]<<16)*__builtin_bit_cast(float,zz[e_]<<16), a1=__builtin_bit_cast(float,v[e_]&0xffff0000u)*__builtin_bit_cast(float,zz[e_]&0xffff0000u); g_[e_]=cvtpk_s(a0,a1); }
      ATTN_STORE16(Ow+(long)row*DM+ch*8,g_);} }
  asm volatile("s_waitcnt lgkmcnt(0)\n\ts_barrier":::"memory");
  #undef DMA_K
  #undef DMA_V
  #undef DMA_KX
  #undef CMASK
  #undef START
  #undef RESC
  #undef ROT
}
constexpr int ATTN_LDS_BYTES=LDS_BYTES;
struct AttnTensors { const bf16* Q; const bf16* K; const bf16* V; const bf16* KX; const bf16* Z; const float* CKL; bf16* O; };
struct AttnUnit { int bh; int qb; };
struct StaticOrder {
  int vcu;
  __device__ __forceinline__ explicit StaticOrder(int grid,int block):vcu((grid%8==0)?(block%8)*(grid/8)+block/8:block){}
  __device__ __forceinline__ bool next(int i,AttnUnit&u)const{ const int L=vcu*8+i; if(i>=8||L>=BATCH*NHEAD*NQB)return false; const int s=vcu&1,p=i>>1; u.bh=vcu>>1; u.qb=(i&1)?(15-2*p-s):(2*p+s); return true; }
  __device__ __forceinline__ void a_ready(const AttnUnit&)const{}
  __device__ __forceinline__ void done(const AttnUnit&)const{}
};
template<int THRL=8> __device__ __forceinline__ void attn_phase(char*lds,volatile __attribute__((address_space(3))) unsigned*bc,unsigned*counter,unsigned char*wsb,float Tthr){
  for(;;){
    if(threadIdx.x==0) bc[0]=__hip_atomic_fetch_add(counter,1u,__ATOMIC_RELAXED,__HIP_MEMORY_SCOPE_AGENT);
    __syncthreads();
    const int U=__builtin_amdgcn_readfirstlane((int)bc[0]);
    __syncthreads();
    if(U>=BATCH*NHEAD*NQB)break;
    const int qb=NQB-1-(U>>7), bh=U&127;
    attn_unit<THRL>(bh/NHEAD,bh%NHEAD,qb,wsb,Tthr,lds);
  }
}
#undef SBAR
#undef WAIT_BAR
}
#define GAS __attribute__((address_space(1)))
#define LAS __attribute__((address_space(3)))
typedef unsigned short bf16;
typedef unsigned v4u __attribute__((ext_vector_type(4)));
typedef float f32x4 __attribute__((ext_vector_type(4)));
typedef short bf16x8 __attribute__((ext_vector_type(8)));
typedef GAS unsigned gu32;
typedef GAS unsigned long long gu64;
#define RLX_AGENT __ATOMIC_RELAXED, __HIP_MEMORY_SCOPE_AGENT
#define LDS_WAIT() asm volatile("s_waitcnt lgkmcnt(0)" ::: "memory")
#define VM_WAIT() asm volatile("s_waitcnt vmcnt(0)" ::: "memory")
__device__ __forceinline__ unsigned long long rt() { return __builtin_amdgcn_s_memrealtime(); }
__device__ __forceinline__ unsigned f2bf(float f) { unsigned u = __builtin_bit_cast(unsigned, f); return (u + 0x7fffu + ((u >> 16) & 1u)) >> 16; }
__device__ __forceinline__ unsigned pk2(float lo, float hi) { return f2bf(lo) | (f2bf(hi) << 16); }
#define XB_TMO      128
#define XB_XCNT(j)  (256  + 64 * (j))
#define XB_XSUB(j)  (1280 + 64 * (j))
#define XB_XGEN(j)  (2304 + 64 * (j))
#define XB_TOP      3328
#define XB_TOPGEN   3392
#define XCD_BAR_WORDS 3456
#define XB_SPIN_CAP (1u << 18)

__device__ __forceinline__ unsigned xb_ld(unsigned* p)              { return __hip_atomic_load(p, __ATOMIC_RELAXED, __HIP_MEMORY_SCOPE_AGENT); }
__device__ __forceinline__ unsigned xb_add(unsigned* p, unsigned v) { return __hip_atomic_fetch_add(p, v, __ATOMIC_RELAXED, __HIP_MEMORY_SCOPE_AGENT); }
__device__ __forceinline__ unsigned xb_xcc_id() { return (unsigned)__builtin_amdgcn_s_getreg((3 << 11) | 20) & 0xFu; }
#define XB_SPIN(cond, bar) do { unsigned _sp = 0; while (cond) { __builtin_amdgcn_s_sleep(1); \
    if ((++_sp & 255u) == 0u) { if (xb_ld(&(bar)[XB_TMO])) break; if (_sp > XB_SPIN_CAP) { atomicAdd(&(bar)[XB_TMO], 1u); break; } } } } while (0)

struct XcdBarrier {
    unsigned* bar; unsigned x;
    volatile LAS unsigned* st;
};

__device__ __forceinline__ XcdBarrier xcd_barrier_post(unsigned* bar, volatile LAS unsigned* st) {
    XcdBarrier b; b.bar = bar; b.x = xb_xcc_id(); b.st = st;
    if (threadIdx.x == 0) (void)xb_add(&bar[XB_XCNT(b.x)], 1u);
    return b;
}
__device__ __forceinline__ void xcd_barrier_complete(unsigned* bar, unsigned x, unsigned& nloc, unsigned& nx) {
    const unsigned G = gridDim.x * gridDim.y * gridDim.z;
    unsigned sum, cnt, mine, sp = 0u;
    for (;;) {
        sum = 0u; cnt = 0u; mine = 0u;
#pragma unroll
        for (unsigned j = 0; j < 16; ++j) { const unsigned c = xb_ld(&bar[XB_XCNT(j)]); sum += c; cnt += (c > 0u) ? 1u : 0u; mine = (j == x) ? c : mine; }
        if (sum == G) break;
        __builtin_amdgcn_s_sleep(1);
        if ((++sp & 255u) == 0u) { if (xb_ld(&bar[XB_TMO])) break; if (sp > XB_SPIN_CAP) { atomicAdd(&bar[XB_TMO], 1u); break; } }
    }
    nloc = mine > 0u ? mine : 1u; nx = cnt > 0u ? cnt : 1u;
}

__device__ __forceinline__ void xcd_barrier(const XcdBarrier& b) {
    asm volatile("s_waitcnt vmcnt(0)" ::: "memory");
    __syncthreads();
    if (threadIdx.x == 0) {
        unsigned* bar = b.bar;
        __builtin_amdgcn_s_waitcnt(0);
        unsigned nloc = b.st[0], nx = b.st[1];
        if (nloc == 0u) { xcd_barrier_complete(bar, b.x, nloc, nx); b.st[0] = nloc; b.st[1] = nx; }
        const unsigned old = xb_add(&bar[XB_XSUB(b.x)], 1u);
        const unsigned gen = old / nloc;
        if (old + 1u == (gen + 1u) * nloc) {
            __builtin_amdgcn_fence(__ATOMIC_RELEASE, "agent");
            asm volatile("s_waitcnt vmcnt(0)" ::: "memory");
            const unsigned og = xb_add(&bar[XB_TOP], 1u);
            const unsigned tg = og / nx;
            if (og + 1u == (tg + 1u) * nx) xb_add(&bar[XB_TOPGEN], 1u);
            else XB_SPIN(xb_ld(&bar[XB_TOPGEN]) == tg, bar);
            __builtin_amdgcn_fence(__ATOMIC_ACQUIRE, "agent");
            xb_add(&bar[XB_XGEN(b.x)], 1u);
            asm volatile("s_waitcnt vmcnt(0)" ::: "memory");
        } else {
            XB_SPIN(xb_ld(&bar[XB_XGEN(b.x)]) == gen, bar);
            __builtin_amdgcn_fence(__ATOMIC_ACQUIRE, "agent");
            asm volatile("s_waitcnt vmcnt(0)" ::: "memory");
        }
    }
    __syncthreads();
}
__device__ __forceinline__ float wave_sum(float v) {
#pragma unroll
    for (int o = 1; o < 64; o <<= 1) v += __shfl_xor(v, o);
    return v;
}
__device__ __forceinline__ void p0_transpose_item(const float* W, int K, int N, bf16* WT, int row_off, LAS float* scr, int item, int lane) {
    const int nblk = N / 32, kb = item / nblk, nb = item % nblk, k0 = 64 * kb, n0 = 32 * nb;
#pragma unroll 8
    for (int i = 0; i < 32; ++i) { const int kk = 2 * i + (lane >> 5); scr[kk * 33 + (lane & 31)] = W[(size_t)(k0 + kk) * N + n0 + (lane & 31)]; }
    LDS_WAIT(); asm volatile("" ::: "memory");
    const int c = lane & 7;
#pragma unroll
    for (int j = 0; j < 4; ++j) { const int n = (lane >> 3) + 8 * j; const LAS float* s = scr + (8 * c) * 33 + n;
        v4u o; o.x = pk2(s[0 * 33], s[1 * 33]); o.y = pk2(s[2 * 33], s[3 * 33]); o.z = pk2(s[4 * 33], s[5 * 33]); o.w = pk2(s[6 * 33], s[7 * 33]);
        *(GAS v4u*)(WT + (size_t)(row_off + n0 + n) * K + k0 + 8 * c) = o; }
    LDS_WAIT(); asm volatile("" ::: "memory");
}
struct Frame {
    LAS unsigned char* lds; volatile LAS unsigned* MISC; gu32* ctl;
    int tid, lane, wave, G;
    unsigned char* ws;
};
#define relaunder(F) do { int t_ = threadIdx.x; asm volatile("" : "+v"(t_)); (F).tid = t_; (F).lane = t_ & 63; (F).wave = __builtin_amdgcn_readfirstlane(t_ >> 6); } while (0)
typedef _Float16 half_t;
__device__ __forceinline__ float bf2f(unsigned short h) { return __builtin_bit_cast(float, (unsigned)h << 16); }
__device__ __forceinline__ float bflo(unsigned w) { return __builtin_bit_cast(float, w << 16); }
__device__ __forceinline__ float bfhi(unsigned w) { return __builtin_bit_cast(float, w & 0xffff0000u); }

__device__ __forceinline__ void p0_transpose_item2(const float* W, int K, int N, bf16* WT, LAS float* scr, int kb, int n0, int nvalid, int lane) {
    const int k0 = 64 * kb;
#pragma unroll 8
    for (int i = 0; i < 32; ++i) { const int kk = 2 * i + (lane >> 5); const int nn = lane & 31; scr[kk * 33 + nn] = (nn < nvalid) ? W[(size_t)(k0 + kk) * N + n0 + nn] : 0.f; }
    LDS_WAIT(); asm volatile("" ::: "memory");
    const int c = lane & 7;
#pragma unroll
    for (int j = 0; j < 4; ++j) { const int n = (lane >> 3) + 8 * j; const LAS float* s = scr + (8 * c) * 33 + n;
        v4u o; o.x = pk2(s[0 * 33], s[1 * 33]); o.y = pk2(s[2 * 33], s[3 * 33]); o.z = pk2(s[4 * 33], s[5 * 33]); o.w = pk2(s[6 * 33], s[7 * 33]);
        if (n < nvalid) *(GAS v4u*)(WT + (size_t)(n0 + n) * K + k0 + 8 * c) = o; }
    LDS_WAIT(); asm volatile("" ::: "memory");
}

__device__ __forceinline__ void gemv8_block(Frame& F, const float* Wm, int N, int j0, int ncols, const LAS float* atab, LAS float* part) {
    float a8[8];
#pragma unroll
    for (int b = 0; b < 8; ++b) a8[b] = 0.f;
    const int j = j0 + F.lane; const bool ok = F.lane < ncols;
    const int kbeg = F.wave * 128;
#pragma unroll 4
    for (int kk = 0; kk < 128; ++kk) { const int k = kbeg + kk; const float w = ok ? Wm[(size_t)k * N + j] : 0.f;
        const f32x4 t0 = *(const LAS f32x4*)(atab + k * 8), t1 = *(const LAS f32x4*)(atab + k * 8 + 4);
        a8[0] += t0[0] * w; a8[1] += t0[1] * w; a8[2] += t0[2] * w; a8[3] += t0[3] * w; a8[4] += t1[0] * w; a8[5] += t1[1] * w; a8[6] += t1[2] * w; a8[7] += t1[3] * w; }
#pragma unroll
    for (int b = 0; b < 8; ++b) part[(F.wave * 8 + b) * 64 + F.lane] = a8[b];
}

__device__ __forceinline__ void p0a(Frame& F, const float* const* in) {
    relaunder(F);
    const float* c = in[1]; const float* norm_g = in[2]; const float* ada_w = in[3]; const float* ada_b = in[4]; const float* lbl = in[5];
    const float* hg_w_in = in[6]; const float* hg_w_out = in[8]; const float* fx_w_in = in[9]; const float* fx_w_out = in[13];
    unsigned char* ws = F.ws;
    {
        LAS float* atab = (LAS float*)(F.lds);
        LAS float* part = (LAS float*)(F.lds + 32768);
        for (int e = F.tid; e < 8192; e += 512) { const int b = e >> 10, k = e & 1023; const float v = c[b * 1024 + k]; atab[k * 8 + b] = v / (1.0f + __expf(-v)); }
        __syncthreads();
        for (int it = blockIdx.x; it < 4 * 48; it += F.G) {
            const int l = it / 48, jb = it % 48, j0 = jb * 64;
            gemv8_block(F, ada_w + (size_t)l * 1024 * 3072, 3072, j0, 64, atab, part);
            __syncthreads();
            { const int b = F.tid >> 6, jl = F.tid & 63, j = j0 + jl; float s = ada_b[l * 3072 + j];
#pragma unroll
              for (int w = 0; w < 8; ++w) s += part[(w * 8 + b) * 64 + jl];
              const int sec = j >> 10, cc = j & 1023; const size_t o = ((size_t)l * 8 + b) * 1024 + cc;
              if (sec == 0) ((float*)(ws + WS_SH))[o] = s; else if (sec == 1) ((float*)(ws + WS_GS))[o] = norm_g[l * 1024 + cc] * (1.0f + s); else ((float*)(ws + WS_GATE))[o] = s; }
            __syncthreads();
        }
    }
    if (blockIdx.x == 0) { float* par = (float*)(ws + WS_PAR); for (int e = F.tid; e < 128; e += 512) { par[e] = in[11][e]; par[128 + e] = in[12][e]; } if (F.tid < 32) par[256 + F.tid] = in[10][F.tid]; for (int e = F.tid; e < 2048; e += 512) par[288 + e] = in[7][e]; }
    if (blockIdx.x == F.G - 1) { for (int e = F.tid; e < 1024; e += 512) { const float d = lbl[1024 + e] - lbl[e]; ((float*)(ws + WS_LB))[e] = 0.f; ((float*)(ws + WS_LB))[1024 + e] = 1.0f / (1.0f + __expf(-d)); } }
    {
        __syncthreads();
        LAS float* scr = (LAS float*)(F.lds + F.wave * 16384);
        const int gw = blockIdx.x * NWAVES + F.wave, NGW = F.G * NWAVES;
        constexpr int I_HG = 16 * 128, I_FX = 16 * 129, I_O = 16 * 32;
        constexpr int NIT = 2 * I_HG + 2 * I_FX + 4 * I_O;
        for (int it = gw; it < NIT; it += NGW) {
            int r = it;
            if (r < 2 * I_HG) { const int j = r / I_HG; r %= I_HG; p0_transpose_item2(hg_w_in + (size_t)j * 1024 * HG_IN, 1024, HG_IN, (bf16*)(ws + WS_WIN + (size_t)(2 * j) * WIN_STRIDE), scr, r / 128, (r % 128) * 32, 32, F.lane); continue; }
            r -= 2 * I_HG;
            if (r < 2 * I_FX) { const int j = r / I_FX; r %= I_FX; const int nb = r % 129; p0_transpose_item2(fx_w_in + (size_t)j * 1024 * FX_IN, 1024, FX_IN, (bf16*)(ws + WS_WIN + (size_t)(2 * j + 1) * WIN_STRIDE), scr, r / 129, nb * 32, nb == 128 ? 16 : 32, F.lane); continue; }
            r -= 2 * I_FX;
            { const int l = r / I_O; r %= I_O; const float* src = (l & 1) ? fx_w_out + (size_t)(l >> 1) * 1024 * 1024 : hg_w_out + (size_t)(l >> 1) * 1024 * 1024;
              p0_transpose_item2(src, 1024, 1024, (bf16*)(ws + WS_WOUT + (size_t)l * WOUT_STRIDE), scr, r / 32, (r % 32) * 32, 32, F.lane); }
        }
        for (int e = blockIdx.x * 512 + F.tid; e < 2 * 240 * 128; e += F.G * 512) { const int j = e / (240 * 128), q = e % (240 * 128);
            *(GAS v4u*)((bf16*)(ws + WS_WIN + (size_t)(2 * j + 1) * WIN_STRIDE) + (size_t)FX_IN * 1024 + (size_t)q * 8) = (v4u){0u, 0u, 0u, 0u}; }
    }
}

__device__ __forceinline__ void p0b(Frame& F, const float* const* in) {
    relaunder(F);
    const float* x = in[0]; const float* hg_w_in = in[6]; const float* fx_w_in = in[9];
    unsigned char* ws = F.ws;
    {
        LAS float* atab = (LAS float*)(F.lds);
        LAS float* part = (LAS float*)(F.lds + 32768);
        constexpr int NB_HG = 64, NB_FX = 68;
        for (int it = blockIdx.x; it < 2 * NB_HG + 2 * NB_FX; it += F.G) {
            int l, jb; if (it < 2 * NB_HG) { l = 2 * (it / NB_HG); jb = it % NB_HG; } else { const int r = it - 2 * NB_HG; l = 2 * (r / NB_FX) + 1; jb = r % NB_FX; }
            const bool fx = l & 1; const int N = fx ? FX_IN : HG_IN; const int j0 = jb * 64; const int ncols = (j0 + 64 <= N) ? 64 : (j0 < N ? N - j0 : 0);
            const float* Wm = fx ? fx_w_in + (size_t)(l >> 1) * 1024 * FX_IN : hg_w_in + (size_t)(l >> 1) * 1024 * HG_IN;
            const float* sh = (const float*)(ws + WS_SH) + (size_t)l * 8 * 1024;
            __syncthreads();
            for (int e = F.tid; e < 8192; e += 512) { const int b = e >> 10, k = e & 1023; atab[k * 8 + b] = sh[b * 1024 + k]; }
            __syncthreads();
            gemv8_block(F, Wm, N, j0, ncols, atab, part);
            __syncthreads();
            { const int b = F.tid >> 6, jl = F.tid & 63; float s = 0.f;
#pragma unroll
              for (int w = 0; w < 8; ++w) s += part[(w * 8 + b) * 64 + jl];
              ((float*)(ws + WS_BIAS))[((size_t)l * 8 + b) * BIAS_LD + j0 + jl] = (jl < ncols) ? s : 0.f; }
        }
    }
    {
        const int gw = blockIdx.x * NWAVES + F.wave, NGW = F.G * NWAVES;
        const float* gs = (const float*)(ws + WS_GS);
        float* rowss = (float*)(ws + WS_ROWSS);
        bf16* xs = (bf16*)(ws + WS_XS);
        for (int m = gw; m < M; m += NGW) {
            const int b = m >> 12; const GAS f32x4* xr = (const GAS f32x4*)(x + (size_t)m * 1024) + F.lane; const f32x4* gr = (const f32x4*)(gs + b * 1024) + F.lane;
            GAS unsigned long long* o8 = (GAS unsigned long long*)(xs + (size_t)m * 1024) + F.lane; float s = 0.f;
#pragma unroll
            for (int j = 0; j < 4; ++j) { const f32x4 v = xr[64 * j], g = gr[64 * j]; s += (v.x * v.x + v.y * v.y) + (v.z * v.z + v.w * v.w);
                o8[64 * j] = (unsigned long long)pk2(v.x * g.x, v.y * g.y) | ((unsigned long long)pk2(v.z * g.z, v.w * g.w) << 32); }
            s = wave_sum(s); if (F.lane == 0) rowss[m] = s;
        }
    }
}

__device__ __forceinline__ void fox_fl_units(Frame& F, int l) {
    relaunder(F);
    unsigned char* ws = F.ws; const int lane = F.lane, w = F.wave, fr = lane & 15, q4 = lane >> 4, jj = l >> 1;
    const GAS bf16* xs = (const GAS bf16*)(ws + WS_XS); const GAS bf16* wt = (const GAS bf16*)(ws + WS_WIN + (size_t)l * WIN_STRIDE) + (size_t)(4096 + fr) * 1024 + 8 * q4;
    const GAS float* rowss = (const GAS float*)(ws + WS_ROWSS) + (size_t)l * M; const GAS float* bias = (const GAS float*)(ws + WS_BIAS) + (size_t)l * 8 * BIAS_LD + 4096;
    const GAS float* bfg = (const GAS float*)(ws + WS_PAR) + 256 + jj * 16; GAS float* lf = (GAS float*)(ws + WS_LF);
    typedef short bf16x8_t __attribute__((ext_vector_type(8)));
    for (int u = blockIdx.x; u < M / 256; u += F.G) {
        const int row0 = u * 256 + 32 * w, b = u >> 4;
        const GAS bf16* a0 = xs + (size_t)(row0 + fr) * 1024 + 8 * q4; const GAS bf16* a1 = a0 + 16 * 1024;
        f32x4 c0 = (f32x4){0.f, 0.f, 0.f, 0.f}, c1 = c0;
#pragma unroll 8
        for (int ks = 0; ks < 32; ++ks) { const bf16x8_t bb = *(const GAS bf16x8_t*)(wt + 32 * ks), x0 = *(const GAS bf16x8_t*)(a0 + 32 * ks), x1 = *(const GAS bf16x8_t*)(a1 + 32 * ks);
            c0 = __builtin_amdgcn_mfma_f32_16x16x32_bf16(x0, bb, c0, 0, 0, 0); c1 = __builtin_amdgcn_mfma_f32_16x16x32_bf16(x1, bb, c1, 0, 0, 0); }
        const float bsum = bias[b * BIAS_LD + fr] + bfg[fr];
#pragma unroll
        for (int e = 0; e < 4; ++e) { const int r0 = row0 + 4 * q4 + e, r1 = r0 + 16;
            lf[(size_t)r0 * 16 + fr] = pg8::log_sigmoid(c0[e] * rsqrtf(rowss[r0] * (1.0f / 1024.0f) + EPS) + bsum);
            lf[(size_t)r1 * 16 + fr] = pg8::log_sigmoid(c1[e] * rsqrtf(rowss[r1] * (1.0f / 1024.0f) + EPS) + bsum); }
    }
}

__device__ __forceinline__ void fox_cumsum(Frame& F) {
    relaunder(F);
    unsigned char* ws = F.ws; const float* lf = (const float*)(ws + WS_LF); float* ckl = (float*)(ws + WS_CKL); bf16* kx = (bf16*)(ws + WS_KX);
    const int gw = blockIdx.x * NWAVES + F.wave, NGW = F.G * NWAVES;
    for (int bh = gw; bh < 128; bh += NGW) {
        const int b = bh >> 4, h = bh & 15; const float* p = lf + ((size_t)b * SEQ + F.lane * 64) * 16 + h;
        float sum = 0.f;
        for (int i = 0; i < 64; ++i) sum += p[i * 16];
        float incl = sum;
#pragma unroll
        for (int off = 1; off < 64; off <<= 1) { const float t = __shfl_up(incl, off); if (F.lane >= off) incl += t; }
        float run = incl - sum;
        for (int i = 0; i < 64; ++i) { run += p[i * 16]; const float c = run * LOG2E; const size_t s = (size_t)bh * SEQ + F.lane * 64 + i; ckl[s] = c;
            const float xv = -c; const unsigned h0 = f2bf(xv); const float r1 = xv - __builtin_bit_cast(float, h0 << 16); const unsigned h1 = f2bf(r1); const float r2 = r1 - __builtin_bit_cast(float, h1 << 16); const unsigned h2 = f2bf(r2);
            *(GAS v4u*)(kx + s * 8) = (v4u){h0 | (h1 << 16), h2, 0u, 0u}; }
    }
}

#if !FAST_ATTN
__device__ __forceinline__ void attn_naive(Frame& F) {
    relaunder(F);
    unsigned char* ws = F.ws;
    const bf16* Q = (const bf16*)(ws + WS_B0); const bf16* K = (const bf16*)(ws + WS_B0 + BUF_STRIDE); const bf16* V = (const bf16*)(ws + WS_B0 + 2 * BUF_STRIDE); const bf16* Z = (const bf16*)(ws + WS_B0 + 3 * BUF_STRIDE);
    const float* CKL = (const float*)(ws + WS_CKL); bf16* AO = (bf16*)(ws + WS_AO);
    LAS float* Kf = (LAS float*)(F.lds); LAS float* Vf = Kf + 4096; LAS float* ckt = Vf + 4096;
    for (int u = blockIdx.x; u < 1024; u += F.G) {
        const int qblk = 7 - (u >> 7), bh = u & 127, b = bh >> 4, h = bh & 15;
        const int t = qblk * 512 + F.tid; const size_t row = (size_t)b * SEQ + t;
        float q[64], o[64];
#pragma unroll
        for (int c8 = 0; c8 < 8; ++c8) { const v4u w = *(const GAS v4u*)(Q + row * 1024 + h * 64 + c8 * 8);
            q[c8 * 8 + 0] = bflo(w.x); q[c8 * 8 + 1] = bfhi(w.x); q[c8 * 8 + 2] = bflo(w.y); q[c8 * 8 + 3] = bfhi(w.y); q[c8 * 8 + 4] = bflo(w.z); q[c8 * 8 + 5] = bfhi(w.z); q[c8 * 8 + 6] = bflo(w.w); q[c8 * 8 + 7] = bfhi(w.w); }
#pragma unroll
        for (int d = 0; d < 64; ++d) o[d] = 0.f;
        float mx = -INFINITY, l = 0.f;
        const int ntile = (qblk + 1) * 8;
        for (int j = 0; j < ntile; ++j) {
            __syncthreads();
            { const int key = F.tid >> 3, ch = F.tid & 7; const size_t krow = (size_t)b * SEQ + j * 64 + key;
              const v4u kw = *(const GAS v4u*)(K + krow * 1024 + h * 64 + ch * 8), vw = *(const GAS v4u*)(V + krow * 1024 + h * 64 + ch * 8);
              LAS f32x4* kd = (LAS f32x4*)(Kf + key * 64 + ch * 8); LAS f32x4* vd = (LAS f32x4*)(Vf + key * 64 + ch * 8);
              kd[0] = (f32x4){bflo(kw.x), bfhi(kw.x), bflo(kw.y), bfhi(kw.y)}; kd[1] = (f32x4){bflo(kw.z), bfhi(kw.z), bflo(kw.w), bfhi(kw.w)};
              vd[0] = (f32x4){bflo(vw.x), bfhi(vw.x), bflo(vw.y), bfhi(vw.y)}; vd[1] = (f32x4){bflo(vw.z), bfhi(vw.z), bflo(vw.w), bfhi(vw.w)};
              if (F.tid < 64) ckt[F.tid] = CKL[(size_t)bh * SEQ + j * 64 + F.tid]; }
            __syncthreads();
            int kmax = t - j * 64; if (kmax > 63) kmax = 63;
            for (int key = 0; key <= kmax; ++key) {
                float s = -ckt[key];
#pragma unroll
                for (int d4 = 0; d4 < 16; ++d4) { const f32x4 kk = *(const LAS f32x4*)(Kf + key * 64 + d4 * 4); s += q[d4 * 4] * kk[0] + q[d4 * 4 + 1] * kk[1] + q[d4 * 4 + 2] * kk[2] + q[d4 * 4 + 3] * kk[3]; }
                if (s > mx) { const float a = __builtin_amdgcn_exp2f(mx - s); l *= a;
#pragma unroll
                    for (int d = 0; d < 64; ++d) o[d] *= a;
                    mx = s; }
                const float p = __builtin_amdgcn_exp2f(s - mx); l += p;
#pragma unroll
                for (int d4 = 0; d4 < 16; ++d4) { const f32x4 vv = *(const LAS f32x4*)(Vf + key * 64 + d4 * 4); o[d4 * 4] += p * vv[0]; o[d4 * 4 + 1] += p * vv[1]; o[d4 * 4 + 2] += p * vv[2]; o[d4 * 4 + 3] += p * vv[3]; }
            }
        }
        const float inv = 1.0f / l;
#pragma unroll
        for (int c8 = 0; c8 < 8; ++c8) { const v4u zw = *(const GAS v4u*)(Z + row * 1024 + h * 64 + c8 * 8); v4u w;
            w.x = pk2(o[c8 * 8 + 0] * inv * bflo(zw.x), o[c8 * 8 + 1] * inv * bfhi(zw.x)); w.y = pk2(o[c8 * 8 + 2] * inv * bflo(zw.y), o[c8 * 8 + 3] * inv * bfhi(zw.y));
            w.z = pk2(o[c8 * 8 + 4] * inv * bflo(zw.z), o[c8 * 8 + 5] * inv * bfhi(zw.z)); w.w = pk2(o[c8 * 8 + 6] * inv * bflo(zw.w), o[c8 * 8 + 7] * inv * bfhi(zw.w));
            *(GAS v4u*)(AO + row * 1024 + h * 64 + c8 * 8) = w; }
    }
}

#endif
#if !FAST_SCAN
__device__ __forceinline__ void scan_naive(Frame& F, int jlayer) {
    relaunder(F); const float* og = (const float*)(F.ws + WS_PAR) + 288 + jlayer * 1024;
    unsigned char* ws = F.ws;
    const bf16* Qb = (const bf16*)(ws + WS_B0); const half_t* Gb = (const half_t*)(ws + WS_B0 + BUF_STRIDE); const bf16* Vb = (const bf16*)(ws + WS_B0 + 2 * BUF_STRIDE); const bf16* Zb = (const bf16*)(ws + WS_B0 + 3 * BUF_STRIDE);
    bf16* AO = (bf16*)(ws + WS_AO);
    LAS float* ff = (LAS float*)(F.lds); LAS float* kk = ff + 1024; LAS float* qq = kk + 1024; LAS float* vv = qq + 1024; LAS float* po = vv + 1024;
    for (int u = blockIdx.x; u < 64; u += F.G) {
        const int b = u >> 3, h = u & 7; const int v = F.tid & 127, kq = F.tid >> 7;
        float S[32];
#pragma unroll
        for (int i = 0; i < 32; ++i) S[i] = 0.f;
        for (int tg = 0; tg < SEQ / 8; ++tg) {
            const size_t row0 = (size_t)b * SEQ + tg * 8;
#pragma unroll
            for (int r = 0; r < 2; ++r) { const int e = F.tid + 512 * r, tok = e >> 7, c = e & 127; const size_t a = (row0 + tok) * 1024 + h * 128 + c;
                const float g = (float)Gb[a]; const float f = __expf(g); ff[e] = f; kk[e] = 1.0f - f; qq[e] = bf2f(Qb[a]); vv[e] = bf2f(Vb[a]); }
            __syncthreads();
#pragma unroll 1
            for (int tok = 0; tok < 8; ++tok) {
                const float vt = vv[tok * 128 + v]; float p = 0.f;
#pragma unroll
                for (int i4 = 0; i4 < 8; ++i4) { const int k = tok * 128 + kq * 32 + i4 * 4; const f32x4 f4 = *(const LAS f32x4*)(ff + k), k4 = *(const LAS f32x4*)(kk + k), q4 = *(const LAS f32x4*)(qq + k);
#pragma unroll
                    for (int e = 0; e < 4; ++e) { S[i4 * 4 + e] = f4[e] * S[i4 * 4 + e] + k4[e] * vt; p += q4[e] * S[i4 * 4 + e]; } }
                po[(tok * 4 + kq) * 128 + v] = p;
            }
            __syncthreads();
            { const int tok = F.tid >> 6, v2 = (F.tid & 63) * 2;
              float o0 = 0.f, o1 = 0.f;
#pragma unroll
              for (int q4 = 0; q4 < 4; ++q4) { o0 += po[(tok * 4 + q4) * 128 + v2]; o1 += po[(tok * 4 + q4) * 128 + v2 + 1]; }
              const float ss = wave_sum(o0 * o0 + o1 * o1); const float rn = rsqrtf(ss * (1.0f / 128.0f) + EPS);
              const size_t a = (row0 + tok) * 1024 + h * 128 + v2; const unsigned zw = *(const GAS unsigned*)(Zb + a);
              *(GAS unsigned*)(AO + a) = pk2(o0 * rn * og[h * 128 + v2] * bflo(zw), o1 * rn * og[h * 128 + v2 + 1] * bfhi(zw)); }
        }
        __syncthreads();
    }
}

#endif
namespace hg {
typedef short bf16x8 __attribute__((ext_vector_type(8)));
typedef short bf16x4 __attribute__((ext_vector_type(4)));
constexpr int QS = 272, KS = 80;
constexpr int OFF_Q = 0, OFF_K = 32 * QS, OFF_KD = 2 * 32 * QS, OFF_VT = OFF_KD + 128 * KS, OFF_DE = OFF_VT + 128 * KS, BUF = OFF_DE + 512;
constexpr int OFF_SSQ = 2 * BUF;
static_assert(OFF_SSQ + 2048 <= RING_BYTES, "scan LDS");
#define HG_MFMA(a, b, c) __builtin_amdgcn_mfma_f32_16x16x32_bf16(a, b, c, 0, 0, 0)
__device__ __forceinline__ bf16x8 cat8(bf16x4 lo, bf16x4 hi) { return (bf16x8){lo[0], lo[1], lo[2], lo[3], hi[0], hi[1], hi[2], hi[3]}; }
typedef float f32x2_t __attribute__((ext_vector_type(2))); typedef __bf16 bf16x2_t __attribute__((ext_vector_type(2)));
__device__ __forceinline__ unsigned cvtpk(float lo, float hi) { f32x2_t v = {lo, hi}; bf16x2_t b = __builtin_convertvector(v, bf16x2_t); return __builtin_bit_cast(unsigned, b); }
__device__ __forceinline__ bf16x8 pack8(f32x4 a, f32x4 b) { v4u r; r.x = cvtpk(a[0], a[1]); r.y = cvtpk(a[2], a[3]); r.z = cvtpk(b[0], b[1]); r.w = cvtpk(b[2], b[3]); return __builtin_bit_cast(bf16x8, r); }

__device__ __forceinline__ void scan_fast(Frame& F, int jlayer, bool full) {
    relaunder(F);
    unsigned char* ws = F.ws;
    const GAS bf16* Qb = (const GAS bf16*)(ws + WS_B0); const GAS half_t* Gb = (const GAS half_t*)(ws + WS_B0 + BUF_STRIDE); const GAS bf16* Vb = (const GAS bf16*)(ws + WS_B0 + 2 * BUF_STRIDE); const GAS bf16* Zb = (const GAS bf16*)(ws + WS_B0 + 3 * BUF_STRIDE);
    GAS bf16* AO = (GAS bf16*)(ws + WS_AO); const GAS float* og = (const GAS float*)(ws + WS_PAR) + 288 + jlayer * 1024;
    const int tid = F.tid, lane = F.lane, w = F.wave, fr = lane & 15, q4 = lane >> 4;
    LAS unsigned char* L = F.lds;
    LAS float* ssq = (LAS float*)(L + OFF_SSQ);
    constexpr int NSUB = SEQ / 4 / 32;
    GAS float* sloc = (GAS float*)(ws + WS_SLOC); GAS float* dtot = (GAS float*)(ws + WS_DTOT);
    const int nunits = full ? 256 : 192;
    for (int u = blockIdx.x; u < nunits; u += F.G) {
        const int bh = u & 63, seg = u >> 6, b = bh >> 3, h = bh & 7; const size_t rowbase = (size_t)b * SEQ + (size_t)seg * (SEQ / 4); const int colbase = h * 128;
        f32x4 S[8];
#pragma unroll
        for (int T = 0; T < 8; ++T) S[T] = (f32x4){0.f, 0.f, 0.f, 0.f};
        if (full) for (int sp = 0; sp < seg; ++sp) {
            const GAS float* sl = sloc + ((size_t)(bh * 4 + sp) << 14) + 16 * w + fr; const GAS float* dl = dtot + (bh * 4 + sp) * 128;
#pragma unroll
            for (int T = 0; T < 8; ++T)
#pragma unroll
                for (int e = 0; e < 4; ++e) { const int c = 16 * T + 4 * q4 + e; S[T][e] = __expf(dl[c]) * S[T][e] + sl[c * 128]; } }
        float Eacc = 0.f;
        f32x4 Zp[2]; Zp[0] = (f32x4){0.f, 0.f, 0.f, 0.f}; Zp[1] = Zp[0];
        const int pc = 16 * w + fr;
        unsigned short qh[8]; half_t gh[8]; v4u vraw;
#pragma unroll
        for (int i = 0; i < 8; ++i) qh[i] = 0;
#define HG_LOAD(n_) do { const size_t r0_ = rowbase + (size_t)(n_) * 32; \
            _Pragma("unroll") for (int i = 0; i < 8; ++i) { const size_t a_ = (r0_ + 8 * q4 + i) * 1024 + colbase + pc; if (full) qh[i] = Qb[a_]; gh[i] = Gb[a_]; } \
            vraw = *(const GAS v4u*)(Vb + (r0_ + (tid >> 4)) * 1024 + colbase + (tid & 15) * 8); } while (0)
        HG_LOAD(0);
        for (int n = 0; n <= NSUB; ++n) {
            LAS unsigned char* buf = L + (n & 1) * BUF;
            if (n < NSUB) {
                float bcum[8]; float run = 0.f;
#pragma unroll
                for (int i = 0; i < 8; ++i) { run += (float)gh[i]; bcum[i] = run; }
                float x = run; float y = __shfl_up(x, 16); if (q4 >= 1) x += y; y = __shfl_up(x, 32); if (q4 >= 2) x += y;
                const float excl = x - run; const float E = __shfl(x, 48 + fr); Eacc += E;
                unsigned kdp[8];
#pragma unroll
                for (int i = 0; i < 8; ++i) { const float bc = excl + bcum[i]; const float qv = bf2f(qh[i]); const float kk = 1.0f - __expf((float)gh[i]);
                    const int t = 8 * q4 + i;
                    if (full) { *(LAS unsigned short*)(buf + OFF_Q + t * QS + pc * 2) = (unsigned short)f2bf(qv * __expf(bc));
                                *(LAS unsigned short*)(buf + OFF_K + t * QS + pc * 2) = (unsigned short)f2bf(kk * __expf(fminf(-bc, 80.f))); }
                    kdp[i] = f2bf(kk * __expf(E - bc)); }
                *(LAS v4u*)(buf + OFF_KD + pc * KS + q4 * 16) = (v4u){kdp[0] | (kdp[1] << 16), kdp[2] | (kdp[3] << 16), kdp[4] | (kdp[5] << 16), kdp[6] | (kdp[7] << 16)};
                if (q4 == 0) *(LAS float*)(buf + OFF_DE + pc * 4) = __expf(E);
                { const int tok = tid >> 4, ch = tid & 15; LAS unsigned char* vp = buf + OFF_VT + (ch * 8) * KS + tok * 2;
                  *(LAS unsigned short*)(vp + 0 * KS) = (unsigned short)(vraw.x & 0xffffu); *(LAS unsigned short*)(vp + 1 * KS) = (unsigned short)(vraw.x >> 16);
                  *(LAS unsigned short*)(vp + 2 * KS) = (unsigned short)(vraw.y & 0xffffu); *(LAS unsigned short*)(vp + 3 * KS) = (unsigned short)(vraw.y >> 16);
                  *(LAS unsigned short*)(vp + 4 * KS) = (unsigned short)(vraw.z & 0xffffu); *(LAS unsigned short*)(vp + 5 * KS) = (unsigned short)(vraw.z >> 16);
                  *(LAS unsigned short*)(vp + 6 * KS) = (unsigned short)(vraw.w & 0xffffu); *(LAS unsigned short*)(vp + 7 * KS) = (unsigned short)(vraw.w >> 16); }
            }
            if (full && n > 0) {
#pragma unroll
                for (int ti = 0; ti < 2; ++ti) { float p = (Zp[ti][0] * Zp[ti][0] + Zp[ti][1] * Zp[ti][1]) + (Zp[ti][2] * Zp[ti][2] + Zp[ti][3] * Zp[ti][3]);
                    p += __shfl_xor(p, 16); p += __shfl_xor(p, 32); if (q4 == 0) ssq[(((n - 1) & 1) * 8 + w) * 32 + 16 * ti + fr] = p; }
            }
            __syncthreads();
            if (full && n > 0) {
                const size_t r0 = rowbase + (size_t)(n - 1) * 32; const int vcol = colbase + 16 * w + 4 * q4; const f32x4 gg = *(const GAS f32x4*)(og + vcol);
#pragma unroll
                for (int ti = 0; ti < 2; ++ti) { float tot = 0.f;
#pragma unroll
                    for (int ww = 0; ww < 8; ++ww) tot += ssq[(((n - 1) & 1) * 8 + ww) * 32 + 16 * ti + fr];
                    const float rn = rsqrtf(tot * (1.0f / 128.0f) + EPS); const size_t a = (r0 + 16 * ti + fr) * 1024 + vcol;
                    const unsigned long long zz = *(const GAS unsigned long long*)(Zb + a); const unsigned z0 = (unsigned)zz, z1 = (unsigned)(zz >> 32);
                    const unsigned o0 = cvtpk(Zp[ti][0] * rn * gg[0] * bflo(z0), Zp[ti][1] * rn * gg[1] * bfhi(z0)), o1 = cvtpk(Zp[ti][2] * rn * gg[2] * bflo(z1), Zp[ti][3] * rn * gg[3] * bfhi(z1));
                    *(GAS unsigned long long*)(AO + a) = (unsigned long long)o0 | ((unsigned long long)o1 << 32); }
            }
            if (n >= NSUB) break;
            if (n + 1 < NSUB) HG_LOAD(n + 1);
            const LAS unsigned char* Qr0 = buf + OFF_Q + fr * QS; const LAS unsigned char* Qr1 = Qr0 + 16 * QS;
            const LAS unsigned char* Kr0 = buf + OFF_K + fr * QS; const LAS unsigned char* Kr1 = Kr0 + 16 * QS;
            const LAS unsigned char* Vr = buf + OFF_VT + (16 * w + fr) * KS;
            f32x4 Z0 = (f32x4){0.f, 0.f, 0.f, 0.f}, Z1 = Z0, X00 = Z0, X01 = Z0, X11 = Z0;
            if (full) {
#pragma unroll
            for (int ks = 0; ks < 4; ++ks) {
                const bf16x8 Sa = pack8(S[2 * ks], S[2 * ks + 1]);
                const int cb = (32 * ks + 4 * q4) * 2;
                const bf16x8 Bq0 = cat8(*(const LAS bf16x4*)(Qr0 + cb), *(const LAS bf16x4*)(Qr0 + cb + 32)), Bq1 = cat8(*(const LAS bf16x4*)(Qr1 + cb), *(const LAS bf16x4*)(Qr1 + cb + 32));
                Z0 = HG_MFMA(Sa, Bq0, Z0); Z1 = HG_MFMA(Sa, Bq1, Z1);
                const int cn = (32 * ks + 8 * q4) * 2;
                const bf16x8 a0 = *(const LAS bf16x8*)(Kr0 + cn), a1 = *(const LAS bf16x8*)(Kr1 + cn), b0 = *(const LAS bf16x8*)(Qr0 + cn), b1 = *(const LAS bf16x8*)(Qr1 + cn);
                X00 = HG_MFMA(a0, b0, X00); X01 = HG_MFMA(a0, b1, X01); X11 = HG_MFMA(a1, b1, X11);
            }
#pragma unroll
            for (int e = 0; e < 4; ++e) { const bool keep = (4 * q4 + e) <= fr; X00[e] = keep ? X00[e] : 0.f; X11[e] = keep ? X11[e] : 0.f; }
            { const bf16x8 P0 = pack8(X00, (f32x4){0.f, 0.f, 0.f, 0.f}), P1 = pack8(X01, X11);
              const bf16x8 Av = cat8(*(const LAS bf16x4*)(Vr + 8 * q4), *(const LAS bf16x4*)(Vr + 32 + 8 * q4));
              Z0 = HG_MFMA(Av, P0, Z0); Z1 = HG_MFMA(Av, P1, Z1); }
            }
            { const bf16x8 Bv = *(const LAS bf16x8*)(Vr + 16 * q4);
#pragma unroll
              for (int T = 0; T < 8; ++T) { const bf16x8 a = *(const LAS bf16x8*)(buf + OFF_KD + (16 * T + fr) * KS + 16 * q4); const f32x4 de = *(const LAS f32x4*)(buf + OFF_DE + (16 * T + 4 * q4) * 4);
                  S[T] = HG_MFMA(a, Bv, S[T] * de); } }
            Zp[0] = Z0; Zp[1] = Z1;
        }
#undef HG_LOAD
        if (!full) {
            GAS float* sl = sloc + ((size_t)(bh * 4 + seg) << 14) + 16 * w + fr;
#pragma unroll
            for (int T = 0; T < 8; ++T)
#pragma unroll
                for (int e = 0; e < 4; ++e) sl[(16 * T + 4 * q4 + e) * 128] = S[T][e];
            if (q4 == 0) dtot[(bh * 4 + seg) * 128 + pc] = Eacc; }
        __syncthreads();
    }
}
#undef HG_MFMA
}
struct Args { const float* in[14]; float* out; unsigned char* ws; int ph_lo, ph_hi, li, pad; };
constexpr int N_PHASES = 2 + 4 * DEPTH;
__global__ void __launch_bounds__(NWAVES * 64, 2) fwd(Args args) {
    extern __shared__ __attribute__((aligned(16))) unsigned char lds[];
    Frame F;
    F.lds = (LAS unsigned char*)lds; F.MISC = (volatile LAS unsigned*)(F.lds + MISC_OFF);
    F.tid = threadIdx.x; F.lane = F.tid & 63; F.wave = __builtin_amdgcn_readfirstlane(F.tid >> 6); F.G = gridDim.x; F.ws = args.ws;
    F.ctl = (gu32*)(args.ws + WS_CTL);
    for (int u = F.tid; u < (LDS_BYTES - LDSCTL_OFF) / 4; u += NWAVES * 64) ((LAS unsigned*)(F.lds + LDSCTL_OFF))[u] = 0u;
    __syncthreads();
    XcdBarrier bar; bar.bar = (unsigned*)(F.ctl + CW_BAR); bar.x = 0; bar.st = nullptr;
    const bool one = (args.ph_hi - args.ph_lo) > 1;
    if (one) bar = xcd_barrier_post((unsigned*)(F.ctl + CW_BAR), F.MISC + 8);
    const int lo = args.ph_lo, hi = args.ph_hi;
#define IN(k) (lo <= (k) && (k) < hi)
#define SEAM(k) do { if (IN(k) && IN((k) + 1)) xcd_barrier(bar); } while (0)
    unsigned char* ws = args.ws;
#if PROBE_DOUBLE & 8
    if (IN(0)) { p0a(F, args.in); SEAM(0); }
    if (IN(1)) { p0b(F, args.in); SEAM(1); }
#endif
    if (IN(0)) { p0a(F, args.in); SEAM(0); }
    if (IN(1)) { p0b(F, args.in); SEAM(1); }
    for (int p = (lo > 2 ? lo : 2); p < hi; ++p) {
        const int l = (p - 2) >> 2, sub = (p - 2) & 3, j = l >> 1; const bool fx = l & 1;
#if PROBE_DOUBLE
        const bool dbl = ((PROBE_DOUBLE & 1) && sub == 0) || ((PROBE_DOUBLE & 2) && !fx && (sub == 1 || sub == 2)) || ((PROBE_DOUBLE & 4) && fx && (sub == 1 || sub == 2));
        for (int rep = dbl ? 0 : 1; rep < 2; ++rep) { if (dbl && rep == 1) xcd_barrier(bar);
#endif
        if (sub == 0 || sub == 3) {
            const bool isout = sub == 3;
            pg8::Gemm g{(const pg8::bf16_t*)(ws + (isout ? WS_AO : WS_XS)), (const pg8::bf16_t*)(ws + (isout ? WS_WOUT + (size_t)l * WOUT_STRIDE : WS_WIN + (size_t)l * WIN_STRIDE)), M, isout ? DM : HG_IN, DM};
            pg8::StaticOrder S; S.init(M, g.N, F.G, (int)blockIdx.x);
            pg8::EpiAll E; E.ws = ws; E.x0 = args.in[0]; E.xo = args.out; E.l = l; E.isout = isout ? 1 : 0;
            pg8::gemm_phase<pg8::EpiAll, pg8::StaticOrder, PG8_ALIGN, PG8_SP2>(F.lds + RING_OFF, g, S, E);
            if (fx && !isout) fox_fl_units(F, l);
        } else if (!fx) {
#if FAST_SCAN
            hg::scan_fast(F, j, sub == 2);
#else
            if (sub == 1) continue;
            scan_naive(F, j);
#endif
        } else if (sub == 1) {
            fox_cumsum(F);
        } else {
#if FAST_ATTN
            relaunder(F);
            float tthr; { const float* par = (const float*)(ws + WS_PAR); float gq = fabsf(par[j * 64 + F.lane]), gk = fabsf(par[128 + j * 64 + F.lane]);
#pragma unroll
              for (int o = 1; o < 64; o <<= 1) { gq = fmaxf(gq, __shfl_xor(gq, o)); gk = fmaxf(gk, __shfl_xor(gk, o)); }
              tthr = __builtin_bit_cast(float, __builtin_amdgcn_readfirstlane(__builtin_bit_cast(int, 2.04f * 64.0f * C2 * gq * gk + 42.0f))); }
            attn_body::attn_phase<8>((char*)lds + RING_OFF, F.MISC + 16, (unsigned*)(ws + WS_CTL) + 64 + 64 * j, ws, tthr);
#else
            attn_naive(F);
#endif
        }
#if PROBE_DOUBLE
        }
#endif
        if (p + 1 < hi) xcd_barrier(bar);
    }
#undef IN
#undef SEAM
}

extern "C" void kernel_launch(void* const* d_in, const int* in_sizes, int n_in, void* d_out, int out_size, void* d_ws, size_t ws_size, hipStream_t stream) {
    static int grid = 0;
    if (grid == 0) {
        if (n_in != 14 || in_sizes[0] != M * DM || out_size != M * DM || ws_size < WS_END) { fprintf(stderr, "kernel_launch: unexpected shapes (n_in %d, in0 %d, out %d, ws %zu); nothing launched\n", n_in, n_in > 0 ? in_sizes[0] : -1, out_size, ws_size); grid = -1; return; }
        int dev = 0, cus = 0, per_cu = 0;
        if (hipGetDevice(&dev) != hipSuccess || hipDeviceGetAttribute(&cus, hipDeviceAttributeMultiprocessorCount, dev) != hipSuccess) { grid = -1; return; }
        if (hipFuncSetAttribute((const void*)fwd, hipFuncAttributeMaxDynamicSharedMemorySize, LDS_BYTES) != hipSuccess) { fprintf(stderr, "kernel_launch: hipFuncSetAttribute failed\n"); grid = -1; return; }
        if (hipOccupancyMaxActiveBlocksPerMultiprocessor(&per_cu, (const void*)fwd, NWAVES * 64, LDS_BYTES) != hipSuccess || per_cu < 1) fprintf(stderr, "kernel_launch: note: occupancy query reports %d workgroups per CU\n", per_cu);
        (void)hipGetLastError();
        grid = cus;
    }
    if (grid < 0) return;
    if (hipMemsetAsync((char*)d_ws + WS_CTL, 0, CTL_ZERO_BYTES, stream) != hipSuccess) { fprintf(stderr, "kernel_launch: hipMemsetAsync failed\n"); return; }
    Args a{};
    for (int i = 0; i < 14; ++i) a.in[i] = (const float*)d_in[i];
    a.out = (float*)d_out; a.ws = (unsigned char*)d_ws; a.li = 0; a.pad = 0;
#if MK_ONE_LAUNCH
    a.ph_lo = 0; a.ph_hi = N_PHASES;
    hipLaunchKernelGGL(fwd, dim3(grid), dim3(NWAVES * 64), LDS_BYTES, stream, a);
#else
    for (int p = 0; p < N_PHASES; ++p) {
        a.ph_lo = p; a.ph_hi = p + 1;
        hipLaunchKernelGGL(fwd, dim3(grid), dim3(NWAVES * 64), LDS_BYTES, stream, a);
    }
#endif
    const hipError_t le = hipPeekAtLastError();
    if (le != hipSuccess) fprintf(stderr, "kernel_launch: launch failed: %s\n", hipGetErrorName(le));
}
```

```cpp
#include <hip/hip_runtime.h>
#include <hip/hip_bf16.h>
#include <cstdio>
#include <cstdint>
#include <cmath>
#ifndef MK_ONE_LAUNCH
#define MK_ONE_LAUNCH 1
#endif
#ifndef FAST_ATTN
#define FAST_ATTN 1
#endif
#ifndef FAST_SCAN
#define FAST_SCAN 1
#endif
#ifndef SCAN_CHECK
#define SCAN_CHECK 0
#endif
#ifndef PROBE_DOUBLE
#define PROBE_DOUBLE 0
#endif
constexpr int BATCH = 8, SEQ = 4096, DM = 1024, M = BATCH * SEQ, DEPTH = 4;
constexpr int HG_H = 8, HG_DK = 128, HG_IN = 4096;
constexpr int FX_H = 16, FX_HD = 64, FX_IN = 4112, FX_INP = 4352;
constexpr float EPS = 1e-6f;
constexpr float LOG2E = 1.4426950408889634f;
constexpr float C2 = 0.125f * LOG2E;

namespace pg8 {
#define PG8_LAS __attribute__((address_space(3)))
typedef unsigned short bf16_t;
typedef short bf16x8 __attribute__((ext_vector_type(8)));
typedef float f32x4 __attribute__((ext_vector_type(4)));
typedef unsigned u32x4 __attribute__((ext_vector_type(4)));
constexpr int BM = 256, BK = 64, HALF = 128, HTB = HALF * BK * 2  , STAGE_BYTES = 8 * HTB, NXCD = 8, WGM = 8;

__host__ __device__ __forceinline__ int lds_byte(int r, int c) { const int st = (r >> 4) * 2 + (c >> 5), rr = r & 15, cc = c & 31, ob = rr * 64 + cc * 2; return st * 1024 + (ob ^ (((ob >> 9) & 1) << 5)); }
__host__ __device__ __forceinline__ void stage_rc(int b, int& R, int& C) { const int st = b / 1024, sb = b % 1024, swz = sb ^ (((sb >> 9) & 1) << 5); R = (st >> 1) * 16 + swz / 64; C = (st & 1) * 32 + (swz % 64) / 2; }
__host__ __device__ __forceinline__ int perm32(int rho) { const int n = rho >> 4, i = rho & 15; return 8 * (i >> 2) + 4 * n + (i & 3); }

struct Unit { int pm, pn; };
struct Gemm { const bf16_t* A; const bf16_t* Bt; int M, N, K; };

struct StaticOrder {
    int nM, nN, nwg, G, c;
    __host__ __device__ void init(int M, int N, int G_, int c_) { nM = M / BM; nN = N / BM; nwg = nM * nN; G = G_; c = c_; }
    __host__ __device__ bool next(int i, Unit& u) const {
        const long L = (long)i * G + c; if (L >= nwg) return false;
        int wgid = (int)L; { const int q = nwg / NXCD, r = nwg % NXCD, xcd = wgid % NXCD, off = wgid / NXCD; wgid = (xcd < r ? xcd * (q + 1) : r * (q + 1) + (xcd - r) * q) + off; }
        const int nig = WGM * nN, gid = wgid / nig, fm = gid * WGM, gsz = (nM - fm) < WGM ? (nM - fm) : WGM;
        u.pm = fm + ((wgid % nig) % gsz); u.pn = (wgid % nig) / gsz; return true;
    }
    __device__ __forceinline__ void a_ready(const Unit&) const {}
    __device__ __forceinline__ void done(const Unit&) const {}
};
template <class Epi, class Sched, bool ALIGN_EPI = false, bool SP2 = false>
__device__ __forceinline__ void gemm_phase(PG8_LAS unsigned char* lds, const Gemm g, const Sched& S, const Epi& E) {
    int tid_ = threadIdx.x; asm volatile("" : "+v"(tid_));
    const int tid = tid_, wid = __builtin_amdgcn_readfirstlane(tid >> 6), lane = tid & 63, wr = wid >> 2, wc = wid & 3, fr = lane & 15, fq = lane >> 4;
    const int K = g.K, nt = K / BK;
    unsigned voffA[2], voffB[2];
#pragma unroll
    for (int i = 0; i < 2; ++i) { int R, C; stage_rc(tid * 16 + i * 8192, R, C); const int Rb = Epi::PMODE == 2 ? (64 * (R >> 5) + perm32(R & 31)) : (Epi::PMODE == 1 ? ((R & ~31) + perm32(R & 31)) : R);
        voffA[i] = (unsigned)(R * K + C) * 2u; voffB[i] = (unsigned)(Rb * K + C) * 2u; }
    const size_t kstep = (size_t)(BK * 2);
    const size_t hstep = (size_t)HALF * K * 2;
    const size_t hstepB = (Epi::PMODE == 2) ? (size_t)32 * K * 2 : hstep;
    const size_t tstep = 2 * hstep;
    const unsigned ldsw = (unsigned)wid * 1024u;
    const int aoff = lds_byte(wr * 64 + fr, fq * 8), boff = lds_byte(wc * 32 + fr, fq * 8);
#define PG8_SA(b, h) (((b) * 2 + (h)) * HTB)
#define PG8_SB(b, h) ((4 + (b) * 2 + (h)) * HTB)
#define PG8_STAGE(bufoff, gbase, voff) do { _Pragma("unroll") for (int _i = 0; _i < 2; ++_i) \
        __builtin_amdgcn_global_load_lds((const unsigned*)((const char*)(gbase) + (voff)[_i]), (PG8_LAS unsigned*)(lds + (bufoff) + ldsw + _i * 8192), 16, 0, 0); } while (0)
#define PG8_LDA(dst, b, h) do { _Pragma("unroll") for (int m = 0; m < 4; ++m) _Pragma("unroll") for (int k = 0; k < 2; ++k) dst[m][k] = *(const PG8_LAS bf16x8*)(lds + PG8_SA(b, h) + aoff + m * 2048 + k * 1024); } while (0)
#define PG8_LDB(dst, b, h) do { _Pragma("unroll") for (int n = 0; n < 2; ++n) _Pragma("unroll") for (int k = 0; k < 2; ++k) dst[n][k] = *(const PG8_LAS bf16x8*)(lds + PG8_SB(b, h) + boff + n * 2048 + k * 1024); } while (0)
#define PG8_MMA(ai, bj, At, Bt) do { __builtin_amdgcn_s_setprio(1); _Pragma("unroll") for (int m = 0; m < 4; ++m) _Pragma("unroll") for (int n = 0; n < 2; ++n) _Pragma("unroll") for (int k = 0; k < 2; ++k) \
        acc[ai][bj][m][n] = __builtin_amdgcn_mfma_f32_16x16x32_bf16(Bt[n][k], At[m][k], acc[ai][bj][m][n], 0, 0, 0); __builtin_amdgcn_s_setprio(0); } while (0)
#define PG8_WAIT_V(n) asm volatile("s_waitcnt vmcnt(" #n ")" ::: "memory")
#define PG8_WAIT_L(n) asm volatile("s_waitcnt lgkmcnt(" #n ")" ::: "memory")
#define PG8_BAR __builtin_amdgcn_s_barrier()
#define PG8_SCHED __builtin_amdgcn_sched_barrier(0)
    Unit cur, nxt; int ui = 0;
    if (!S.next(0, cur)) return;
    f32x4 acc[2][2][4][2];
#pragma unroll
    for (int a = 0; a < 2; ++a)
#pragma unroll
        for (int b = 0; b < 2; ++b)
#pragma unroll
            for (int m = 0; m < 4; ++m)
#pragma unroll
                for (int n = 0; n < 2; ++n) acc[a][b][m][n] = (f32x4){0.f, 0.f, 0.f, 0.f};
    bf16x8 At[4][2], B0[2][2], B1[2][2];
    const char* cA = (const char*)g.A + (size_t)cur.pm * tstep; const char* cB = (const char*)g.Bt + (size_t)cur.pn * tstep;
    S.a_ready(cur);
    if constexpr (SP2) {
        PG8_STAGE(PG8_SB(0, 0), cB, voffB); PG8_STAGE(PG8_SB(0, 1), cB + hstepB, voffB); PG8_STAGE(PG8_SA(0, 0), cA, voffA); PG8_STAGE(PG8_SA(0, 1), cA + hstep, voffA);
        if (wr == 1) PG8_BAR;
        PG8_WAIT_V(2); PG8_BAR;
        PG8_STAGE(PG8_SB(1, 0), cB + kstep, voffB); PG8_STAGE(PG8_SA(1, 0), cA + kstep, voffA); PG8_STAGE(PG8_SB(1, 1), cB + hstepB + kstep, voffB);
        PG8_WAIT_V(6); PG8_BAR;
    } else {
        PG8_STAGE(PG8_SB(0, 0), cB, voffB); PG8_STAGE(PG8_SA(0, 0), cA, voffA); PG8_STAGE(PG8_SB(0, 1), cB + hstepB, voffB); PG8_STAGE(PG8_SA(0, 1), cA + hstep, voffA);
        if (wr == 1) PG8_BAR;
        PG8_WAIT_V(4); PG8_BAR;
        PG8_STAGE(PG8_SB(1, 0), cB + kstep, voffB); PG8_STAGE(PG8_SA(1, 0), cA + kstep, voffA); PG8_STAGE(PG8_SB(1, 1), cB + hstepB + kstep, voffB);
        PG8_WAIT_V(6); PG8_BAR;
    }
    for (;;) {
        const bool has_next = S.next(ui + 1, nxt);
        const char* nA = has_next ? (const char*)g.A + (size_t)nxt.pm * tstep : cA; const char* nB = has_next ? (const char*)g.Bt + (size_t)nxt.pn * tstep : cB;
        for (int t = 0; t < nt; t += 2) {
            const bool last = (t == nt - 2);
            const char* a1 = cA + (size_t)(t + 1) * kstep;
            const char* a2 = last ? nA : cA + (size_t)(t + 2) * kstep; const char* b2 = last ? nB : cB + (size_t)(t + 2) * kstep;
            const char* a3 = a2 + kstep; const char* b3 = b2 + kstep;
            if (last && has_next) S.a_ready(nxt);
            if constexpr (SP2) {
            PG8_LDB(B0, 0, 0); PG8_LDB(B1, 0, 1); PG8_SCHED; PG8_LDA(At, 0, 0); PG8_STAGE(PG8_SA(1, 1), a1 + hstep, voffA);
            PG8_WAIT_V(8); PG8_WAIT_L(0); PG8_BAR; PG8_MMA(0, 0, At, B0); PG8_MMA(0, 1, At, B1); PG8_BAR; PG8_SCHED;
            PG8_LDA(At, 0, 1); PG8_STAGE(PG8_SB(0, 0), b2, voffB); PG8_STAGE(PG8_SB(0, 1), b2 + hstepB, voffB); PG8_STAGE(PG8_SA(0, 0), a2, voffA);
            PG8_WAIT_V(8); PG8_WAIT_L(0); PG8_BAR; PG8_MMA(1, 0, At, B0); PG8_MMA(1, 1, At, B1); PG8_BAR; PG8_SCHED;
            PG8_LDB(B0, 1, 0); PG8_LDB(B1, 1, 1); PG8_SCHED; PG8_LDA(At, 1, 0); PG8_STAGE(PG8_SA(0, 1), a2 + hstep, voffA);
            PG8_WAIT_V(8); PG8_WAIT_L(0); PG8_BAR; PG8_MMA(0, 0, At, B0); PG8_MMA(0, 1, At, B1); PG8_BAR; PG8_SCHED;
            PG8_LDA(At, 1, 1); PG8_STAGE(PG8_SB(1, 0), b3, voffB); PG8_STAGE(PG8_SB(1, 1), b3 + hstepB, voffB); PG8_STAGE(PG8_SA(1, 0), a3, voffA);
            PG8_WAIT_V(8); PG8_WAIT_L(0); PG8_BAR; PG8_MMA(1, 0, At, B0); PG8_MMA(1, 1, At, B1); PG8_BAR; PG8_SCHED;
            } else {
            PG8_LDB(B0, 0, 0); PG8_SCHED; PG8_LDA(At, 0, 0); PG8_STAGE(PG8_SA(1, 1), a1 + hstep, voffA);
            PG8_WAIT_L(8); PG8_BAR; PG8_WAIT_L(0); PG8_MMA(0, 0, At, B0); PG8_BAR; PG8_SCHED;
            PG8_LDB(B1, 0, 1); PG8_STAGE(PG8_SB(0, 0), b2, voffB);
            PG8_BAR; PG8_WAIT_L(0); PG8_MMA(0, 1, At, B1); PG8_BAR;
            PG8_LDA(At, 0, 1); PG8_STAGE(PG8_SA(0, 0), a2, voffA);
            PG8_BAR; PG8_WAIT_L(0); PG8_MMA(1, 0, At, B0); PG8_BAR; PG8_SCHED;
            PG8_STAGE(PG8_SB(0, 1), b2 + hstepB, voffB);
            PG8_WAIT_V(6); PG8_BAR; PG8_MMA(1, 1, At, B1); PG8_BAR;
            PG8_LDB(B0, 1, 0); PG8_SCHED; PG8_LDA(At, 1, 0); PG8_STAGE(PG8_SA(0, 1), a2 + hstep, voffA);
            PG8_WAIT_L(8); PG8_BAR; PG8_WAIT_L(0); PG8_MMA(0, 0, At, B0); PG8_BAR; PG8_SCHED;
            PG8_LDB(B1, 1, 1); PG8_STAGE(PG8_SB(1, 0), b3, voffB);
            PG8_BAR; PG8_WAIT_L(0); PG8_MMA(0, 1, At, B1); PG8_BAR;
            PG8_LDA(At, 1, 1); PG8_STAGE(PG8_SA(1, 0), a3, voffA);
            PG8_BAR; PG8_WAIT_L(0); PG8_MMA(1, 0, At, B0); PG8_BAR; PG8_SCHED;
            PG8_STAGE(PG8_SB(1, 1), b3 + hstepB, voffB);
            PG8_WAIT_V(6); PG8_BAR; PG8_MMA(1, 1, At, B1); PG8_BAR;
            }
        }
        if constexpr (ALIGN_EPI) { if (wr == 0) PG8_BAR; }
        if constexpr (!Epi::AFTER_DRAIN) { E(acc, cur, wr, wc, fr, fq); S.done(cur); }
        if (!has_next) break;
#pragma unroll
        for (int a = 0; a < 2; ++a)
#pragma unroll
            for (int b = 0; b < 2; ++b)
#pragma unroll
                for (int m = 0; m < 4; ++m)
#pragma unroll
                    for (int n = 0; n < 2; ++n) acc[a][b][m][n] = (f32x4){0.f, 0.f, 0.f, 0.f};
        cur = nxt; cA = nA; cB = nB; ++ui;
        if constexpr (ALIGN_EPI) { if (wr == 1) PG8_BAR; }
    }
    PG8_WAIT_V(0);
    if constexpr (!ALIGN_EPI) { if (wr == 0) PG8_BAR; }
    PG8_BAR;
    if constexpr (Epi::AFTER_DRAIN) { E.fused(acc, cur, wr, wc, fr, fq, lds, wid, lane); S.done(cur); }
#undef PG8_SA
#undef PG8_SB
#undef PG8_STAGE
#undef PG8_LDA
#undef PG8_LDB
#undef PG8_MMA
#undef PG8_WAIT_V
#undef PG8_WAIT_L
#undef PG8_BAR
#undef PG8_SCHED
}
}

#ifndef PG8_SP2
#define PG8_SP2 true
#endif
#ifndef PG8_ALIGN
#define PG8_ALIGN true
#endif
constexpr size_t MiB = 1u << 20;
constexpr size_t WS_CTL = 0, CTL_ZERO_BYTES = 1 * MiB;
constexpr size_t WS_ROWSS = 65536;
constexpr size_t WS_WIN = 4 * MiB, WIN_STRIDE = 10 * MiB;
constexpr size_t WS_WOUT = 44 * MiB, WOUT_STRIDE = 2 * MiB;
constexpr size_t WS_XS = 64 * MiB;
constexpr size_t WS_B0 = 128 * MiB, BUF_STRIDE = 64 * MiB;
constexpr size_t WS_AO = 384 * MiB;
constexpr size_t WS_MISC = 448 * MiB;
constexpr size_t WS_GS = WS_MISC, WS_SH = WS_MISC + 128 * 1024, WS_GATE = WS_MISC + 256 * 1024, WS_LB = WS_MISC + 384 * 1024;
constexpr size_t WS_PAR = WS_MISC + 400 * 1024;
constexpr size_t WS_BIAS = WS_MISC + 1 * MiB;
constexpr size_t WS_LF = WS_MISC + 2 * MiB;
constexpr size_t WS_CKL = WS_MISC + 4 * MiB;
constexpr size_t WS_KX = WS_MISC + 6 * MiB;
constexpr size_t WS_SLOC = WS_MISC + 16 * MiB;
constexpr size_t WS_DTOT = WS_MISC + 32 * MiB;
constexpr size_t WS_END = WS_MISC + 34 * MiB;
constexpr int CW_TMO = 0, CW_CODE = 1, CW_BAR = 4096;
constexpr int BIAS_LD = FX_INP;

constexpr int RING_OFF = 0, RING_BYTES = 131072;
constexpr int LDSCTL_OFF = RING_BYTES, MISC_OFF = LDSCTL_OFF + 320;
constexpr int LDS_BYTES = 147456;
constexpr int NWAVES = 8;

namespace pg8 {
#define PG8_GAS __attribute__((address_space(1)))
__device__ __forceinline__ unsigned cvt_pk_bf16(float lo, float hi) { unsigned r; asm volatile("v_cvt_pk_bf16_f32 %0, %1, %2" : "=v"(r) : "v"(lo), "v"(hi)); return r; }
typedef _Float16 f16x2 __attribute__((ext_vector_type(2)));
__device__ __forceinline__ unsigned cvt_pk_f16(float lo, float hi) { f16x2 v = {(_Float16)lo, (_Float16)hi}; return __builtin_bit_cast(unsigned, v); }
__device__ __forceinline__ float fast_sigmoid(float v) { return __builtin_amdgcn_rcpf(1.0f + __builtin_amdgcn_exp2f(v * -LOG2E)); }
__device__ __forceinline__ float fast_log(float v) { return __builtin_amdgcn_logf(v) * 0.6931471805599453f; }
__device__ __forceinline__ float log_sigmoid(float v) { return fminf(v, 0.f) - fast_log(1.0f + __builtin_amdgcn_exp2f(fabsf(v) * -LOG2E)); }

struct EpiAll {
    static constexpr int PMODE = 2; static constexpr bool AFTER_DRAIN = false;
    unsigned char* ws; const float* x0; float* xo; int l; int isout;
    __device__ __forceinline__ void operator()(const f32x4 (&acc)[2][2][4][2], const Unit& u, int wr_, int wc_, int fr_, int fq_) const {
        if (isout) epi_out(acc, u, wr_, wc_, fr_, fq_); else epi_in(acc, u, wr_, wc_, fr_, fq_);
    }
    __device__ __forceinline__ void epi_in(const f32x4 (&acc)[2][2][4][2], const Unit& u, int wr_, int wc_, int fr_, int fq_) const {
        unsigned char* w = ws; int wr = wr_, wc = wc_, fr = fr_, fq = fq_, ll = l;
        asm volatile("" : "+s"(w), "+s"(ll), "+s"(wr), "+s"(wc), "+v"(fr), "+v"(fq));
        const int kind = ll & 1, jj = ll >> 1;
        const PG8_GAS float* rowss = (const PG8_GAS float*)(w + WS_ROWSS) + (size_t)ll * M;
        const int nb = BIAS_LD; const PG8_GAS float* bias = (const PG8_GAS float*)(w + WS_BIAS) + (size_t)ll * 8 * BIAS_LD;
        PG8_GAS bf16_t* obase = (PG8_GAS bf16_t*)(w + WS_B0); const size_t ostride = BUF_STRIDE / 2;
        const PG8_GAS float* lb = (kind == 0 && jj > 0) ? (const PG8_GAS float*)(w + WS_LB) + jj * 1024 : nullptr;
        const PG8_GAS float* qg = (const PG8_GAS float*)(w + WS_PAR) + jj * 64; const PG8_GAS float* kg = (const PG8_GAS float*)(w + WS_PAR) + 128 + jj * 64;
        const int t = u.pn >> 2, b = u.pm >> 4;
        const int crel = 64 * wc + 8 * fq, gcol0 = u.pn * 256 + crel, ocol0 = (u.pn & 3) * 256 + crel;
        f32x4 bv[2][2], pv[2][2];
#pragma unroll
        for (int bj = 0; bj < 2; ++bj)
#pragma unroll
            for (int n = 0; n < 2; ++n) {
                bv[bj][n] = *(const PG8_GAS f32x4*)(bias + (size_t)b * nb + gcol0 + 32 * bj + 4 * n);
                pv[bj][n] = (f32x4){0.f, 0.f, 0.f, 0.f};
                if (kind == 0) { if (t == 1 && lb) pv[bj][n] = *(const PG8_GAS f32x4*)(lb + ocol0 + 32 * bj + 4 * n); }
                else { if (t == 0) pv[bj][n] = *(const PG8_GAS f32x4*)(qg + 32 * bj + 8 * fq + 4 * n) * C2; else if (t == 1) pv[bj][n] = *(const PG8_GAS f32x4*)(kg + 32 * bj + 8 * fq + 4 * n); }
            }
        PG8_GAS bf16_t* ob = obase + (size_t)(t & 3) * ostride;
        float rs[2][4];
#pragma unroll
        for (int ai = 0; ai < 2; ++ai)
#pragma unroll
            for (int m = 0; m < 4; ++m) rs[ai][m] = rowss[u.pm * 256 + ai * 128 + wr * 64 + m * 16 + fr];
#pragma unroll
        for (int ai = 0; ai < 2; ++ai)
#pragma unroll
            for (int m = 0; m < 4; ++m) {
                const int row = u.pm * 256 + ai * 128 + wr * 64 + m * 16 + fr;
                const float rstd = rsqrtf(rs[ai][m] * (1.0f / 1024.0f) + EPS);
                f32x4 v[2][2];
#pragma unroll
                for (int bj = 0; bj < 2; ++bj)
#pragma unroll
                    for (int n = 0; n < 2; ++n) v[bj][n] = acc[ai][bj][m][n] * rstd + bv[bj][n];
                bool half16 = false;
                if (kind == 0) {
                    if (t == 1) {
                        half16 = true;
#pragma unroll
                        for (int bj = 0; bj < 2; ++bj)
#pragma unroll
                            for (int n = 0; n < 2; ++n)
#pragma unroll
                                for (int e = 0; e < 4; ++e) { const float fl = v[bj][n][e];
                                    v[bj][n][e] = lb ? __builtin_amdgcn_logf(pv[bj][n][e] + (1.0f - pv[bj][n][e]) * fast_sigmoid(fl)) : log_sigmoid(fl) * LOG2E; }
                    } else if (t == 3) {
#pragma unroll
                        for (int bj = 0; bj < 2; ++bj)
#pragma unroll
                            for (int n = 0; n < 2; ++n)
#pragma unroll
                                for (int e = 0; e < 4; ++e) { const float z = v[bj][n][e]; v[bj][n][e] = z * fast_sigmoid(z); }
                    }
                } else {
                    if (t <= 1) {
                        float ss = 0.f;
#pragma unroll
                        for (int bj = 0; bj < 2; ++bj)
#pragma unroll
                            for (int n = 0; n < 2; ++n) { const f32x4 x = v[bj][n]; ss += (x[0] * x[0] + x[1] * x[1]) + (x[2] * x[2] + x[3] * x[3]); }
                        ss += __shfl_xor(ss, 16); ss += __shfl_xor(ss, 32);
                        const float rn = rsqrtf(ss * (1.0f / 64.0f) + EPS);
#pragma unroll
                        for (int bj = 0; bj < 2; ++bj)
#pragma unroll
                            for (int n = 0; n < 2; ++n) v[bj][n] = v[bj][n] * rn * pv[bj][n];
                    } else if (t == 3) {
#pragma unroll
                        for (int bj = 0; bj < 2; ++bj)
#pragma unroll
                            for (int n = 0; n < 2; ++n)
#pragma unroll
                                for (int e = 0; e < 4; ++e) { const float z = v[bj][n][e]; v[bj][n][e] = z * fast_sigmoid(z); }
                    }
                }
                PG8_GAS bf16_t* rowp = ob + (size_t)row * 1024 + ocol0;
#pragma unroll
                for (int bj = 0; bj < 2; ++bj) { u32x4 w;
                    if (half16) { w.x = cvt_pk_f16(v[bj][0][0], v[bj][0][1]); w.y = cvt_pk_f16(v[bj][0][2], v[bj][0][3]); w.z = cvt_pk_f16(v[bj][1][0], v[bj][1][1]); w.w = cvt_pk_f16(v[bj][1][2], v[bj][1][3]); }
                    else { w.x = cvt_pk_bf16(v[bj][0][0], v[bj][0][1]); w.y = cvt_pk_bf16(v[bj][0][2], v[bj][0][3]); w.z = cvt_pk_bf16(v[bj][1][0], v[bj][1][1]); w.w = cvt_pk_bf16(v[bj][1][2], v[bj][1][3]); }
                    *(PG8_GAS u32x4*)(rowp + 32 * bj) = w; }
            }
    }

    __device__ __forceinline__ void epi_out(const f32x4 (&acc)[2][2][4][2], const Unit& u, int wr_, int wc_, int fr_, int fq_) const {
        unsigned char* w = ws; int wr = wr_, wc = wc_, fr = fr_, fq = fq_, ll = l; const float* xin_ = (l == 0) ? x0 : xo; float* xout_ = xo;
        asm volatile("" : "+s"(w), "+s"(ll), "+s"(wr), "+s"(wc), "+v"(fr), "+v"(fq), "+s"(xin_), "+s"(xout_));
        const PG8_GAS float* xin = (const PG8_GAS float*)xin_; PG8_GAS float* xout = (PG8_GAS float*)xout_;
        const PG8_GAS float* gate = (const PG8_GAS float*)(w + WS_GATE) + (size_t)ll * 8 * 1024;
        const PG8_GAS float* gsn = (ll + 1 < DEPTH) ? (const PG8_GAS float*)(w + WS_GS) + (size_t)(ll + 1) * 8 * 1024 : nullptr;
        PG8_GAS bf16_t* xs = (PG8_GAS bf16_t*)(w + WS_XS); float* rowssn = (float*)(w + WS_ROWSS) + (size_t)(ll + 1 < DEPTH ? ll + 1 : 0) * M;
        const int b = u.pm >> 4, col0 = u.pn * 256 + 64 * wc + 8 * fq;
        f32x4 gv[2][2], sv[2][2];
#pragma unroll
        for (int bj = 0; bj < 2; ++bj)
#pragma unroll
            for (int n = 0; n < 2; ++n) { gv[bj][n] = *(const PG8_GAS f32x4*)(gate + b * 1024 + col0 + 32 * bj + 4 * n);
                sv[bj][n] = gsn ? *(const PG8_GAS f32x4*)(gsn + b * 1024 + col0 + 32 * bj + 4 * n) : (f32x4){0.f, 0.f, 0.f, 0.f}; }
#pragma unroll
        for (int ai = 0; ai < 2; ++ai)
#pragma unroll
            for (int m = 0; m < 4; ++m) {
                const int row = u.pm * 256 + ai * 128 + wr * 64 + m * 16 + fr; float ss = 0.f;
#pragma unroll
                for (int bj = 0; bj < 2; ++bj) { const size_t off = (size_t)row * 1024 + col0 + 32 * bj;
                    const f32x4 y0 = *(const PG8_GAS f32x4*)(xin + off) + gv[bj][0] * acc[ai][bj][m][0], y1 = *(const PG8_GAS f32x4*)(xin + off + 4) + gv[bj][1] * acc[ai][bj][m][1];
                    *(PG8_GAS f32x4*)(xout + off) = y0; *(PG8_GAS f32x4*)(xout + off + 4) = y1;
                    ss += (y0[0] * y0[0] + y0[1] * y0[1]) + (y0[2] * y0[2] + y0[3] * y0[3]) + (y1[0] * y1[0] + y1[1] * y1[1]) + (y1[2] * y1[2] + y1[3] * y1[3]);
                    if (gsn) { const f32x4 a0 = y0 * sv[bj][0], a1 = y1 * sv[bj][1]; u32x4 w; w.x = cvt_pk_bf16(a0[0], a0[1]); w.y = cvt_pk_bf16(a0[2], a0[3]); w.z = cvt_pk_bf16(a1[0], a1[1]); w.w = cvt_pk_bf16(a1[2], a1[3]);
                        *(PG8_GAS u32x4*)(xs + off) = w; } }
                if (gsn) { ss += __shfl_xor(ss, 16); ss += __shfl_xor(ss, 32); if (fq == 0) atomicAdd(rowssn + row, ss); }
            }
    }
};
}
#include <hip/hip_bf16.h>
#include <cmath>
namespace attn_body {
using bf16=__hip_bfloat16;
using bf16x8=__attribute__((ext_vector_type(8)))short;
using s16x4=__attribute__((ext_vector_type(4)))short;
using f32x16=__attribute__((ext_vector_type(16)))float;
using u32x4=__attribute__((ext_vector_type(4)))unsigned;
constexpr int BATCH=8,NHEAD=16,SEQ=4096,D=64,DM=NHEAD*D;
constexpr int NW=8,QBLK=32,QB=QBLK*NW,KVBLK=64,NQB=SEQ/QB;
constexpr int ATTN_PITCH=DM, ATTN_UNIT_ROWS=QB;
__device__ __forceinline__ int crow(int r,int hi){return (r&3)+8*(r>>2)+4*hi;}
#define SBAR() __builtin_amdgcn_sched_barrier(0)
__device__ __forceinline__ void cmask(f32x16&p0,f32x16&p1,int jb,int qrel,int hi){
  const float NEG=-INFINITY; int kb=64*jb+4*hi;
  #pragma unroll
  for(int r=0;r<16;++r){int kv=kb+(r&3)+8*(r>>2); if(kv>qrel)p0[r]=NEG; if(kv+32>qrel)p1[r]=NEG;}
}

constexpr size_t ATT_WS_Q=WS_B0, ATT_WS_K=WS_B0+BUF_STRIDE, ATT_WS_V=WS_B0+2*BUF_STRIDE, ATT_WS_Z=WS_B0+3*BUF_STRIDE, ATT_WS_KX=WS_KX, ATT_WS_CKL=WS_CKL, ATT_WS_O=WS_AO;
constexpr int NSLOT=3, SLOTB=8192;
constexpr int LDS_K=0, LDS_V=NSLOT*SLOTB, LDS_KX=2*NSLOT*SLOTB, LDS_WS=LDS_KX+4*1024, LDS_OST=LDS_WS+NW*64*4, LDS_BYTES=LDS_OST+NW*4096;
constexpr float C2=0.125f*1.4426950408889634f;
__device__ __forceinline__ void glds16(const void*sbase,unsigned voff,unsigned lds_dst){unsigned keep;
  asm volatile("s_mov_b32 %0, m0\n\ts_mov_b32 m0, %3\n\ts_nop 0\n\tglobal_load_lds_dwordx4 %1, %2\n\ts_mov_b32 m0, %0":"=&s"(keep):"v"(voff),"s"(sbase),"s"(lds_dst):"memory");}
__device__ __forceinline__ float max3f(float a,float b,float c){float r;asm("v_max3_f32 %0, %1, %2, %3":"=v"(r):"v"(a),"v"(b),"v"(c));return r;}
__device__ __forceinline__ float max2f(float a,float b){float r;asm("v_max_f32_e32 %0, %1, %2":"=v"(r):"v"(a),"v"(b));return r;}
__device__ __forceinline__ float fadd_s(float a,float b){float r;asm("v_add_f32_e32 %0, %1, %2":"=v"(r):"v"(a),"v"(b));return r;}
__device__ __forceinline__ float fsub_s(float a,float b){float r;asm("v_sub_f32_e32 %0, %1, %2":"=v"(r):"v"(a),"v"(b));return r;}
typedef float f32x2_t __attribute__((ext_vector_type(2))); typedef __bf16 bf16x2_t __attribute__((ext_vector_type(2)));
__device__ __forceinline__ unsigned cvtpk_s(float lo,float hi){f32x2_t v={lo,hi};bf16x2_t b=__builtin_convertvector(v,bf16x2_t);return __builtin_bit_cast(unsigned,b);}
#define WAIT_BAR(N) asm volatile("s_waitcnt vmcnt(" #N ") lgkmcnt(0)\n\ts_barrier":::"memory")

__device__ __forceinline__ void qkt(f32x16&p0,f32x16&p1,const char*Kslot,const char*KXslot,const bf16x8*qr,const f32x16&negm,int r32,int hi){
  const char*kb=Kslot+hi*1024+r32*16;
  #pragma unroll
  for(int d0=0;d0<4;++d0){
    const bf16x8 b0=*reinterpret_cast<const bf16x8*>(kb+d0*2048);
    const bf16x8 b1=*reinterpret_cast<const bf16x8*>(kb+d0*2048+512);
    if(d0==0){p0=__builtin_amdgcn_mfma_f32_32x32x16_bf16(b0,qr[0],negm,0,0,0);p1=__builtin_amdgcn_mfma_f32_32x32x16_bf16(b1,qr[0],negm,0,0,0);}
    else{p0=__builtin_amdgcn_mfma_f32_32x32x16_bf16(b0,qr[d0],p0,0,0,0);p1=__builtin_amdgcn_mfma_f32_32x32x16_bf16(b1,qr[d0],p1,0,0,0);}}
  { const bf16x8 e0=*reinterpret_cast<const bf16x8*>(KXslot+r32*16), e1=*reinterpret_cast<const bf16x8*>(KXslot+r32*16+512);
    p0=__builtin_amdgcn_mfma_f32_32x32x16_bf16(e0,qr[4],p0,0,0,0);p1=__builtin_amdgcn_mfma_f32_32x32x16_bf16(e1,qr[4],p1,0,0,0);}
}
typedef __attribute__((address_space(3))) const char* lds_cptr;
typedef short v4i16_t __attribute__((ext_vector_type(4)));
__device__ __forceinline__ void kload8(bf16x8*kf,lds_cptr kp){
  kf[0]=*(const __attribute__((address_space(3))) bf16x8*)(kp);      kf[1]=*(const __attribute__((address_space(3))) bf16x8*)(kp+512);
  kf[2]=*(const __attribute__((address_space(3))) bf16x8*)(kp+2048); kf[3]=*(const __attribute__((address_space(3))) bf16x8*)(kp+2560);
  kf[4]=*(const __attribute__((address_space(3))) bf16x8*)(kp+4096); kf[5]=*(const __attribute__((address_space(3))) bf16x8*)(kp+4608);
  kf[6]=*(const __attribute__((address_space(3))) bf16x8*)(kp+6144); kf[7]=*(const __attribute__((address_space(3))) bf16x8*)(kp+6656);
}
__device__ __forceinline__ void kload2(bf16x8*kf,lds_cptr kp,int j){ kf[2*j]=*(const __attribute__((address_space(3))) bf16x8*)(kp+j*2048); kf[2*j+1]=*(const __attribute__((address_space(3))) bf16x8*)(kp+j*2048+512); }
__device__ __forceinline__ s16x4 vtr(lds_cptr p){ return __builtin_bit_cast(s16x4,__builtin_amdgcn_ds_read_tr16_b64_v4i16((__attribute__((address_space(3))) v4i16_t*)p)); }
__device__ __forceinline__ float rowmax(const f32x16&p0,const f32x16&p1){
  float a=max3f(p0[0],p0[1],p1[0]),b=max3f(p0[2],p0[3],p1[1]);a=max3f(a,p1[2],p1[3]);
  #pragma unroll
  for(int r=4;r<16;r+=4){a=max3f(a,p0[r],p0[r+1]);b=max3f(b,p0[r+2],p0[r+3]);a=max3f(a,p1[r],p1[r+1]);b=max3f(b,p1[r+2],p1[r+3]);}
  const float m=max2f(a,b);
  auto rr=__builtin_amdgcn_permlane32_swap(__float_as_uint(m),__float_as_uint(m),false,false);
  return max2f(__uint_as_float(rr[0]),__uint_as_float(rr[1]));
}
__device__ __forceinline__ void pv(f32x16*o,int vb,bf16x8 pa0,bf16x8 pa1,bf16x8 pa2,bf16x8 pa3){
  #pragma unroll
  for(int d0=0;d0<2;++d0){s16x4 lo[4],hi[4];
    #pragma unroll
    for(int ks=0;ks<4;++ks){
      asm volatile("ds_read_b64_tr_b16 %0,%1 offset:%c2":"=&v"(lo[ks]):"v"(vb),"i"(d0*4096+ks*1024):"memory");
      asm volatile("ds_read_b64_tr_b16 %0,%1 offset:%c2":"=&v"(hi[ks]):"v"(vb),"i"(d0*4096+ks*1024+512):"memory");}
    asm volatile("s_waitcnt lgkmcnt(0)":::"memory");SBAR();
    #define PK(k) (bf16x8){lo[k][0],lo[k][1],lo[k][2],lo[k][3],hi[k][0],hi[k][1],hi[k][2],hi[k][3]}
    o[d0]=__builtin_amdgcn_mfma_f32_32x32x16_bf16(pa0,PK(0),o[d0],0,0,0);
    o[d0]=__builtin_amdgcn_mfma_f32_32x32x16_bf16(pa1,PK(1),o[d0],0,0,0);
    o[d0]=__builtin_amdgcn_mfma_f32_32x32x16_bf16(pa2,PK(2),o[d0],0,0,0);
    o[d0]=__builtin_amdgcn_mfma_f32_32x32x16_bf16(pa3,PK(3),o[d0],0,0,0);
    #undef PK
  }
}

#ifndef ATTN_STORE16
#define ATTN_STORE16(p,v) (*(u32x4*)(p)=(v))
#endif
template<int THRL> __device__ __forceinline__ void attn_unit(int b,int h,int qb,unsigned char*wsb,float Tthr,char*shm){
  asm volatile("":"+s"(wsb));
  const bf16*Q=(const bf16*)(wsb+ATT_WS_Q); const bf16*__restrict__ K=(const bf16*)(wsb+ATT_WS_K); const bf16*__restrict__ V=(const bf16*)(wsb+ATT_WS_V); const bf16*__restrict__ KX=(const bf16*)(wsb+ATT_WS_KX);
  const bf16*__restrict__ Z=(const bf16*)(wsb+ATT_WS_Z); const float*__restrict__ CKL=(const float*)(wsb+ATT_WS_CKL); bf16*O=(bf16*)(wsb+ATT_WS_O);
  int tid_=threadIdx.x; asm volatile("":"+v"(tid_));
  const int tid=tid_,lane=tid&63,r32=lane&31,hi=lane>>5; const int wid=__builtin_amdgcn_readfirstlane(tid>>6);
  const long rowbase=(long)b*SEQ; const int q0=qb*QB;
  const bf16*Qw=Q+(rowbase+q0+wid*QBLK)*DM+h*D;
  const bf16*Kh=K+rowbase*DM+h*D,*Vh=V+rowbase*DM+h*D; const bf16*KXh=KX+((long)(b*NHEAD+h)*SEQ)*8;
  int j0=0;
  { const float*ck=CKL+(long)(b*NHEAD+h)*SEQ; const int nfull=q0/KVBLK; const float cq=ck[q0]; const float ce=(lane<nfull)?ck[KVBLK*lane+KVBLK-1]:0.f;
    const bool sk=(lane<nfull)&&((cq-ce)<-Tthr); const unsigned long long bal=__ballot(sk); j0=__builtin_amdgcn_readfirstlane((int)__builtin_ctzll(~bal))&~1; }
  Kh+=(long)j0*KVBLK*DM; Vh+=(long)j0*KVBLK*DM; KXh+=(long)j0*KVBLK*8;
  const unsigned lds0=(unsigned)(uintptr_t)shm;
  float*wsf=(float*)(shm+LDS_WS)+wid*64;
  const unsigned koff=(unsigned)(lane*DM+wid*8)*2u;
  const unsigned voff=(unsigned)((16*(wid&3)+(lane>>2))*DM+(wid>>2)*32+(lane&3)*8)*2u;
  const unsigned kdst=lds0+LDS_K+wid*1024, vdst=lds0+LDS_V+wid*1024, kxdst=lds0+LDS_KX+wid*128;
  const unsigned kxoff=(unsigned)(8*wid+(lane&7))*16u;
  #define DMA_K(t,slot) glds16(Kh+(long)(t)*KVBLK*DM,koff,(unsigned)__builtin_amdgcn_readfirstlane(kdst+(slot)))
  #define DMA_V(t,slot) glds16(Vh+(long)(t)*KVBLK*DM,voff,(unsigned)__builtin_amdgcn_readfirstlane(vdst+(slot)))
  #define DMA_KX(t) do{ const unsigned d_=(unsigned)__builtin_amdgcn_readfirstlane(kxdst+(((t)&3)<<10)); if(lane<8) glds16(KXh+(long)(t)*KVBLK*8,kxoff,d_); }while(0)
  const int vb0=(int)(lds0+LDS_V)+((lane>>4)&1)*32+(lane&3)*8+(4*hi+((lane&15)>>2))*64;
  const char*Kbase=shm+LDS_K; const char*KXbase=shm+LDS_KX; bf16x8 kf[8];
  const lds_cptr shm3=(lds_cptr)shm; const lds_cptr kp0=shm3+LDS_K+hi*1024+r32*16; const lds_cptr vp0=shm3+LDS_V+((lane>>4)&1)*32+(lane&3)*8+(4*hi+((lane&15)>>2))*64; const lds_cptr kxp0=shm3+LDS_KX+r32*16;
  const int NT=(q0+QB)/KVBLK-j0;
  DMA_K(0,0);DMA_KX(0);DMA_V(0,0);DMA_K(1,SLOTB);DMA_KX(1);
  bf16x8 qr[5];
  { const short one_=hi?(short)0:(short)0x3F80; qr[4]=(bf16x8){one_,one_,one_,0,0,0,0,0}; }
  #pragma unroll
  for(int d0=0;d0<4;++d0)qr[d0]=*reinterpret_cast<const bf16x8*>(&Qw[(long)r32*DM+d0*16+hi*8]);
  float mhat=0.f,l_reg=0.f;f32x16 o[2];o[0]=f32x16{};o[1]=f32x16{};f32x16 negm=f32x16{};asm volatile("":"+v"(negm));
  const int qrel=wid*QBLK+r32;
  #define CMASK(P0,P1,t) do{int jb_=(t)-(NT-4); if(jb_>=0)cmask(P0,P1,jb_,qrel,hi);}while(0)
  bool resc=false;
  #define START(P0,P1) do{ const float rm=rowmax(P0,P1); resc=false; \
    { const float dl=rm; mhat=fadd_s(mhat,dl); \
      _Pragma("unroll") for(int r=0;r<16;++r){P0[r]=fsub_s(P0[r],dl);P1[r]=fsub_s(P1[r],dl);} \
      _Pragma("unroll") for(int r=0;r<16;++r)negm[r]=-mhat; asm volatile("":"+v"(negm)); } \
    _Pragma("unroll") for(int r=0;r<16;++r)P0[r]=__builtin_amdgcn_exp2f(P0[r]); }while(0)
  #define RESC() do{ if(resc){ asm volatile("s_waitcnt lgkmcnt(0)":::"memory"); \
      _Pragma("unroll") for(int d_=0;d_<2;++d_) _Pragma("unroll") for(int r=0;r<16;++r)o[d_][r]*=wsf[crow(r,hi)]; } }while(0)
  f32x16 pA0,pA1,pB0,pB1;
  int sl_prev=0,sl_cur=0,sl_next=SLOTB;
  #define ROT() do{sl_prev=sl_cur;sl_cur=sl_next;sl_next=(sl_next==(NSLOT-1)*SLOTB)?0:sl_next+SLOTB;}while(0)
  DMA_K(2,2*SLOTB);DMA_KX(2);
  WAIT_BAR(5);
  qkt(pA0,pA1,Kbase,KXbase,qr,negm,r32,hi);asm volatile("s_nop 15\n\ts_nop 7":"+v"(pA0),"+v"(pA1));CMASK(pA0,pA1,0);
  START(pA0,pA1);
  _Pragma("unroll") for(int r=0;r<16;++r)pA1[r]=__builtin_amdgcn_exp2f(pA1[r]);
  WAIT_BAR(0);
  DMA_K(3,0);DMA_KX(3);DMA_V(1,SLOTB);
  ROT();
  kload8(kf,kp0+sl_cur);
  WAIT_BAR(3);
  s16x4 vlo[8],vhi[8]; u32x4 pw0,pw1,pw2,pw3;
  #define PKW(P,B) cvtpk_s(P[B],P[B+1])
  #define PAF(k) __builtin_bit_cast(bf16x8,pw##k)
  #define VFR(i) (bf16x8){vlo[i][0],vlo[i][1],vlo[i][2],vlo[i][3],vhi[i][0],vhi[i][1],vhi[i][2],vhi[i][3]}
  #define PIN(x) asm volatile("":"+v"(x))
  #define MX3(a,b,c) __builtin_fmaxf(__builtin_fmaxf((a),(b)),(c))
  #define GAPA(MF,A0,A1,A2,A3,W0,W1,PW) do{ MF; sacc+=A0; sacc+=A1; sacc+=A2; sacc+=A3; PIN(sacc); W0; W1; PIN(PW); SBAR(); }while(0)
  #define EX(v) __builtin_amdgcn_exp2f(v)
  #define GAPB(MF,X,B) do{ MF; X[B]=EX(X[B]); X[B+1]=EX(X[B+1]); X[B+2]=EX(X[B+2]); X[B+3]=EX(X[B+3]); PIN(X); SBAR(); }while(0)
  #define VRD(i) do{ vlo[i]=vtr(vp_+(((i)>>2)*4096+((i)&3)*1024)); vhi[i]=vtr(vp_+(((i)>>2)*4096+((i)&3)*1024+512)); }while(0)
  #define KRD(G,j) do{ if(G){ kload2(kf,kp0+sl_next,j); SBAR(); } }while(0)
  #define STEP(C0,C1,P0,P1,t,GK,GV,GL) do{ SBAR(); \
    const lds_cptr vp_=vp0+sl_prev; \
    VRD(0); SBAR(); float sacc=(P0[0]+P0[1]); \
    GAPA(C0=__builtin_amdgcn_mfma_f32_32x32x16_bf16(kf[0],qr[0],negm,0,0,0), P0[2],P0[3],P0[4],P0[5],     pw0[0]=PKW(P0,0), pw0[1]=PKW(P0,2), pw0); \
    VRD(4); SBAR(); GAPA(C1=__builtin_amdgcn_mfma_f32_32x32x16_bf16(kf[1],qr[0],negm,0,0,0), P0[6],P0[7],P0[8],P0[9],     pw0[2]=PKW(P0,4), pw0[3]=PKW(P0,6), pw0); \
    VRD(1); SBAR(); GAPA(C0=__builtin_amdgcn_mfma_f32_32x32x16_bf16(kf[2],qr[1],C0,0,0,0),   P0[10],P0[11],P0[12],P0[13], pw1[0]=PKW(P0,8), pw1[1]=PKW(P0,10), pw1); \
    VRD(5); SBAR(); GAPA(C1=__builtin_amdgcn_mfma_f32_32x32x16_bf16(kf[3],qr[1],C1,0,0,0),   P0[14],P0[15],P1[0],P1[1],   pw1[2]=PKW(P0,12),pw1[3]=PKW(P0,14), pw1); \
    VRD(2); SBAR(); GAPA(C0=__builtin_amdgcn_mfma_f32_32x32x16_bf16(kf[4],qr[2],C0,0,0,0),   P1[2],P1[3],P1[4],P1[5],     pw2[0]=PKW(P1,0), pw2[1]=PKW(P1,2), pw2); \
    VRD(6); SBAR(); GAPA(C1=__builtin_amdgcn_mfma_f32_32x32x16_bf16(kf[5],qr[2],C1,0,0,0),   P1[6],P1[7],P1[8],P1[9],     pw2[2]=PKW(P1,4), pw2[3]=PKW(P1,6), pw2); \
    VRD(3); SBAR(); GAPA(C0=__builtin_amdgcn_mfma_f32_32x32x16_bf16(kf[6],qr[3],C0,0,0,0),   P1[10],P1[11],P1[12],P1[13], pw3[0]=PKW(P1,8), pw3[1]=PKW(P1,10), pw3); \
    VRD(7); SBAR(); GAPA(C1=__builtin_amdgcn_mfma_f32_32x32x16_bf16(kf[7],qr[3],C1,0,0,0),   P1[14],P1[15],0.f,0.f,       pw3[2]=PKW(P1,12),pw3[3]=PKW(P1,14), pw3); \
    { const lds_cptr xp_=kxp0+(((t)&3)<<10); const bf16x8 e0_=*(const __attribute__((address_space(3))) bf16x8*)(xp_), e1_=*(const __attribute__((address_space(3))) bf16x8*)(xp_+512); \
      C0=__builtin_amdgcn_mfma_f32_32x32x16_bf16(e0_,qr[4],C0,0,0,0); C1=__builtin_amdgcn_mfma_f32_32x32x16_bf16(e1_,qr[4],C1,0,0,0); SBAR(); } \
    l_reg+=sacc; \
    if(GK){DMA_K((t)+3,sl_cur);DMA_KX((t)+3);} if(GV){DMA_V((t)+1,sl_next);} \
    CMASK(C0,C1,t); \
    { float a=MX3(C0[0],C0[1],C1[0]),b=MX3(C0[2],C0[3],C1[1]); a=MX3(a,C1[2],C1[3]); \
      _Pragma("unroll") for(int r=4;r<16;r+=4){a=MX3(a,C0[r],C0[r+1]);b=MX3(b,C0[r+2],C0[r+3]);a=MX3(a,C1[r],C1[r+1]);b=MX3(b,C1[r+2],C1[r+3]);} \
      float rm=__builtin_fmaxf(a,b); { auto rr=__builtin_amdgcn_permlane32_swap(__float_as_uint(rm),__float_as_uint(rm),false,false); rm=__builtin_fmaxf(__uint_as_float(rr[0]),__uint_as_float(rr[1])); } \
      resc=false; \
      if(__builtin_expect(__any(rm>(float)THRL),0)){ const float dl=__builtin_fmaxf(rm,0.f); mhat+=dl; \
        _Pragma("unroll") for(int r=0;r<16;++r){C0[r]-=dl;C1[r]-=dl;} \
        _Pragma("unroll") for(int r=0;r<16;++r)negm[r]=-mhat; asm volatile("":"+v"(negm)); \
        const float f=__builtin_amdgcn_exp2f(-dl); l_reg*=f; if(hi==0)wsf[r32]=f; resc=true; } } \
    SBAR(); \
    GAPB(o[0]=__builtin_amdgcn_mfma_f32_32x32x16_bf16(PAF(0),VFR(0),o[0],0,0,0), C0,0); \
    GAPB(o[1]=__builtin_amdgcn_mfma_f32_32x32x16_bf16(PAF(0),VFR(4),o[1],0,0,0), C0,4); \
    KRD(GL,0); GAPB(o[0]=__builtin_amdgcn_mfma_f32_32x32x16_bf16(PAF(1),VFR(1),o[0],0,0,0), C0,8); \
    KRD(GL,1); GAPB(o[1]=__builtin_amdgcn_mfma_f32_32x32x16_bf16(PAF(1),VFR(5),o[1],0,0,0), C0,12); \
    KRD(GL,2); GAPB(o[0]=__builtin_amdgcn_mfma_f32_32x32x16_bf16(PAF(2),VFR(2),o[0],0,0,0), C1,0); \
    KRD(GL,3); GAPB(o[1]=__builtin_amdgcn_mfma_f32_32x32x16_bf16(PAF(2),VFR(6),o[1],0,0,0), C1,4); \
    GAPB(o[0]=__builtin_amdgcn_mfma_f32_32x32x16_bf16(PAF(3),VFR(3),o[0],0,0,0), C1,8); \
    GAPB(o[1]=__builtin_amdgcn_mfma_f32_32x32x16_bf16(PAF(3),VFR(7),o[1],0,0,0), C1,12); \
    }while(0)
  int t=1;
  #undef CMASK
  #define CMASK(P0,P1,t) do{}while(0)
  for(;t+5<NT;t+=2){
    STEP(pB0,pB1,pA0,pA1,t,true,true,true);     WAIT_BAR(3); RESC(); ROT();
    STEP(pA0,pA1,pB0,pB1,t+1,true,true,true);   WAIT_BAR(3); RESC(); ROT();
  }
  #undef CMASK
  #define CMASK(P0,P1,t) do{int jb_=(t)-(NT-4); if(jb_>=0)cmask(P0,P1,jb_,qrel,hi);}while(0)
  #define ENDW(tt) do{ if((tt)+3<NT){WAIT_BAR(3);} else if((tt)+2<NT){WAIT_BAR(1);} else {WAIT_BAR(0);} }while(0)
  for(;t+1<NT;t+=2){
    STEP(pB0,pB1,pA0,pA1,t,(t+3<NT),(t+1<NT),(t+1<NT));       ENDW(t);   RESC(); ROT();
    STEP(pA0,pA1,pB0,pB1,t+1,(t+4<NT),(t+2<NT),(t+2<NT));     ENDW(t+1); RESC(); ROT();
  }
  STEP(pB0,pB1,pA0,pA1,NT-1,false,false,false); RESC();
  { float sacc=pB0[0]+pB0[1]; _Pragma("unroll") for(int r=2;r<16;++r)sacc+=pB0[r]; _Pragma("unroll") for(int r=0;r<16;++r)sacc+=pB1[r]; l_reg+=sacc;
    pw0=(u32x4){PKW(pB0,0),PKW(pB0,2),PKW(pB0,4),PKW(pB0,6)};pw1=(u32x4){PKW(pB0,8),PKW(pB0,10),PKW(pB0,12),PKW(pB0,14)};pw2=(u32x4){PKW(pB1,0),PKW(pB1,2),PKW(pB1,4),PKW(pB1,6)};pw3=(u32x4){PKW(pB1,8),PKW(pB1,10),PKW(pB1,12),PKW(pB1,14)};
    SBAR(); pv(o,vb0+sl_cur,PAF(0),PAF(1),PAF(2),PAF(3)); }
  #undef PKW
  #undef PAF
  #undef VFR
  #undef PIN
  #undef MX3
  #undef GAPA
  #undef GAPB
  #undef EX
  #undef VRD
  #undef KRD
  #undef STEP
  #undef ENDW
  {auto rr=__builtin_amdgcn_permlane32_swap(__float_as_uint(l_reg),__float_as_uint(l_reg),false,false);l_reg=__uint_as_float(rr[0])+__uint_as_float(rr[1]);}
  if(hi==0)wsf[32+r32]=l_reg;asm volatile("s_waitcnt lgkmcnt(0)":::"memory");
  float rli[16];
  #pragma unroll
  for(int r=0;r<16;++r)rli[r]=__builtin_amdgcn_rcpf(wsf[32+crow(r,hi)]);
  bf16*Ow=O+(rowbase+q0+wid*QBLK)*DM+h*D; const bf16*Zw=Z+(rowbase+q0+wid*QBLK)*DM+h*D;
  { bf16*stg=(bf16*)(shm+LDS_OST)+wid*2048;
    #pragma unroll
    for(int r=0;r<16;++r){const int orow=crow(r,hi);
      #pragma unroll
      for(int d0=0;d0<2;++d0)stg[orow*64+d0*32+r32]=__float2bfloat16(o[d0][r]*rli[r]);}
    asm volatile("s_waitcnt lgkmcnt(0)":::"memory");
    #pragma unroll
    for(int i=0;i<4;++i){const int row=i*8+(lane>>3),ch=lane&7; const u32x4 v=*(const u32x4*)(stg+row*64+ch*8); const u32x4 zz=*(const u32x4*)(Zw+(long)row*DM+ch*8); u32x4 g_;
      #pragma unroll
      for(int e_=0;e_<4;++e_){ const float a0=__builtin_bit_cast(float,v[e_]<<16)*__builtin_bit_cast(float,zz[e_]<<16), a1=__builtin_bit_cast(float,v[e_]&0xffff0000u)*__builtin_bit_cast(float,zz[e_]&0xffff0000u); g_[e_]=cvtpk_s(a0,a1); }
      ATTN_STORE16(Ow+(long)row*DM+ch*8,g_);} }
  asm volatile("s_waitcnt lgkmcnt(0)\n\ts_barrier":::"memory");
  #undef DMA_K
  #undef DMA_V
  #undef DMA_KX
  #undef CMASK
  #undef START
  #undef RESC
  #undef ROT
}
constexpr int ATTN_LDS_BYTES=LDS_BYTES;
struct AttnTensors { const bf16* Q; const bf16* K; const bf16* V; const bf16* KX; const bf16* Z; const float* CKL; bf16* O; };
struct AttnUnit { int bh; int qb; };
struct StaticOrder {
  int vcu;
  __device__ __forceinline__ explicit StaticOrder(int grid,int block):vcu((grid%8==0)?(block%8)*(grid/8)+block/8:block){}
  __device__ __forceinline__ bool next(int i,AttnUnit&u)const{ const int L=vcu*8+i; if(i>=8||L>=BATCH*NHEAD*NQB)return false; const int s=vcu&1,p=i>>1; u.bh=vcu>>1; u.qb=(i&1)?(15-2*p-s):(2*p+s); return true; }
  __device__ __forceinline__ void a_ready(const AttnUnit&)const{}
  __device__ __forceinline__ void done(const AttnUnit&)const{}
};
template<int THRL=8> __device__ __forceinline__ void attn_phase(char*lds,volatile __attribute__((address_space(3))) unsigned*bc,unsigned*counter,unsigned char*wsb,float Tthr){
  for(;;){
    if(threadIdx.x==0) bc[0]=__hip_atomic_fetch_add(counter,1u,__ATOMIC_RELAXED,__HIP_MEMORY_SCOPE_AGENT);
    __syncthreads();
    const int U=__builtin_amdgcn_readfirstlane((int)bc[0]);
    __syncthreads();
    if(U>=BATCH*NHEAD*NQB)break;
    const int qb=NQB-1-(U>>7), bh=U&127;
    attn_unit<THRL>(bh/NHEAD,bh%NHEAD,qb,wsb,Tthr,lds);
  }
}
#undef SBAR
#undef WAIT_BAR
}
#define GAS __attribute__((address_space(1)))
#define LAS __attribute__((address_space(3)))
typedef unsigned short bf16;
typedef unsigned v4u __attribute__((ext_vector_type(4)));
typedef float f32x4 __attribute__((ext_vector_type(4)));
typedef short bf16x8 __attribute__((ext_vector_type(8)));
typedef GAS unsigned gu32;
typedef GAS unsigned long long gu64;
#define RLX_AGENT __ATOMIC_RELAXED, __HIP_MEMORY_SCOPE_AGENT
#define LDS_WAIT() asm volatile("s_waitcnt lgkmcnt(0)" ::: "memory")
#define VM_WAIT() asm volatile("s_waitcnt vmcnt(0)" ::: "memory")
__device__ __forceinline__ unsigned long long rt() { return __builtin_amdgcn_s_memrealtime(); }
__device__ __forceinline__ unsigned f2bf(float f) { unsigned u = __builtin_bit_cast(unsigned, f); return (u + 0x7fffu + ((u >> 16) & 1u)) >> 16; }
__device__ __forceinline__ unsigned pk2(float lo, float hi) { return f2bf(lo) | (f2bf(hi) << 16); }
#define XB_TMO      128
#define XB_XCNT(j)  (256  + 64 * (j))
#define XB_XSUB(j)  (1280 + 64 * (j))
#define XB_XGEN(j)  (2304 + 64 * (j))
#define XB_TOP      3328
#define XB_TOPGEN   3392
#define XCD_BAR_WORDS 3456
#define XB_SPIN_CAP (1u << 18)

__device__ __forceinline__ unsigned xb_ld(unsigned* p)              { return __hip_atomic_load(p, __ATOMIC_RELAXED, __HIP_MEMORY_SCOPE_AGENT); }
__device__ __forceinline__ unsigned xb_add(unsigned* p, unsigned v) { return __hip_atomic_fetch_add(p, v, __ATOMIC_RELAXED, __HIP_MEMORY_SCOPE_AGENT); }
__device__ __forceinline__ unsigned xb_xcc_id() { return (unsigned)__builtin_amdgcn_s_getreg((3 << 11) | 20) & 0xFu; }
#define XB_SPIN(cond, bar) do { unsigned _sp = 0; while (cond) { __builtin_amdgcn_s_sleep(1); \
    if ((++_sp & 255u) == 0u) { if (xb_ld(&(bar)[XB_TMO])) break; if (_sp > XB_SPIN_CAP) { atomicAdd(&(bar)[XB_TMO], 1u); break; } } } } while (0)

struct XcdBarrier {
    unsigned* bar; unsigned x;
    volatile LAS unsigned* st;
};

__device__ __forceinline__ XcdBarrier xcd_barrier_post(unsigned* bar, volatile LAS unsigned* st) {
    XcdBarrier b; b.bar = bar; b.x = xb_xcc_id(); b.st = st;
    if (threadIdx.x == 0) (void)xb_add(&bar[XB_XCNT(b.x)], 1u);
    return b;
}
__device__ __forceinline__ void xcd_barrier_complete(unsigned* bar, unsigned x, unsigned& nloc, unsigned& nx) {
    const unsigned G = gridDim.x * gridDim.y * gridDim.z;
    unsigned sum, cnt, mine, sp = 0u;
    for (;;) {
        sum = 0u; cnt = 0u; mine = 0u;
#pragma unroll
        for (unsigned j = 0; j < 16; ++j) { const unsigned c = xb_ld(&bar[XB_XCNT(j)]); sum += c; cnt += (c > 0u) ? 1u : 0u; mine = (j == x) ? c : mine; }
        if (sum == G) break;
        __builtin_amdgcn_s_sleep(1);
        if ((++sp & 255u) == 0u) { if (xb_ld(&bar[XB_TMO])) break; if (sp > XB_SPIN_CAP) { atomicAdd(&bar[XB_TMO], 1u); break; } }
    }
    nloc = mine > 0u ? mine : 1u; nx = cnt > 0u ? cnt : 1u;
}

__device__ __forceinline__ void xcd_barrier(const XcdBarrier& b) {
    asm volatile("s_waitcnt vmcnt(0)" ::: "memory");
    __syncthreads();
    if (threadIdx.x == 0) {
        unsigned* bar = b.bar;
        __builtin_amdgcn_s_waitcnt(0);
        unsigned nloc = b.st[0], nx = b.st[1];
        if (nloc == 0u) { xcd_barrier_complete(bar, b.x, nloc, nx); b.st[0] = nloc; b.st[1] = nx; }
        const unsigned old = xb_add(&bar[XB_XSUB(b.x)], 1u);
        const unsigned gen = old / nloc;
        if (old + 1u == (gen + 1u) * nloc) {
            __builtin_amdgcn_fence(__ATOMIC_RELEASE, "agent");
            asm volatile("s_waitcnt vmcnt(0)" ::: "memory");
            const unsigned og = xb_add(&bar[XB_TOP], 1u);
            const unsigned tg = og / nx;
            if (og + 1u == (tg + 1u) * nx) xb_add(&bar[XB_TOPGEN], 1u);
            else XB_SPIN(xb_ld(&bar[XB_TOPGEN]) == tg, bar);
            __builtin_amdgcn_fence(__ATOMIC_ACQUIRE, "agent");
            xb_add(&bar[XB_XGEN(b.x)], 1u);
            asm volatile("s_waitcnt vmcnt(0)" ::: "memory");
        } else {
            XB_SPIN(xb_ld(&bar[XB_XGEN(b.x)]) == gen, bar);
            __builtin_amdgcn_fence(__ATOMIC_ACQUIRE, "agent");
            asm volatile("s_waitcnt vmcnt(0)" ::: "memory");
        }
    }
    __syncthreads();
}
__device__ __forceinline__ float wave_sum(float v) {
#pragma unroll
    for (int o = 1; o < 64; o <<= 1) v += __shfl_xor(v, o);
    return v;
}
__device__ __forceinline__ void p0_transpose_item(const float* W, int K, int N, bf16* WT, int row_off, LAS float* scr, int item, int lane) {
    const int nblk = N / 32, kb = item / nblk, nb = item % nblk, k0 = 64 * kb, n0 = 32 * nb;
#pragma unroll 8
    for (int i = 0; i < 32; ++i) { const int kk = 2 * i + (lane >> 5); scr[kk * 33 + (lane & 31)] = W[(size_t)(k0 + kk) * N + n0 + (lane & 31)]; }
    LDS_WAIT(); asm volatile("" ::: "memory");
    const int c = lane & 7;
#pragma unroll
    for (int j = 0; j < 4; ++j) { const int n = (lane >> 3) + 8 * j; const LAS float* s = scr + (8 * c) * 33 + n;
        v4u o; o.x = pk2(s[0 * 33], s[1 * 33]); o.y = pk2(s[2 * 33], s[3 * 33]); o.z = pk2(s[4 * 33], s[5 * 33]); o.w = pk2(s[6 * 33], s[7 * 33]);
        *(GAS v4u*)(WT + (size_t)(row_off + n0 + n) * K + k0 + 8 * c) = o; }
    LDS_WAIT(); asm volatile("" ::: "memory");
}
struct Frame {
    LAS unsigned char* lds; volatile LAS unsigned* MISC; gu32* ctl;
    int tid, lane, wave, G;
    unsigned char* ws;
};
#define relaunder(F) do { int t_ = threadIdx.x; asm volatile("" : "+v"(t_)); (F).tid = t_; (F).lane = t_ & 63; (F).wave = __builtin_amdgcn_readfirstlane(t_ >> 6); } while (0)
typedef _Float16 half_t;
__device__ __forceinline__ float bf2f(unsigned short h) { return __builtin_bit_cast(float, (unsigned)h << 16); }
__device__ __forceinline__ float bflo(unsigned w) { return __builtin_bit_cast(float, w << 16); }
__device__ __forceinline__ float bfhi(unsigned w) { return __builtin_bit_cast(float, w & 0xffff0000u); }

__device__ __forceinline__ void p0_transpose_item2(const float* W, int K, int N, bf16* WT, LAS float* scr, int kb, int n0, int nvalid, int lane) {
    const int k0 = 64 * kb;
#pragma unroll 8
    for (int i = 0; i < 32; ++i) { const int kk = 2 * i + (lane >> 5); const int nn = lane & 31; scr[kk * 33 + nn] = (nn < nvalid) ? W[(size_t)(k0 + kk) * N + n0 + nn] : 0.f; }
    LDS_WAIT(); asm volatile("" ::: "memory");
    const int c = lane & 7;
#pragma unroll
    for (int j = 0; j < 4; ++j) { const int n = (lane >> 3) + 8 * j; const LAS float* s = scr + (8 * c) * 33 + n;
        v4u o; o.x = pk2(s[0 * 33], s[1 * 33]); o.y = pk2(s[2 * 33], s[3 * 33]); o.z = pk2(s[4 * 33], s[5 * 33]); o.w = pk2(s[6 * 33], s[7 * 33]);
        if (n < nvalid) *(GAS v4u*)(WT + (size_t)(n0 + n) * K + k0 + 8 * c) = o; }
    LDS_WAIT(); asm volatile("" ::: "memory");
}

__device__ __forceinline__ void gemv8_block(Frame& F, const float* Wm, int N, int j0, int ncols, const LAS float* atab, LAS float* part) {
    float a8[8];
#pragma unroll
    for (int b = 0; b < 8; ++b) a8[b] = 0.f;
    const int j = j0 + F.lane; const bool ok = F.lane < ncols;
    const int kbeg = F.wave * 128;
#pragma unroll 4
    for (int kk = 0; kk < 128; ++kk) { const int k = kbeg + kk; const float w = ok ? Wm[(size_t)k * N + j] : 0.f;
        const f32x4 t0 = *(const LAS f32x4*)(atab + k * 8), t1 = *(const LAS f32x4*)(atab + k * 8 + 4);
        a8[0] += t0[0] * w; a8[1] += t0[1] * w; a8[2] += t0[2] * w; a8[3] += t0[3] * w; a8[4] += t1[0] * w; a8[5] += t1[1] * w; a8[6] += t1[2] * w; a8[7] += t1[3] * w; }
#pragma unroll
    for (int b = 0; b < 8; ++b) part[(F.wave * 8 + b) * 64 + F.lane] = a8[b];
}

__device__ __forceinline__ void p0a(Frame& F, const float* const* in) {
    relaunder(F);
    const float* c = in[1]; const float* norm_g = in[2]; const float* ada_w = in[3]; const float* ada_b = in[4]; const float* lbl = in[5];
    const float* hg_w_in = in[6]; const float* hg_w_out = in[8]; const float* fx_w_in = in[9]; const float* fx_w_out = in[13];
    unsigned char* ws = F.ws;
    {
        LAS float* atab = (LAS float*)(F.lds);
        LAS float* part = (LAS float*)(F.lds + 32768);
        for (int e = F.tid; e < 8192; e += 512) { const int b = e >> 10, k = e & 1023; const float v = c[b * 1024 + k]; atab[k * 8 + b] = v / (1.0f + __expf(-v)); }
        __syncthreads();
        for (int it = blockIdx.x; it < 4 * 48; it += F.G) {
            const int l = it / 48, jb = it % 48, j0 = jb * 64;
            gemv8_block(F, ada_w + (size_t)l * 1024 * 3072, 3072, j0, 64, atab, part);
            __syncthreads();
            { const int b = F.tid >> 6, jl = F.tid & 63, j = j0 + jl; float s = ada_b[l * 3072 + j];
#pragma unroll
              for (int w = 0; w < 8; ++w) s += part[(w * 8 + b) * 64 + jl];
              const int sec = j >> 10, cc = j & 1023; const size_t o = ((size_t)l * 8 + b) * 1024 + cc;
              if (sec == 0) ((float*)(ws + WS_SH))[o] = s; else if (sec == 1) ((float*)(ws + WS_GS))[o] = norm_g[l * 1024 + cc] * (1.0f + s); else ((float*)(ws + WS_GATE))[o] = s; }
            __syncthreads();
        }
    }
    if (blockIdx.x == 0) { float* par = (float*)(ws + WS_PAR); for (int e = F.tid; e < 128; e += 512) { par[e] = in[11][e]; par[128 + e] = in[12][e]; } if (F.tid < 32) par[256 + F.tid] = in[10][F.tid]; for (int e = F.tid; e < 2048; e += 512) par[288 + e] = in[7][e]; }
    if (blockIdx.x == F.G - 1) { for (int e = F.tid; e < 1024; e += 512) { const float d = lbl[1024 + e] - lbl[e]; ((float*)(ws + WS_LB))[e] = 0.f; ((float*)(ws + WS_LB))[1024 + e] = 1.0f / (1.0f + __expf(-d)); } }
    {
        __syncthreads();
        LAS float* scr = (LAS float*)(F.lds + F.wave * 16384);
        const int gw = blockIdx.x * NWAVES + F.wave, NGW = F.G * NWAVES;
        constexpr int I_HG = 16 * 128, I_FX = 16 * 129, I_O = 16 * 32;
        constexpr int NIT = 2 * I_HG + 2 * I_FX + 4 * I_O;
        for (int it = gw; it < NIT; it += NGW) {
            int r = it;
            if (r < 2 * I_HG) { const int j = r / I_HG; r %= I_HG; p0_transpose_item2(hg_w_in + (size_t)j * 1024 * HG_IN, 1024, HG_IN, (bf16*)(ws + WS_WIN + (size_t)(2 * j) * WIN_STRIDE), scr, r / 128, (r % 128) * 32, 32, F.lane); continue; }
            r -= 2 * I_HG;
            if (r < 2 * I_FX) { const int j = r / I_FX; r %= I_FX; const int nb = r % 129; p0_transpose_item2(fx_w_in + (size_t)j * 1024 * FX_IN, 1024, FX_IN, (bf16*)(ws + WS_WIN + (size_t)(2 * j + 1) * WIN_STRIDE), scr, r / 129, nb * 32, nb == 128 ? 16 : 32, F.lane); continue; }
            r -= 2 * I_FX;
            { const int l = r / I_O; r %= I_O; const float* src = (l & 1) ? fx_w_out + (size_t)(l >> 1) * 1024 * 1024 : hg_w_out + (size_t)(l >> 1) * 1024 * 1024;
              p0_transpose_item2(src, 1024, 1024, (bf16*)(ws + WS_WOUT + (size_t)l * WOUT_STRIDE), scr, r / 32, (r % 32) * 32, 32, F.lane); }
        }
        for (int e = blockIdx.x * 512 + F.tid; e < 2 * 240 * 128; e += F.G * 512) { const int j = e / (240 * 128), q = e % (240 * 128);
            *(GAS v4u*)((bf16*)(ws + WS_WIN + (size_t)(2 * j + 1) * WIN_STRIDE) + (size_t)FX_IN * 1024 + (size_t)q * 8) = (v4u){0u, 0u, 0u, 0u}; }
    }
}

__device__ __forceinline__ void p0b(Frame& F, const float* const* in) {
    relaunder(F);
    const float* x = in[0]; const float* hg_w_in = in[6]; const float* fx_w_in = in[9];
    unsigned char* ws = F.ws;
    {
        LAS float* atab = (LAS float*)(F.lds);
        LAS float* part = (LAS float*)(F.lds + 32768);
        constexpr int NB_HG = 64, NB_FX = 68;
        for (int it = blockIdx.x; it < 2 * NB_HG + 2 * NB_FX; it += F.G) {
            int l, jb; if (it < 2 * NB_HG) { l = 2 * (it / NB_HG); jb = it % NB_HG; } else { const int r = it - 2 * NB_HG; l = 2 * (r / NB_FX) + 1; jb = r % NB_FX; }
            const bool fx = l & 1; const int N = fx ? FX_IN : HG_IN; const int j0 = jb * 64; const int ncols = (j0 + 64 <= N) ? 64 : (j0 < N ? N - j0 : 0);
            const float* Wm = fx ? fx_w_in + (size_t)(l >> 1) * 1024 * FX_IN : hg_w_in + (size_t)(l >> 1) * 1024 * HG_IN;
            const float* sh = (const float*)(ws + WS_SH) + (size_t)l * 8 * 1024;
            __syncthreads();
            for (int e = F.tid; e < 8192; e += 512) { const int b = e >> 10, k = e & 1023; atab[k * 8 + b] = sh[b * 1024 + k]; }
            __syncthreads();
            gemv8_block(F, Wm, N, j0, ncols, atab, part);
            __syncthreads();
            { const int b = F.tid >> 6, jl = F.tid & 63; float s = 0.f;
#pragma unroll
              for (int w = 0; w < 8; ++w) s += part[(w * 8 + b) * 64 + jl];
              ((float*)(ws + WS_BIAS))[((size_t)l * 8 + b) * BIAS_LD + j0 + jl] = (jl < ncols) ? s : 0.f; }
        }
    }
    {
        const int gw = blockIdx.x * NWAVES + F.wave, NGW = F.G * NWAVES;
        const float* gs = (const float*)(ws + WS_GS);
        float* rowss = (float*)(ws + WS_ROWSS);
        bf16* xs = (bf16*)(ws + WS_XS);
        for (int m = gw; m < M; m += NGW) {
            const int b = m >> 12; const GAS f32x4* xr = (const GAS f32x4*)(x + (size_t)m * 1024) + F.lane; const f32x4* gr = (const f32x4*)(gs + b * 1024) + F.lane;
            GAS unsigned long long* o8 = (GAS unsigned long long*)(xs + (size_t)m * 1024) + F.lane; float s = 0.f;
#pragma unroll
            for (int j = 0; j < 4; ++j) { const f32x4 v = xr[64 * j], g = gr[64 * j]; s += (v.x * v.x + v.y * v.y) + (v.z * v.z + v.w * v.w);
                o8[64 * j] = (unsigned long long)pk2(v.x * g.x, v.y * g.y) | ((unsigned long long)pk2(v.z * g.z, v.w * g.w) << 32); }
            s = wave_sum(s); if (F.lane == 0) rowss[m] = s;
        }
    }
}

__device__ __forceinline__ void fox_fl_units(Frame& F, int l) {
    relaunder(F);
    unsigned char* ws = F.ws; const int lane = F.lane, w = F.wave, fr = lane & 15, q4 = lane >> 4, jj = l >> 1;
    const GAS bf16* xs = (const GAS bf16*)(ws + WS_XS); const GAS bf16* wt = (const GAS bf16*)(ws + WS_WIN + (size_t)l * WIN_STRIDE) + (size_t)(4096 + fr) * 1024 + 8 * q4;
    const GAS float* rowss = (const GAS float*)(ws + WS_ROWSS) + (size_t)l * M; const GAS float* bias = (const GAS float*)(ws + WS_BIAS) + (size_t)l * 8 * BIAS_LD + 4096;
    const GAS float* bfg = (const GAS float*)(ws + WS_PAR) + 256 + jj * 16; GAS float* lf = (GAS float*)(ws + WS_LF);
    typedef short bf16x8_t __attribute__((ext_vector_type(8)));
    for (int u = blockIdx.x; u < M / 256; u += F.G) {
        const int row0 = u * 256 + 32 * w, b = u >> 4;
        const GAS bf16* a0 = xs + (size_t)(row0 + fr) * 1024 + 8 * q4; const GAS bf16* a1 = a0 + 16 * 1024;
        f32x4 c0 = (f32x4){0.f, 0.f, 0.f, 0.f}, c1 = c0;
#pragma unroll 8
        for (int ks = 0; ks < 32; ++ks) { const bf16x8_t bb = *(const GAS bf16x8_t*)(wt + 32 * ks), x0 = *(const GAS bf16x8_t*)(a0 + 32 * ks), x1 = *(const GAS bf16x8_t*)(a1 + 32 * ks);
            c0 = __builtin_amdgcn_mfma_f32_16x16x32_bf16(x0, bb, c0, 0, 0, 0); c1 = __builtin_amdgcn_mfma_f32_16x16x32_bf16(x1, bb, c1, 0, 0, 0); }
        const float bsum = bias[b * BIAS_LD + fr] + bfg[fr];
#pragma unroll
        for (int e = 0; e < 4; ++e) { const int r0 = row0 + 4 * q4 + e, r1 = r0 + 16;
            lf[(size_t)r0 * 16 + fr] = pg8::log_sigmoid(c0[e] * rsqrtf(rowss[r0] * (1.0f / 1024.0f) + EPS) + bsum);
            lf[(size_t)r1 * 16 + fr] = pg8::log_sigmoid(c1[e] * rsqrtf(rowss[r1] * (1.0f / 1024.0f) + EPS) + bsum); }
    }
}

__device__ __forceinline__ void fox_cumsum(Frame& F) {
    relaunder(F);
    unsigned char* ws = F.ws; const float* lf = (const float*)(ws + WS_LF); float* ckl = (float*)(ws + WS_CKL); bf16* kx = (bf16*)(ws + WS_KX);
    const int gw = blockIdx.x * NWAVES + F.wave, NGW = F.G * NWAVES;
    for (int bh = gw; bh < 128; bh += NGW) {
        const int b = bh >> 4, h = bh & 15; const float* p = lf + ((size_t)b * SEQ + F.lane * 64) * 16 + h;
        float sum = 0.f;
        for (int i = 0; i < 64; ++i) sum += p[i * 16];
        float incl = sum;
#pragma unroll
        for (int off = 1; off < 64; off <<= 1) { const float t = __shfl_up(incl, off); if (F.lane >= off) incl += t; }
        float run = incl - sum;
        for (int i = 0; i < 64; ++i) { run += p[i * 16]; const float c = run * LOG2E; const size_t s = (size_t)bh * SEQ + F.lane * 64 + i; ckl[s] = c;
            const float xv = -c; const unsigned h0 = f2bf(xv); const float r1 = xv - __builtin_bit_cast(float, h0 << 16); const unsigned h1 = f2bf(r1); const float r2 = r1 - __builtin_bit_cast(float, h1 << 16); const unsigned h2 = f2bf(r2);
            *(GAS v4u*)(kx + s * 8) = (v4u){h0 | (h1 << 16), h2, 0u, 0u}; }
    }
}

#if !FAST_ATTN
__device__ __forceinline__ void attn_naive(Frame& F) {
    relaunder(F);
    unsigned char* ws = F.ws;
    const bf16* Q = (const bf16*)(ws + WS_B0); const bf16* K = (const bf16*)(ws + WS_B0 + BUF_STRIDE); const bf16* V = (const bf16*)(ws + WS_B0 + 2 * BUF_STRIDE); const bf16* Z = (const bf16*)(ws + WS_B0 + 3 * BUF_STRIDE);
    const float* CKL = (const float*)(ws + WS_CKL); bf16* AO = (bf16*)(ws + WS_AO);
    LAS float* Kf = (LAS float*)(F.lds); LAS float* Vf = Kf + 4096; LAS float* ckt = Vf + 4096;
    for (int u = blockIdx.x; u < 1024; u += F.G) {
        const int qblk = 7 - (u >> 7), bh = u & 127, b = bh >> 4, h = bh & 15;
        const int t = qblk * 512 + F.tid; const size_t row = (size_t)b * SEQ + t;
        float q[64], o[64];
#pragma unroll
        for (int c8 = 0; c8 < 8; ++c8) { const v4u w = *(const GAS v4u*)(Q + row * 1024 + h * 64 + c8 * 8);
            q[c8 * 8 + 0] = bflo(w.x); q[c8 * 8 + 1] = bfhi(w.x); q[c8 * 8 + 2] = bflo(w.y); q[c8 * 8 + 3] = bfhi(w.y); q[c8 * 8 + 4] = bflo(w.z); q[c8 * 8 + 5] = bfhi(w.z); q[c8 * 8 + 6] = bflo(w.w); q[c8 * 8 + 7] = bfhi(w.w); }
#pragma unroll
        for (int d = 0; d < 64; ++d) o[d] = 0.f;
        float mx = -INFINITY, l = 0.f;
        const int ntile = (qblk + 1) * 8;
        for (int j = 0; j < ntile; ++j) {
            __syncthreads();
            { const int key = F.tid >> 3, ch = F.tid & 7; const size_t krow = (size_t)b * SEQ + j * 64 + key;
              const v4u kw = *(const GAS v4u*)(K + krow * 1024 + h * 64 + ch * 8), vw = *(const GAS v4u*)(V + krow * 1024 + h * 64 + ch * 8);
              LAS f32x4* kd = (LAS f32x4*)(Kf + key * 64 + ch * 8); LAS f32x4* vd = (LAS f32x4*)(Vf + key * 64 + ch * 8);
              kd[0] = (f32x4){bflo(kw.x), bfhi(kw.x), bflo(kw.y), bfhi(kw.y)}; kd[1] = (f32x4){bflo(kw.z), bfhi(kw.z), bflo(kw.w), bfhi(kw.w)};
              vd[0] = (f32x4){bflo(vw.x), bfhi(vw.x), bflo(vw.y), bfhi(vw.y)}; vd[1] = (f32x4){bflo(vw.z), bfhi(vw.z), bflo(vw.w), bfhi(vw.w)};
              if (F.tid < 64) ckt[F.tid] = CKL[(size_t)bh * SEQ + j * 64 + F.tid]; }
            __syncthreads();
            int kmax = t - j * 64; if (kmax > 63) kmax = 63;
            for (int key = 0; key <= kmax; ++key) {
                float s = -ckt[key];
#pragma unroll
                for (int d4 = 0; d4 < 16; ++d4) { const f32x4 kk = *(const LAS f32x4*)(Kf + key * 64 + d4 * 4); s += q[d4 * 4] * kk[0] + q[d4 * 4 + 1] * kk[1] + q[d4 * 4 + 2] * kk[2] + q[d4 * 4 + 3] * kk[3]; }
                if (s > mx) { const float a = __builtin_amdgcn_exp2f(mx - s); l *= a;
#pragma unroll
                    for (int d = 0; d < 64; ++d) o[d] *= a;
                    mx = s; }
                const float p = __builtin_amdgcn_exp2f(s - mx); l += p;
#pragma unroll
                for (int d4 = 0; d4 < 16; ++d4) { const f32x4 vv = *(const LAS f32x4*)(Vf + key * 64 + d4 * 4); o[d4 * 4] += p * vv[0]; o[d4 * 4 + 1] += p * vv[1]; o[d4 * 4 + 2] += p * vv[2]; o[d4 * 4 + 3] += p * vv[3]; }
            }
        }
        const float inv = 1.0f / l;
#pragma unroll
        for (int c8 = 0; c8 < 8; ++c8) { const v4u zw = *(const GAS v4u*)(Z + row * 1024 + h * 64 + c8 * 8); v4u w;
            w.x = pk2(o[c8 * 8 + 0] * inv * bflo(zw.x), o[c8 * 8 + 1] * inv * bfhi(zw.x)); w.y = pk2(o[c8 * 8 + 2] * inv * bflo(zw.y), o[c8 * 8 + 3] * inv * bfhi(zw.y));
            w.z = pk2(o[c8 * 8 + 4] * inv * bflo(zw.z), o[c8 * 8 + 5] * inv * bfhi(zw.z)); w.w = pk2(o[c8 * 8 + 6] * inv * bflo(zw.w), o[c8 * 8 + 7] * inv * bfhi(zw.w));
            *(GAS v4u*)(AO + row * 1024 + h * 64 + c8 * 8) = w; }
    }
}

#endif
#if !FAST_SCAN
__device__ __forceinline__ void scan_naive(Frame& F, int jlayer) {
    relaunder(F); const float* og = (const float*)(F.ws + WS_PAR) + 288 + jlayer * 1024;
    unsigned char* ws = F.ws;
    const bf16* Qb = (const bf16*)(ws + WS_B0); const half_t* Gb = (const half_t*)(ws + WS_B0 + BUF_STRIDE); const bf16* Vb = (const bf16*)(ws + WS_B0 + 2 * BUF_STRIDE); const bf16* Zb = (const bf16*)(ws + WS_B0 + 3 * BUF_STRIDE);
    bf16* AO = (bf16*)(ws + WS_AO);
    LAS float* ff = (LAS float*)(F.lds); LAS float* kk = ff + 1024; LAS float* qq = kk + 1024; LAS float* vv = qq + 1024; LAS float* po = vv + 1024;
    for (int u = blockIdx.x; u < 64; u += F.G) {
        const int b = u >> 3, h = u & 7; const int v = F.tid & 127, kq = F.tid >> 7;
        float S[32];
#pragma unroll
        for (int i = 0; i < 32; ++i) S[i] = 0.f;
        for (int tg = 0; tg < SEQ / 8; ++tg) {
            const size_t row0 = (size_t)b * SEQ + tg * 8;
#pragma unroll
            for (int r = 0; r < 2; ++r) { const int e = F.tid + 512 * r, tok = e >> 7, c = e & 127; const size_t a = (row0 + tok) * 1024 + h * 128 + c;
                const float g = (float)Gb[a]; const float f = __builtin_amdgcn_exp2f(g); ff[e] = f; kk[e] = 1.0f - f; qq[e] = bf2f(Qb[a]); vv[e] = bf2f(Vb[a]); }
            __syncthreads();
#pragma unroll 1
            for (int tok = 0; tok < 8; ++tok) {
                const float vt = vv[tok * 128 + v]; float p = 0.f;
#pragma unroll
                for (int i4 = 0; i4 < 8; ++i4) { const int k = tok * 128 + kq * 32 + i4 * 4; const f32x4 f4 = *(const LAS f32x4*)(ff + k), k4 = *(const LAS f32x4*)(kk + k), q4 = *(const LAS f32x4*)(qq + k);
#pragma unroll
                    for (int e = 0; e < 4; ++e) { S[i4 * 4 + e] = f4[e] * S[i4 * 4 + e] + k4[e] * vt; p += q4[e] * S[i4 * 4 + e]; } }
                po[(tok * 4 + kq) * 128 + v] = p;
            }
            __syncthreads();
            { const int tok = F.tid >> 6, v2 = (F.tid & 63) * 2;
              float o0 = 0.f, o1 = 0.f;
#pragma unroll
              for (int q4 = 0; q4 < 4; ++q4) { o0 += po[(tok * 4 + q4) * 128 + v2]; o1 += po[(tok * 4 + q4) * 128 + v2 + 1]; }
              const float ss = wave_sum(o0 * o0 + o1 * o1); const float rn = rsqrtf(ss * (1.0f / 128.0f) + EPS);
              const size_t a = (row0 + tok) * 1024 + h * 128 + v2; const unsigned zw = *(const GAS unsigned*)(Zb + a);
              *(GAS unsigned*)(AO + a) = pk2(o0 * rn * og[h * 128 + v2] * bflo(zw), o1 * rn * og[h * 128 + v2 + 1] * bfhi(zw)); }
        }
        __syncthreads();
    }
}

#endif
namespace hg {
typedef short bf16x8 __attribute__((ext_vector_type(8)));
typedef short bf16x4 __attribute__((ext_vector_type(4)));
constexpr int QS = 272, KS = 80;
constexpr int OFF_Q = 0, OFF_K = 32 * QS, OFF_KD = 2 * 32 * QS, OFF_VT = OFF_KD + 128 * KS, OFF_DE = OFF_VT + 128 * KS, BUF = OFF_DE + 512;
constexpr int OFF_SSQ = 2 * BUF;
static_assert(OFF_SSQ + 2048 <= RING_BYTES, "scan LDS");
#define HG_MFMA(a, b, c) __builtin_amdgcn_mfma_f32_16x16x32_bf16(a, b, c, 0, 0, 0)
__device__ __forceinline__ bf16x8 cat8(bf16x4 lo, bf16x4 hi) { return (bf16x8){lo[0], lo[1], lo[2], lo[3], hi[0], hi[1], hi[2], hi[3]}; }
typedef float f32x2_t __attribute__((ext_vector_type(2))); typedef __bf16 bf16x2_t __attribute__((ext_vector_type(2)));
__device__ __forceinline__ unsigned cvtpk(float lo, float hi) { f32x2_t v = {lo, hi}; bf16x2_t b = __builtin_convertvector(v, bf16x2_t); return __builtin_bit_cast(unsigned, b); }
__device__ __forceinline__ bf16x8 pack8(f32x4 a, f32x4 b) { v4u r; r.x = cvtpk(a[0], a[1]); r.y = cvtpk(a[2], a[3]); r.z = cvtpk(b[0], b[1]); r.w = cvtpk(b[2], b[3]); return __builtin_bit_cast(bf16x8, r); }

__device__ __forceinline__ void scan_fast(Frame& F, int jlayer, bool full) {
    relaunder(F);
    unsigned char* ws = F.ws;
    const GAS bf16* Qb = (const GAS bf16*)(ws + WS_B0); const GAS half_t* Gb = (const GAS half_t*)(ws + WS_B0 + BUF_STRIDE); const GAS bf16* Vb = (const GAS bf16*)(ws + WS_B0 + 2 * BUF_STRIDE); const GAS bf16* Zb = (const GAS bf16*)(ws + WS_B0 + 3 * BUF_STRIDE);
    GAS bf16* AO = (GAS bf16*)(ws + WS_AO); const GAS float* og = (const GAS float*)(ws + WS_PAR) + 288 + jlayer * 1024;
    const int tid = F.tid, lane = F.lane, w = F.wave, fr = lane & 15, q4 = lane >> 4;
    LAS unsigned char* L = F.lds;
    LAS float* ssq = (LAS float*)(L + OFF_SSQ);
    constexpr int NSUB = SEQ / 4 / 32;
    GAS float* sloc = (GAS float*)(ws + WS_SLOC); GAS float* dtot = (GAS float*)(ws + WS_DTOT);
    const int nunits = full ? 256 : 192;
    for (int u = blockIdx.x; u < nunits; u += F.G) {
        const int bh = u & 63, seg = u >> 6, b = bh >> 3, h = bh & 7; const size_t rowbase = (size_t)b * SEQ + (size_t)seg * (SEQ / 4); const int colbase = h * 128;
        f32x4 S[8];
#pragma unroll
        for (int T = 0; T < 8; ++T) S[T] = (f32x4){0.f, 0.f, 0.f, 0.f};
        if (full) for (int sp = 0; sp < seg; ++sp) {
            const GAS float* sl = sloc + ((size_t)(bh * 4 + sp) << 14) + 16 * w + fr; const GAS float* dl = dtot + (bh * 4 + sp) * 128;
#pragma unroll
            for (int T = 0; T < 8; ++T)
#pragma unroll
                for (int e = 0; e < 4; ++e) { const int c = 16 * T + 4 * q4 + e; S[T][e] = __builtin_amdgcn_exp2f(dl[c]) * S[T][e] + sl[c * 128]; } }
        float Eacc = 0.f;
        f32x4 Zp[2]; Zp[0] = (f32x4){0.f, 0.f, 0.f, 0.f}; Zp[1] = Zp[0];
        const int pc = 16 * w + fr;
        unsigned short qh[8]; half_t gh[8]; v4u vraw; unsigned long long zcur[2] = {0ull, 0ull}, znext[2] = {0ull, 0ull};
#pragma unroll
        for (int i = 0; i < 8; ++i) qh[i] = 0;
#define HG_LOAD(n_) do { const size_t r0_ = rowbase + (size_t)(n_) * 32; \
            _Pragma("unroll") for (int i = 0; i < 8; ++i) { const size_t a_ = (r0_ + 8 * q4 + i) * 1024 + colbase + pc; if (full) qh[i] = Qb[a_]; gh[i] = Gb[a_]; } \
            vraw = *(const GAS v4u*)(Vb + (r0_ + (tid & 31)) * 1024 + colbase + (tid >> 5) * 8); } while (0)
        HG_LOAD(0);
        for (int n = 0; n <= NSUB; ++n) {
            LAS unsigned char* buf = L + (n & 1) * BUF;
            unsigned short qc[8]; half_t gc[8];
#pragma unroll
            for (int i = 0; i < 8; ++i) { qc[i] = qh[i]; gc[i] = gh[i]; }
            const v4u vcur = vraw;
            if (n + 1 < NSUB) HG_LOAD(n + 1);
            if (full && n < NSUB) {
#pragma unroll
                for (int ti = 0; ti < 2; ++ti) znext[ti] = *(const GAS unsigned long long*)(Zb + (rowbase + (size_t)n * 32 + 16 * ti + fr) * 1024 + colbase + 16 * w + 4 * q4); }
            if (n < NSUB) {
                float bcum[8]; float run = 0.f;
#pragma unroll
                for (int i = 0; i < 8; ++i) { run += (float)gc[i]; bcum[i] = run; }
                float x = run; float y = __shfl_up(x, 16); if (q4 >= 1) x += y; y = __shfl_up(x, 32); if (q4 >= 2) x += y;
                const float excl = x - run; const float E = __shfl(x, 48 + fr); Eacc += E;
                float kdv[8];
#pragma unroll
                for (int i = 0; i < 8; ++i) { const float bc = excl + bcum[i]; const float kk = 1.0f - __builtin_amdgcn_exp2f((float)gc[i]);
                    kdv[i] = kk * __builtin_amdgcn_exp2f(E - bc);
                    if (full) { const int t = 8 * q4 + i; const unsigned qk = cvtpk(bf2f(qc[i]) * __builtin_amdgcn_exp2f(bc), kk * __builtin_amdgcn_exp2f(fminf(-bc, 115.f)));
                        *(LAS unsigned short*)(buf + OFF_Q + t * QS + pc * 2) = (unsigned short)(qk & 0xffffu); *(LAS unsigned short*)(buf + OFF_K + t * QS + pc * 2) = (unsigned short)(qk >> 16); } }
                *(LAS v4u*)(buf + OFF_KD + pc * KS + q4 * 16) = (v4u){cvtpk(kdv[0], kdv[1]), cvtpk(kdv[2], kdv[3]), cvtpk(kdv[4], kdv[5]), cvtpk(kdv[6], kdv[7])};
                if (q4 == 0) *(LAS float*)(buf + OFF_DE + pc * 4) = __builtin_amdgcn_exp2f(E);
                { const int tok = tid & 31, ch = tid >> 5; LAS unsigned char* vp = buf + OFF_VT + (ch * 8) * KS + tok * 2;
                  *(LAS unsigned short*)(vp + 0 * KS) = (unsigned short)(vcur.x & 0xffffu); *(LAS unsigned short*)(vp + 1 * KS) = (unsigned short)(vcur.x >> 16);
                  *(LAS unsigned short*)(vp + 2 * KS) = (unsigned short)(vcur.y & 0xffffu); *(LAS unsigned short*)(vp + 3 * KS) = (unsigned short)(vcur.y >> 16);
                  *(LAS unsigned short*)(vp + 4 * KS) = (unsigned short)(vcur.z & 0xffffu); *(LAS unsigned short*)(vp + 5 * KS) = (unsigned short)(vcur.z >> 16);
                  *(LAS unsigned short*)(vp + 6 * KS) = (unsigned short)(vcur.w & 0xffffu); *(LAS unsigned short*)(vp + 7 * KS) = (unsigned short)(vcur.w >> 16); }
            }
            if (full && n > 0) {
#pragma unroll
                for (int ti = 0; ti < 2; ++ti) { float p = (Zp[ti][0] * Zp[ti][0] + Zp[ti][1] * Zp[ti][1]) + (Zp[ti][2] * Zp[ti][2] + Zp[ti][3] * Zp[ti][3]);
                    p += __shfl_xor(p, 16); p += __shfl_xor(p, 32); if (q4 == 0) ssq[(((n - 1) & 1) * 8 + w) * 32 + 16 * ti + fr] = p; }
            }
            __syncthreads();
            if (full && n > 0) {
                const size_t r0 = rowbase + (size_t)(n - 1) * 32; const int vcol = colbase + 16 * w + 4 * q4; const f32x4 gg = *(const GAS f32x4*)(og + vcol);
#pragma unroll
                for (int ti = 0; ti < 2; ++ti) { float tot = 0.f;
#pragma unroll
                    for (int ww = 0; ww < 8; ++ww) tot += ssq[(((n - 1) & 1) * 8 + ww) * 32 + 16 * ti + fr];
                    const float rn = rsqrtf(tot * (1.0f / 128.0f) + EPS); const size_t a = (r0 + 16 * ti + fr) * 1024 + vcol;
                    const unsigned long long zz = zcur[ti]; const unsigned z0 = (unsigned)zz, z1 = (unsigned)(zz >> 32);
                    const unsigned o0 = cvtpk(Zp[ti][0] * rn * gg[0] * bflo(z0), Zp[ti][1] * rn * gg[1] * bfhi(z0)), o1 = cvtpk(Zp[ti][2] * rn * gg[2] * bflo(z1), Zp[ti][3] * rn * gg[3] * bfhi(z1));
                    *(GAS unsigned long long*)(AO + a) = (unsigned long long)o0 | ((unsigned long long)o1 << 32); }
            }
            zcur[0] = znext[0]; zcur[1] = znext[1];
            if (n >= NSUB) break;
            const LAS unsigned char* Qr0 = buf + OFF_Q + fr * QS; const LAS unsigned char* Qr1 = Qr0 + 16 * QS;
            const LAS unsigned char* Kr0 = buf + OFF_K + fr * QS; const LAS unsigned char* Kr1 = Kr0 + 16 * QS;
            const LAS unsigned char* Vr = buf + OFF_VT + (16 * w + fr) * KS;
            f32x4 Z0 = (f32x4){0.f, 0.f, 0.f, 0.f}, Z1 = Z0, X00 = Z0, X01 = Z0, X11 = Z0;
            if (full) {
#pragma unroll
            for (int ks = 0; ks < 4; ++ks) {
                const bf16x8 Sa = pack8(S[2 * ks], S[2 * ks + 1]);
                const int cb = (32 * ks + 4 * q4) * 2;
                const bf16x8 Bq0 = cat8(*(const LAS bf16x4*)(Qr0 + cb), *(const LAS bf16x4*)(Qr0 + cb + 32)), Bq1 = cat8(*(const LAS bf16x4*)(Qr1 + cb), *(const LAS bf16x4*)(Qr1 + cb + 32));
                Z0 = HG_MFMA(Sa, Bq0, Z0); Z1 = HG_MFMA(Sa, Bq1, Z1);
                const int cn = (32 * ks + 8 * q4) * 2;
                const bf16x8 a0 = *(const LAS bf16x8*)(Kr0 + cn), a1 = *(const LAS bf16x8*)(Kr1 + cn), b0 = *(const LAS bf16x8*)(Qr0 + cn), b1 = *(const LAS bf16x8*)(Qr1 + cn);
                X00 = HG_MFMA(a0, b0, X00); X01 = HG_MFMA(a0, b1, X01); X11 = HG_MFMA(a1, b1, X11);
            }
#pragma unroll
            for (int e = 0; e < 4; ++e) { const bool keep = (4 * q4 + e) <= fr; X00[e] = keep ? X00[e] : 0.f; X11[e] = keep ? X11[e] : 0.f; }
            { const bf16x8 P0 = pack8(X00, (f32x4){0.f, 0.f, 0.f, 0.f}), P1 = pack8(X01, X11);
              const bf16x8 Av = cat8(*(const LAS bf16x4*)(Vr + 8 * q4), *(const LAS bf16x4*)(Vr + 32 + 8 * q4));
              Z0 = HG_MFMA(Av, P0, Z0); Z1 = HG_MFMA(Av, P1, Z1); }
            }
            { const bf16x8 Bv = *(const LAS bf16x8*)(Vr + 16 * q4);
#pragma unroll
              for (int T = 0; T < 8; ++T) { const bf16x8 a = *(const LAS bf16x8*)(buf + OFF_KD + (16 * T + fr) * KS + 16 * q4); const f32x4 de = *(const LAS f32x4*)(buf + OFF_DE + (16 * T + 4 * q4) * 4);
                  S[T] = HG_MFMA(a, Bv, S[T] * de); } }
            Zp[0] = Z0; Zp[1] = Z1;
        }
#undef HG_LOAD
        if (!full) {
            GAS float* sl = sloc + ((size_t)(bh * 4 + seg) << 14) + 16 * w + fr;
#pragma unroll
            for (int T = 0; T < 8; ++T)
#pragma unroll
                for (int e = 0; e < 4; ++e) sl[(16 * T + 4 * q4 + e) * 128] = S[T][e];
            if (q4 == 0) dtot[(bh * 4 + seg) * 128 + pc] = Eacc; }
        __syncthreads();
    }
}
#undef HG_MFMA
}
struct Args { const float* in[14]; float* out; unsigned char* ws; int ph_lo, ph_hi, li, pad; };
constexpr int N_PHASES = 2 + 4 * DEPTH;
__global__ void __launch_bounds__(NWAVES * 64, 2) fwd(Args args) {
    extern __shared__ __attribute__((aligned(16))) unsigned char lds[];
    Frame F;
    F.lds = (LAS unsigned char*)lds; F.MISC = (volatile LAS unsigned*)(F.lds + MISC_OFF);
    F.tid = threadIdx.x; F.lane = F.tid & 63; F.wave = __builtin_amdgcn_readfirstlane(F.tid >> 6); F.G = gridDim.x; F.ws = args.ws;
    F.ctl = (gu32*)(args.ws + WS_CTL);
    for (int u = F.tid; u < (LDS_BYTES - LDSCTL_OFF) / 4; u += NWAVES * 64) ((LAS unsigned*)(F.lds + LDSCTL_OFF))[u] = 0u;
    __syncthreads();
    XcdBarrier bar; bar.bar = (unsigned*)(F.ctl + CW_BAR); bar.x = 0; bar.st = nullptr;
    const bool one = (args.ph_hi - args.ph_lo) > 1;
    if (one) bar = xcd_barrier_post((unsigned*)(F.ctl + CW_BAR), F.MISC + 8);
    const int lo = args.ph_lo, hi = args.ph_hi;
#define IN(k) (lo <= (k) && (k) < hi)
#define SEAM(k) do { if (IN(k) && IN((k) + 1)) xcd_barrier(bar); } while (0)
    unsigned char* ws = args.ws;
#if PROBE_DOUBLE & 8
    if (IN(0)) { p0a(F, args.in); SEAM(0); }
    if (IN(1)) { p0b(F, args.in); SEAM(1); }
#endif
    if (IN(0)) { p0a(F, args.in); SEAM(0); }
    if (IN(1)) { p0b(F, args.in); SEAM(1); }
    for (int p = (lo > 2 ? lo : 2); p < hi; ++p) {
        const int l = (p - 2) >> 2, sub = (p - 2) & 3, j = l >> 1; const bool fx = l & 1;
#if PROBE_DOUBLE
        const bool dbl = ((PROBE_DOUBLE & 1) && sub == 0) || ((PROBE_DOUBLE & 2) && !fx && (sub == 1 || sub == 2)) || ((PROBE_DOUBLE & 4) && fx && (sub == 1 || sub == 2));
        for (int rep = dbl ? 0 : 1; rep < 2; ++rep) { if (dbl && rep == 1) xcd_barrier(bar);
#endif
        if (sub == 0 || sub == 3) {
            const bool isout = sub == 3;
            pg8::Gemm g{(const pg8::bf16_t*)(ws + (isout ? WS_AO : WS_XS)), (const pg8::bf16_t*)(ws + (isout ? WS_WOUT + (size_t)l * WOUT_STRIDE : WS_WIN + (size_t)l * WIN_STRIDE)), M, isout ? DM : HG_IN, DM};
            pg8::StaticOrder S; S.init(M, g.N, F.G, (int)blockIdx.x);
            pg8::EpiAll E; E.ws = ws; E.x0 = args.in[0]; E.xo = args.out; E.l = l; E.isout = isout ? 1 : 0;
            pg8::gemm_phase<pg8::EpiAll, pg8::StaticOrder, PG8_ALIGN, PG8_SP2>(F.lds + RING_OFF, g, S, E);
            if (fx && !isout) fox_fl_units(F, l);
        } else if (!fx) {
#if FAST_SCAN
            hg::scan_fast(F, j, sub == 2);
#else
            if (sub == 1) continue;
            scan_naive(F, j);
#endif
        } else if (sub == 1) {
            fox_cumsum(F);
        } else {
#if FAST_ATTN
            relaunder(F);
            float tthr; { const float* par = (const float*)(ws + WS_PAR); float gq = fabsf(par[j * 64 + F.lane]), gk = fabsf(par[128 + j * 64 + F.lane]);
#pragma unroll
              for (int o = 1; o < 64; o <<= 1) { gq = fmaxf(gq, __shfl_xor(gq, o)); gk = fmaxf(gk, __shfl_xor(gk, o)); }
              tthr = __builtin_bit_cast(float, __builtin_amdgcn_readfirstlane(__builtin_bit_cast(int, 2.04f * 64.0f * C2 * gq * gk + 42.0f))); }
            attn_body::attn_phase<8>((char*)lds + RING_OFF, F.MISC + 16, (unsigned*)(ws + WS_CTL) + 64 + 64 * j, ws, tthr);
#else
            attn_naive(F);
#endif
        }
#if PROBE_DOUBLE
        }
#endif
        if (p + 1 < hi) xcd_barrier(bar);
    }
#undef IN
#undef SEAM
}

extern "C" void kernel_launch(void* const* d_in, const int* in_sizes, int n_in, void* d_out, int out_size, void* d_ws, size_t ws_size, hipStream_t stream) {
    static int grid = 0;
    if (grid == 0) {
        if (n_in != 14 || in_sizes[0] != M * DM || out_size != M * DM || ws_size < WS_END) { fprintf(stderr, "kernel_launch: unexpected shapes (n_in %d, in0 %d, out %d, ws %zu); nothing launched\n", n_in, n_in > 0 ? in_sizes[0] : -1, out_size, ws_size); grid = -1; return; }
        int dev = 0, cus = 0, per_cu = 0;
        if (hipGetDevice(&dev) != hipSuccess || hipDeviceGetAttribute(&cus, hipDeviceAttributeMultiprocessorCount, dev) != hipSuccess) { grid = -1; return; }
        if (hipFuncSetAttribute((const void*)fwd, hipFuncAttributeMaxDynamicSharedMemorySize, LDS_BYTES) != hipSuccess) { fprintf(stderr, "kernel_launch: hipFuncSetAttribute failed\n"); grid = -1; return; }
        if (hipOccupancyMaxActiveBlocksPerMultiprocessor(&per_cu, (const void*)fwd, NWAVES * 64, LDS_BYTES) != hipSuccess || per_cu < 1) fprintf(stderr, "kernel_launch: note: occupancy query reports %d workgroups per CU\n", per_cu);
        (void)hipGetLastError();
        grid = cus;
    }
    if (grid < 0) return;
    if (hipMemsetAsync((char*)d_ws + WS_CTL, 0, CTL_ZERO_BYTES, stream) != hipSuccess) { fprintf(stderr, "kernel_launch: hipMemsetAsync failed\n"); return; }
    Args a{};
    for (int i = 0; i < 14; ++i) a.in[i] = (const float*)d_in[i];
    a.out = (float*)d_out; a.ws = (unsigned char*)d_ws; a.li = 0; a.pad = 0;
#if MK_ONE_LAUNCH
    a.ph_lo = 0; a.ph_hi = N_PHASES;
    hipLaunchKernelGGL(fwd, dim3(grid), dim3(NWAVES * 64), LDS_BYTES, stream, a);
#else
    for (int p = 0; p < N_PHASES; ++p) {
        a.ph_lo = p; a.ph_hi = p + 1;
        hipLaunchKernelGGL(fwd, dim3(grid), dim3(NWAVES * 64), LDS_BYTES, stream, a);
    }
#endif
    const hipError_t le = hipPeekAtLastError();
    if (le != hipSuccess) fprintf(stderr, "kernel_launch: launch failed: %s\n", hipGetErrorName(le));
}
```
